# Optimizing an MI355X kernel written in HIP

```python
import jax, jax.numpy as jnp
from jax import lax
import numpy as np

D_MODEL = 2048
BATCH = 32
SEQ = 256
DEPTH = 4
DEC_BATCH = 2
DEC_SEQ = 1024
PAST_LEN = 512

GRID_W = 64
HEAD_DIM = 128
MIX_WIDTH = D_MODEL
D_FF = 5504
N_MOD = 9
EPS = 1e-6
NEG = -1e30
ROPE_BASE = 10000.0
CHUNK = 128
A_WIDTH = MIX_WIDTH // 2
A_GROUP_DIM = 128
A_GROUPS = A_WIDTH // A_GROUP_DIM
B_WIDTH = MIX_WIDTH // 2
B_GROUPS = 4
B_GROUP_DIM = B_WIDTH // B_GROUPS
C_HEADS = (MIX_WIDTH // 2) // HEAD_DIM
C_KV_HEADS = 2
C_GROUP = C_HEADS // C_KV_HEADS
WINDOW = 128
BLOCK = 128
D_HEADS = (MIX_WIDTH // 2) // HEAD_DIM
NA_ROWS_MAX = 8
NA_COLS = 16
N_EVEN = (DEPTH + 1) // 2
N_ODD = DEPTH // 2
EVEN_IN = 2 * A_WIDTH + B_WIDTH
C_Q = C_HEADS * HEAD_DIM
C_KV = C_KV_HEADS * HEAD_DIM
D_W = D_HEADS * HEAD_DIM
ODD_IN = C_Q + 2 * C_KV + 3 * D_W
ATTN_SCALE = HEAD_DIM ** -0.5

kernel_name = "hybrid_diffusion_prefix_trunk_step"


def rmsnorm(x, g):
    xf = x.astype(jnp.float32)
    y = xf * lax.rsqrt(jnp.mean(xf * xf, axis=-1, keepdims=True) + EPS)
    return (y * g.astype(jnp.float32)).astype(x.dtype)


def ada_mod(cvec, w, b):
    m = jax.nn.silu(cvec) @ w + b
    return m.reshape(cvec.shape[0], N_MOD, 1, D_MODEL)


def modulate(x, g, shift, scale):
    return rmsnorm(x, g) * (1 + scale) + shift


def swiglu(h, w_gu, w_down):
    gt, up = jnp.split(h @ w_gu, 2, axis=-1)
    return (jax.nn.silu(gt) * up) @ w_down


def axial_rope(x, n_tokens):
    t = jnp.arange(n_tokens)
    row = (t // GRID_W).astype(jnp.float32)
    col = (t % GRID_W).astype(jnp.float32)
    half = HEAD_DIM // 2
    nf = half // 2
    inv = ROPE_BASE ** (-jnp.arange(nf, dtype=jnp.float32) / nf)

    def rot(xp, pos):
        ang = pos[:, None] * inv[None, :]
        cos, sin = jnp.cos(ang), jnp.sin(ang)
        x1, x2 = xp[..., :nf], xp[..., nf:]
        return jnp.concatenate([x1 * cos - x2 * sin, x1 * sin + x2 * cos], axis=-1)

    xf = x.astype(jnp.float32)
    out = jnp.concatenate([rot(xf[..., :half], row), rot(xf[..., half:], col)], axis=-1)
    return out.astype(x.dtype)


def sink_softmax(s, sink):
    m = jnp.max(s, axis=-1, keepdims=True)
    if sink is not None:
        m = jnp.maximum(m, sink)
    p = jnp.exp(s - m)
    den = jnp.sum(p, axis=-1, keepdims=True)
    if sink is not None:
        den = den + jnp.exp(sink - m)
    return p / den


def ctx_attention(q, k, v, sink):
    B, Hk, G, S, hd = q.shape
    nb = S // BLOCK
    qb = jnp.moveaxis(q.reshape(B, Hk, G, nb, BLOCK, hd), 3, 0)
    sk = None if sink is None else sink.astype(jnp.float32)[None, :, :, None, None]

    def one(qi):
        s = jnp.einsum('bkgqd,bkld->bkgql', qi, k).astype(jnp.float32) * ATTN_SCALE
        p = sink_softmax(s, sk).astype(v.dtype)
        return jnp.einsum('bkgql,bkld->bkgqd', p, v)

    out = lax.map(one, qb)
    return jnp.moveaxis(out, 0, 3).reshape(B, Hk, G, S, hd)


def window_attention(q, k, v, k_ctx, v_ctx, sink):
    B, Hk, G, S, hd = q.shape
    L = k_ctx.shape[2]
    nb = S // BLOCK
    kp = jnp.pad(k, ((0, 0), (0, 0), (BLOCK, BLOCK), (0, 0)))
    vp = jnp.pad(v, ((0, 0), (0, 0), (BLOCK, BLOCK), (0, 0)))
    qpos = jnp.arange(BLOCK)
    kpos = jnp.arange(3 * BLOCK) - BLOCK
    rel_ok = jnp.abs(kpos[None, :] - qpos[:, None]) <= WINDOW
    sk = sink.astype(jnp.float32)[None, :, :, None, None]

    def one(j):
        qi = lax.dynamic_slice_in_dim(q, j * BLOCK, BLOCK, axis=3)
        kb = lax.dynamic_slice_in_dim(kp, j * BLOCK, 3 * BLOCK, axis=2)
        vb = lax.dynamic_slice_in_dim(vp, j * BLOCK, 3 * BLOCK, axis=2)
        kabs = j * BLOCK + kpos
        valid = rel_ok & ((kabs >= 0) & (kabs < S))[None, :]
        s_loc = jnp.einsum('bkgqd,bkld->bkgql', qi, kb).astype(jnp.float32) * ATTN_SCALE
        s_loc = jnp.where(valid, s_loc, NEG)
        s_ctx = jnp.einsum('bkgqd,bkld->bkgql', qi, k_ctx).astype(jnp.float32) * ATTN_SCALE
        p = sink_softmax(jnp.concatenate([s_ctx, s_loc], axis=-1), sk).astype(v.dtype)
        return (jnp.einsum('bkgql,bkld->bkgqd', p[..., :L], v_ctx)
                + jnp.einsum('bkgql,bkld->bkgqd', p[..., L:], vb))

    out = lax.map(one, jnp.arange(nb))
    return jnp.moveaxis(out, 0, 3).reshape(B, Hk, G, S, hd)


def neighborhood_attention(q, k, v, k_ctx, v_ctx, rpb):
    B, H, S, hd = q.shape
    rows = S // GRID_W
    kr = min(NA_ROWS_MAX, rows)
    kcn = min(NA_COLS, GRID_W)
    cols = jnp.arange(GRID_W)
    cstart = jnp.clip(cols - kcn // 2, 0, GRID_W - kcn)
    col_idx = cstart[:, None] + jnp.arange(kcn)[None, :]
    dc = col_idx - cols[:, None]
    q_grid = q.reshape(B, H, rows, GRID_W, hd)
    k_grid = k.reshape(B, H, rows, GRID_W, hd)
    v_grid = v.reshape(B, H, rows, GRID_W, hd)
    rpb32 = rpb.astype(jnp.float32)

    def one(r):
        rs = jnp.clip(r - kr // 2, 0, rows - kr)
        k_rows = lax.dynamic_slice_in_dim(k_grid, rs, kr, axis=2)
        v_rows = lax.dynamic_slice_in_dim(v_grid, rs, kr, axis=2)
        k_nb = k_rows[:, :, :, col_idx]
        v_nb = v_rows[:, :, :, col_idx]
        qr = lax.dynamic_index_in_dim(q_grid, r, axis=2, keepdims=False)
        dr = rs + jnp.arange(kr) - r
        bias = rpb32[:, (dr + NA_ROWS_MAX - 1)[None, :, None], (dc + NA_COLS - 1)[:, None, :]]
        s_nb = jnp.einsum('bhqd,bhrqcd->bhqrc', qr, k_nb).astype(jnp.float32) * ATTN_SCALE + bias[None]
        s_nb = s_nb.reshape(B, H, GRID_W, kr * kcn)
        s_ctx = jnp.einsum('bhqd,bhld->bhql', qr, k_ctx).astype(jnp.float32) * ATTN_SCALE
        L = s_ctx.shape[-1]
        p = sink_softmax(jnp.concatenate([s_ctx, s_nb], axis=-1), None).astype(v.dtype)
        p_nb = p[..., L:].reshape(B, H, GRID_W, kr, kcn)
        return (jnp.einsum('bhql,bhld->bhqd', p[..., :L], v_ctx)
                + jnp.einsum('bhqrc,bhrqcd->bhqd', p_nb, v_nb))

    out = lax.map(one, jnp.arange(rows))
    return jnp.moveaxis(out, 0, 2).reshape(B, H, S, hd)


def even_mixer(h, w_in, g_sgu, w_sgu, b_sgu):
    B, S, _ = h.shape
    u, v, f = jnp.split(h @ w_in, [A_WIDTH, 2 * A_WIDTH], axis=-1)
    v = rmsnorm(v, g_sgu)
    nch = S // CHUNK
    vg = v.reshape(B, nch, CHUNK, A_GROUPS, A_GROUP_DIM)
    sp = jnp.einsum('gpq,bnqgc->bnpgc', w_sgu, vg) + b_sgu.T[None, None, :, :, None]
    a_out = u * sp.reshape(B, S, A_WIDTH)
    fb = f.reshape(B, S, B_GROUPS, B_GROUP_DIM).astype(jnp.float32)
    b_out = jnp.real(jnp.fft.fft2(fb, axes=(1, 3), norm='ortho')).astype(h.dtype).reshape(B, S, B_WIDTH)
    return jnp.concatenate([a_out, b_out], axis=-1)


def odd_heads(h, w_in, g_qc, g_kc, g_qd, g_kd):
    B, S, _ = h.shape
    qc, kc, vc, qd, kd, vd = jnp.split(
        h @ w_in, [C_Q, C_Q + C_KV, C_Q + 2 * C_KV, C_Q + 2 * C_KV + D_W, C_Q + 2 * C_KV + 2 * D_W], axis=-1)

    def heads(t, n):
        return t.reshape(B, S, n, HEAD_DIM).transpose(0, 2, 1, 3)

    return (rmsnorm(heads(qc, C_HEADS), g_qc), rmsnorm(heads(kc, C_KV_HEADS), g_kc), heads(vc, C_KV_HEADS),
            rmsnorm(heads(qd, D_HEADS), g_qd), rmsnorm(heads(kd, D_HEADS), g_kd), heads(vd, D_HEADS))


def merge_heads(oc, od):
    o = jnp.concatenate([oc, od], axis=1)
    B, H, S, hd = o.shape
    return o.transpose(0, 2, 1, 3).reshape(B, S, H * hd)


def odd_context(h, w_in, g_qc, g_kc, g_qd, g_kd, sink):
    B, S, _ = h.shape
    qc, kc, vc, qd, kd, vd = odd_heads(h, w_in, g_qc, g_kc, g_qd, g_kd)
    oc = ctx_attention(qc.reshape(B, C_KV_HEADS, C_GROUP, S, HEAD_DIM), kc, vc, sink.reshape(C_KV_HEADS, C_GROUP))
    od = ctx_attention(qd[:, :, None], kd, vd, None)
    return merge_heads(oc.reshape(B, C_HEADS, S, HEAD_DIM), od.reshape(B, D_HEADS, S, HEAD_DIM)), kc, vc, kd, vd


def odd_latent(h, k_ctx_c, v_ctx_c, k_ctx_d, v_ctx_d, w_in, g_qc, g_kc, g_qd, g_kd, sink, rpb):
    B, S, _ = h.shape
    qc, kc, vc, qd, kd, vd = odd_heads(h, w_in, g_qc, g_kc, g_qd, g_kd)
    qc = axial_rope(qc, S)
    kc = axial_rope(kc, S)
    oc = window_attention(qc.reshape(B, C_KV_HEADS, C_GROUP, S, HEAD_DIM), kc, vc, k_ctx_c, v_ctx_c,
                          sink.reshape(C_KV_HEADS, C_GROUP))
    od = neighborhood_attention(qd, kd, vd, k_ctx_d, v_ctx_d, rpb)
    return merge_heads(oc.reshape(B, C_HEADS, S, HEAD_DIM), od)


def setup_inputs(seed: int = 0) -> dict:
    key = jax.random.key(seed)
    ks = jax.random.split(key, 32)

    def nrm(k, shape, s):
        return jax.random.normal(k, shape, jnp.float32) * s

    def gain(k, shape):
        return 1.0 + 0.02 * jax.random.normal(k, shape, jnp.float32)

    return {
        "x_prompt": nrm(ks[0], (BATCH, SEQ, D_MODEL), 1.0),
        "x_sample": nrm(ks[1], (DEC_BATCH, DEC_SEQ, D_MODEL), 1.0),
        "c": nrm(ks[2], (DEC_BATCH, D_MODEL), 1.0),
        "cache_c_k": nrm(ks[3], (DEC_BATCH, N_ODD, C_KV_HEADS, PAST_LEN, HEAD_DIM), 1.0),
        "cache_c_v": nrm(ks[4], (DEC_BATCH, N_ODD, C_KV_HEADS, PAST_LEN, HEAD_DIM), 1.0),
        "cache_d_k": nrm(ks[5], (DEC_BATCH, N_ODD, D_HEADS, PAST_LEN, HEAD_DIM), 1.0),
        "cache_d_v": nrm(ks[6], (DEC_BATCH, N_ODD, D_HEADS, PAST_LEN, HEAD_DIM), 1.0),
        "c_ctx": nrm(ks[7], (D_MODEL,), 1.0),
        "w_ada": nrm(ks[8], (DEPTH, D_MODEL, N_MOD * D_MODEL), 0.5 * D_MODEL ** -0.5),
        "b_ada": nrm(ks[9], (DEPTH, N_MOD * D_MODEL), 0.02),
        "g_ffn1": gain(ks[10], (DEPTH, D_MODEL)),
        "w_ffn1_gu": nrm(ks[11], (DEPTH, D_MODEL, 2 * D_FF), D_MODEL ** -0.5),
        "w_ffn1_down": nrm(ks[12], (DEPTH, D_FF, D_MODEL), D_FF ** -0.5),
        "g_mix": gain(ks[13], (DEPTH, D_MODEL)),
        "w_mix_out": nrm(ks[14], (DEPTH, MIX_WIDTH, D_MODEL), MIX_WIDTH ** -0.5),
        "g_ffn2": gain(ks[15], (DEPTH, D_MODEL)),
        "w_ffn2_gu": nrm(ks[16], (DEPTH, D_MODEL, 2 * D_FF), D_MODEL ** -0.5),
        "w_ffn2_down": nrm(ks[17], (DEPTH, D_FF, D_MODEL), D_FF ** -0.5),
        "w_in_even": nrm(ks[18], (N_EVEN, D_MODEL, EVEN_IN), D_MODEL ** -0.5),
        "g_sgu": gain(ks[19], (N_EVEN, A_WIDTH)),
        "w_sgu": nrm(ks[20], (N_EVEN, A_GROUPS, CHUNK, CHUNK), CHUNK ** -0.5),
        "b_sgu": gain(ks[21], (N_EVEN, A_GROUPS, CHUNK)),
        "w_in_odd": nrm(ks[22], (N_ODD, D_MODEL, ODD_IN), D_MODEL ** -0.5),
        "g_q_c": gain(ks[23], (N_ODD, HEAD_DIM)),
        "g_k_c": gain(ks[24], (N_ODD, HEAD_DIM)),
        "g_q_d": gain(ks[25], (N_ODD, HEAD_DIM)),
        "g_k_d": gain(ks[26], (N_ODD, HEAD_DIM)),
        "sink_c": nrm(ks[27], (N_ODD, C_HEADS), 0.5),
        "rpb_d": nrm(ks[28], (N_ODD, D_HEADS, 2 * NA_ROWS_MAX - 1, 2 * NA_COLS - 1), 0.1),
    }


def reference(x_prompt, x_sample, c, cache_c_k, cache_c_v, cache_d_k, cache_d_v, c_ctx,
              w_ada, b_ada, g_ffn1, w_ffn1_gu, w_ffn1_down, g_mix, w_mix_out, g_ffn2, w_ffn2_gu, w_ffn2_down,
              w_in_even, g_sgu, w_sgu, b_sgu, w_in_odd, g_q_c, g_k_c, g_q_d, g_k_d, sink_c, rpb_d):
    xp = x_prompt
    xs = x_sample
    ck_list, cv_list, dk_list, dv_list = [], [], [], []
    for layer in range(DEPTH):
        mc = ada_mod(c_ctx[None, :], w_ada[layer], b_ada[layer])
        ml = ada_mod(c, w_ada[layer], b_ada[layer])
        xp = xp + 0.5 * mc[:, 2] * swiglu(modulate(xp, g_ffn1[layer], mc[:, 0], mc[:, 1]),
                                          w_ffn1_gu[layer], w_ffn1_down[layer])
        xs = xs + 0.5 * ml[:, 2] * swiglu(modulate(xs, g_ffn1[layer], ml[:, 0], ml[:, 1]),
                                          w_ffn1_gu[layer], w_ffn1_down[layer])
        hp = modulate(xp, g_mix[layer], mc[:, 3], mc[:, 4])
        hs = modulate(xs, g_mix[layer], ml[:, 3], ml[:, 4])
        if layer % 2 == 0:
            e = layer // 2
            op = even_mixer(hp, w_in_even[e], g_sgu[e], w_sgu[e], b_sgu[e])
            os_ = even_mixer(hs, w_in_even[e], g_sgu[e], w_sgu[e], b_sgu[e])
        else:
            o = layer // 2
            op, kc, vc, kd, vd = odd_context(hp, w_in_odd[o], g_q_c[o], g_k_c[o], g_q_d[o], g_k_d[o], sink_c[o])
            ck_list.append(kc)
            cv_list.append(vc)
            dk_list.append(kd)
            dv_list.append(vd)
            os_ = odd_latent(hs, cache_c_k[:, o], cache_c_v[:, o], cache_d_k[:, o], cache_d_v[:, o],
                             w_in_odd[o], g_q_c[o], g_k_c[o], g_q_d[o], g_k_d[o], sink_c[o], rpb_d[o])
        xp = xp + mc[:, 5] * (op @ w_mix_out[layer])
        xs = xs + ml[:, 5] * (os_ @ w_mix_out[layer])
        xp = xp + 0.5 * mc[:, 8] * swiglu(modulate(xp, g_ffn2[layer], mc[:, 6], mc[:, 7]),
                                          w_ffn2_gu[layer], w_ffn2_down[layer])
        xs = xs + 0.5 * ml[:, 8] * swiglu(modulate(xs, g_ffn2[layer], ml[:, 6], ml[:, 7]),
                                          w_ffn2_gu[layer], w_ffn2_down[layer])
    state_c_k = jnp.stack(ck_list, axis=1)
    state_c_v = jnp.stack(cv_list, axis=1)
    state_d_k = jnp.stack(dk_list, axis=1)
    state_d_v = jnp.stack(dv_list, axis=1)
    return (xp, xs, state_c_k, state_c_v, state_d_k, state_d_v)
```

```cpp
#include <hip/hip_runtime.h>
#include <cstdio>
#include <cstdint>

#define LAS __attribute__((address_space(3)))
#define GAS __attribute__((address_space(1)))
typedef unsigned short bf16_t;
typedef short bf16x8 __attribute__((ext_vector_type(8)));
typedef short s16x4 __attribute__((ext_vector_type(4)));
typedef float f32x2 __attribute__((ext_vector_type(2)));
typedef float f32x4 __attribute__((ext_vector_type(4)));
typedef float f32x8 __attribute__((ext_vector_type(8)));
typedef float f32x16 __attribute__((ext_vector_type(16)));
typedef unsigned u32x2 __attribute__((ext_vector_type(2)));
typedef unsigned u32x4 __attribute__((ext_vector_type(4)));

constexpr int DM = 2048, MP = 8192, MS = 2048, MTOT = 10240, DFF = 5504, NGU = 11008, NIN_E = 3072, NIN_O = 4608, NMODV = 18432;
constexpr float EPS = 1e-6f;
constexpr int NWAVES = 8, NTHR = 512;

constexpr size_t MiB = 1u << 20;
constexpr size_t WS_CTL = 0, CTL_ZERO_BYTES = 64 * 1024;
constexpr size_t WS_MODS = 1 * MiB;
constexpr size_t WS_ADAP = 2 * MiB;
constexpr size_t WS_SSQ = 6 * MiB;
constexpr size_t WS_T256 = 7 * MiB;
constexpr size_t WS_ROPE = WS_T256 + 262144;
constexpr size_t WS_WSGU = 8 * MiB;
constexpr size_t WS_CS1024 = 9 * MiB;
constexpr size_t WS_CS256 = 23 * MiB;
constexpr size_t WS_CCK = 13 * MiB;
constexpr size_t WS_CCV = 14 * MiB, WS_CDK = 15 * MiB, WS_CDV = 19 * MiB;
constexpr size_t WS_H = 24 * MiB;
constexpr size_t WS_ACT = 64 * MiB;
constexpr size_t WS_MIXIN = 172 * MiB;
constexpr size_t WS_MIXOUT = 262 * MiB;
constexpr size_t WS_SLAB = 302 * MiB;
constexpr size_t WS_GT = 366 * MiB;
constexpr size_t WS_GTS = WS_GT + 128 * MiB;
constexpr size_t WS_QKV = 366 * MiB;
constexpr size_t WS_W = 502 * MiB;
constexpr size_t W_GU1 = 0, W_DN1 = (size_t)NGU * DM, W_GU2 = W_DN1 + (size_t)DM * DFF, W_DN2 = W_GU2 + (size_t)NGU * DM, W_OUT = W_DN2 + (size_t)DM * DFF,
                 W_IN = W_OUT + (size_t)DM * DM, W_LAYER = W_IN + (size_t)NIN_O * DM;
constexpr size_t WS_END = WS_W + 4 * W_LAYER * 2;
constexpr size_t Q_QCP = 0, Q_KCP = Q_QCP + (size_t)MP * 1024, Q_VCP = Q_KCP + (size_t)MP * 256, Q_QDP = Q_VCP + (size_t)MP * 256, Q_KDP = Q_QDP + (size_t)MP * 1024,
                 Q_VDP = Q_KDP + (size_t)MP * 1024, Q_QCS = Q_VDP + (size_t)MP * 1024, Q_KCS = Q_QCS + (size_t)MS * 1024, Q_VCS = Q_KCS + (size_t)MS * 256,
                 Q_QDS = Q_VCS + (size_t)MS * 256, Q_KDS = Q_QDS + (size_t)MS * 1024, Q_VDS = Q_KDS + (size_t)MS * 1024, Q_END = Q_VDS + (size_t)MS * 1024;
static_assert(WS_QKV + Q_END * 2 <= WS_W, "qkv region");
constexpr size_t O_YP = 0, O_YS = (size_t)MP * DM, O_SCK = O_YS + (size_t)MS * DM, O_SCV = O_SCK + (size_t)32 * 2 * 2 * 256 * 128, O_SDK = O_SCV + (size_t)32 * 2 * 2 * 256 * 128,
                 O_SDV = O_SDK + (size_t)32 * 2 * 8 * 256 * 128, O_END = O_SDV + (size_t)32 * 2 * 8 * 256 * 128;

constexpr int LDS_BYTES = 147456;
constexpr int LDS_MISC = 135168;

#define LDS_WAIT() asm volatile("s_waitcnt lgkmcnt(0)" ::: "memory")
#define VM_WAIT() asm volatile("s_waitcnt vmcnt(0)" ::: "memory")
__device__ __forceinline__ unsigned f2bf(float f) { unsigned u = __builtin_bit_cast(unsigned, f); return (u + 0x7fffu + ((u >> 16) & 1u)) >> 16; }
__device__ __forceinline__ unsigned pk2(float lo, float hi) { return f2bf(lo) | (f2bf(hi) << 16); }
__device__ __forceinline__ unsigned cvt_pk_bf16(float lo, float hi) { unsigned r; asm volatile("v_cvt_pk_bf16_f32 %0, %1, %2" : "=v"(r) : "v"(lo), "v"(hi)); return r; }
__device__ __forceinline__ float bf_lo(unsigned w) { return __uint_as_float(w << 16); }
__device__ __forceinline__ float bf_hi(unsigned w) { return __uint_as_float(w & 0xffff0000u); }
__device__ __forceinline__ int ptid(int wv) { int t = wv * 64 + (int)__builtin_amdgcn_mbcnt_hi(~0u, __builtin_amdgcn_mbcnt_lo(~0u, 0u)); asm volatile("" : "+v"(t)); return t; }
__device__ __forceinline__ int obid() { int b = (int)blockIdx.x; asm volatile("" : "+s"(b)); return b; }
__device__ __forceinline__ float wave_sum(float v) {
#pragma unroll
    for (int o = 1; o < 64; o <<= 1) v += __shfl_xor(v, o);
    return v;
}

#define XB_TMO      128
#define XB_XCNT(j)  (256  + 64 * (j))
#define XB_XSUB(j)  (1280 + 64 * (j))
#define XB_XGEN(j)  (2304 + 64 * (j))
#define XB_TOP      3328
#define XB_TOPGEN   3392
#define XCD_BAR_WORDS 3456
#define XB_SPIN_CAP (1u << 18)
__device__ __forceinline__ unsigned xb_ld(unsigned* p)              { return __hip_atomic_load(p, __ATOMIC_RELAXED, __HIP_MEMORY_SCOPE_AGENT); }
__device__ __forceinline__ unsigned xb_add(unsigned* p, unsigned v) { return __hip_atomic_fetch_add(p, v, __ATOMIC_RELAXED, __HIP_MEMORY_SCOPE_AGENT); }
__device__ __forceinline__ unsigned xb_xcc_id() { return (unsigned)__builtin_amdgcn_s_getreg((3 << 11) | 20) & 0xFu; }
#define XB_SPIN(cond, bar) do { unsigned _sp = 0; while (cond) { __builtin_amdgcn_s_sleep(1); \
    if ((++_sp & 255u) == 0u) { if (xb_ld(&(bar)[XB_TMO])) break; if (_sp > XB_SPIN_CAP) { atomicAdd(&(bar)[XB_TMO], 1u); break; } } } } while (0)
struct XcdBarrier { unsigned* bar; unsigned x; volatile LAS unsigned* st; };
__device__ __forceinline__ XcdBarrier xcd_barrier_post(unsigned* bar, volatile LAS unsigned* st, int tid) {
    XcdBarrier b; b.bar = bar; b.x = 0; b.st = st;
    if (tid == 0) (void)xb_add(&bar[XB_XCNT(xb_xcc_id())], 1u);
    return b;
}
__device__ __forceinline__ void xcd_barrier_complete(unsigned* bar, unsigned x, unsigned& nloc, unsigned& nx) {
    const unsigned G = gridDim.x * gridDim.y * gridDim.z;
    unsigned sum, cnt, mine, sp = 0u;
    for (;;) {
        sum = 0u; cnt = 0u; mine = 0u;
#pragma unroll
        for (unsigned j = 0; j < 16; ++j) { const unsigned c = xb_ld(&bar[XB_XCNT(j)]); sum += c; cnt += (c > 0u) ? 1u : 0u; mine = (j == x) ? c : mine; }
        if (sum == G) break;
        __builtin_amdgcn_s_sleep(1);
        if ((++sp & 255u) == 0u) { if (xb_ld(&bar[XB_TMO])) break; if (sp > XB_SPIN_CAP) { atomicAdd(&bar[XB_TMO], 1u); break; } }
    }
    nloc = mine > 0u ? mine : 1u; nx = cnt > 0u ? cnt : 1u;
}
__device__ __forceinline__ void xcd_barrier(const XcdBarrier& b, int wv) {
    asm volatile("s_waitcnt vmcnt(0)" ::: "memory");
    __syncthreads();
    if (ptid(wv) == 0) {
        unsigned* bar = b.bar; const unsigned bx = xb_xcc_id();
        __builtin_amdgcn_s_waitcnt(0);
        unsigned nloc = b.st[0], nx = b.st[1];
        if (nloc == 0u) { xcd_barrier_complete(bar, bx, nloc, nx); b.st[0] = nloc; b.st[1] = nx; }
        const unsigned old = xb_add(&bar[XB_XSUB(bx)], 1u);
        const unsigned gen = old / nloc;
        if (old + 1u == (gen + 1u) * nloc) {
            __builtin_amdgcn_fence(__ATOMIC_RELEASE, "agent");
            asm volatile("s_waitcnt vmcnt(0)" ::: "memory");
            const unsigned og = xb_add(&bar[XB_TOP], 1u);
            const unsigned tg = og / nx;
            if (og + 1u == (tg + 1u) * nx) xb_add(&bar[XB_TOPGEN], 1u);
            else XB_SPIN(xb_ld(&bar[XB_TOPGEN]) == tg, bar);
            __builtin_amdgcn_fence(__ATOMIC_ACQUIRE, "agent");
            xb_add(&bar[XB_XGEN(bx)], 1u);
            asm volatile("s_waitcnt vmcnt(0)" ::: "memory");
        } else {
            XB_SPIN(xb_ld(&bar[XB_XGEN(bx)]) == gen, bar);
            __builtin_amdgcn_fence(__ATOMIC_ACQUIRE, "agent");
            asm volatile("s_waitcnt vmcnt(0)" ::: "memory");
        }
    }
    __syncthreads();
}

namespace pg8 {
constexpr int BM = 256, BK = 64, HALF = 128, HTB = HALF * BK * 2, STAGE_BYTES = 8 * HTB;
__device__ __forceinline__ int lds_byte(int r, int c) { const int st = (r >> 4) * 2 + (c >> 5), rr = r & 15, cc = c & 31, ob = rr * 64 + cc * 2; return st * 1024 + (ob ^ (((ob >> 9) & 1) << 5)); }
__device__ __forceinline__ void stage_rc(int b, int& R, int& C) { const int st = b / 1024, sb = b % 1024, swz = sb ^ (((sb >> 9) & 1) << 5); R = (st >> 1) * 16 + swz / 64; C = (st & 1) * 32 + (swz % 64) / 2; }
__device__ __forceinline__ int perm32(int rho) { const int n = rho >> 4, i = rho & 15; return 8 * (i >> 2) + 4 * n + (i & 3); }

struct GUnit { const char* a; const char* b; int nt; int pm, pn, ks; };

template <class Epi, class Sched, bool ALIGN_EPI, bool SP2>
__device__ __forceinline__ void gemm_phase(LAS unsigned char* lds, const Sched& S, const Epi& E, int wv) {
    const int tid = ptid(wv);
    const int wid = wv, lane = tid & 63, wr = wid >> 2, wc = wid & 3, fr = lane & 15, fq = lane >> 4;
    unsigned cvA0, cvA1, cvB0, cvB1;
    { int R0, C0, R1, C1; stage_rc(tid * 16, R0, C0); stage_rc(tid * 16 + 8192, R1, C1);
      const int Rb0 = Epi::PERM ? ((R0 & ~31) + perm32(R0 & 31)) : R0, Rb1 = Epi::PERM ? ((R1 & ~31) + perm32(R1 & 31)) : R1;
      cvA0 = (unsigned)(R0 * S.lda2 + C0 * 2); cvA1 = (unsigned)(R1 * S.lda2 + C1 * 2); cvB0 = (unsigned)(Rb0 * S.ldb2 + C0 * 2); cvB1 = (unsigned)(Rb1 * S.ldb2 + C1 * 2); }
    const unsigned ldsw = (unsigned)wid * 1024u;
    const int aoff = lds_byte(wr * 64 + fr, fq * 8), boff = lds_byte(wc * 32 + fr, fq * 8);
#define PG8_SA(b, h) (((b) * 2 + (h)) * HTB)
#define PG8_SB(b, h) ((4 + (b) * 2 + (h)) * HTB)
#define PG8_STAGE(bufoff, gbase, v0, v1) do { \
        __builtin_amdgcn_global_load_lds((const unsigned*)((const char*)(gbase) + (v0)), (LAS unsigned*)(lds + (bufoff) + ldsw), 16, 0, 0); \
        __builtin_amdgcn_global_load_lds((const unsigned*)((const char*)(gbase) + (v1)), (LAS unsigned*)(lds + (bufoff) + ldsw + 8192), 16, 0, 0); } while (0)
#define PG8_LDA(dst, b, h) do { _Pragma("unroll") for (int m = 0; m < 4; ++m) _Pragma("unroll") for (int k = 0; k < 2; ++k) dst[m][k] = *(const LAS bf16x8*)(lds + PG8_SA(b, h) + aoff + m * 2048 + k * 1024); } while (0)
#define PG8_LDB(dst, b, h) do { _Pragma("unroll") for (int n = 0; n < 2; ++n) _Pragma("unroll") for (int k = 0; k < 2; ++k) dst[n][k] = *(const LAS bf16x8*)(lds + PG8_SB(b, h) + boff + n * 2048 + k * 1024); } while (0)
#define PG8_MMA(ai, bj, At, Bt) do { __builtin_amdgcn_s_setprio(1); _Pragma("unroll") for (int m = 0; m < 4; ++m) _Pragma("unroll") for (int n = 0; n < 2; ++n) _Pragma("unroll") for (int k = 0; k < 2; ++k) \
        acc[ai][bj][m][n] = __builtin_amdgcn_mfma_f32_16x16x32_bf16(Bt[n][k], At[m][k], acc[ai][bj][m][n], 0, 0, 0); __builtin_amdgcn_s_setprio(0); } while (0)
#define PG8_WAIT_V(n) asm volatile("s_waitcnt vmcnt(" #n ")" ::: "memory")
#define PG8_WAIT_L(n) asm volatile("s_waitcnt lgkmcnt(" #n ")" ::: "memory")
#define PG8_BAR __builtin_amdgcn_s_barrier()
#define PG8_SCHED __builtin_amdgcn_sched_barrier(0)
    GUnit cur, nxt; int ui = 0;
    if (!S.next(0, cur)) return;
    f32x4 acc[2][2][4][2];
#pragma unroll
    for (int a = 0; a < 2; ++a)
#pragma unroll
        for (int b = 0; b < 2; ++b)
#pragma unroll
            for (int m = 0; m < 4; ++m)
#pragma unroll
                for (int n = 0; n < 2; ++n) acc[a][b][m][n] = (f32x4){0.f, 0.f, 0.f, 0.f};
    bf16x8 At[4][2], B0[2][2], B1[2][2];
    const size_t chA = (size_t)HALF * S.lda2, chB = (size_t)HALF * S.ldb2;
    const size_t kstep = (size_t)(BK * 2);
    const char* cA = cur.a; const char* cB = cur.b;
    if constexpr (SP2) {
        PG8_STAGE(PG8_SB(0, 0), cB, cvB0, cvB1); PG8_STAGE(PG8_SB(0, 1), cB + chB, cvB0, cvB1); PG8_STAGE(PG8_SA(0, 0), cA, cvA0, cvA1); PG8_STAGE(PG8_SA(0, 1), cA + chA, cvA0, cvA1);
        if (wr == 1) PG8_BAR;
        PG8_WAIT_V(2); PG8_BAR;
        PG8_STAGE(PG8_SB(1, 0), cB + kstep, cvB0, cvB1); PG8_STAGE(PG8_SA(1, 0), cA + kstep, cvA0, cvA1); PG8_STAGE(PG8_SB(1, 1), cB + chB + kstep, cvB0, cvB1);
        PG8_WAIT_V(6); PG8_BAR;
    } else {
        PG8_STAGE(PG8_SB(0, 0), cB, cvB0, cvB1); PG8_STAGE(PG8_SA(0, 0), cA, cvA0, cvA1); PG8_STAGE(PG8_SB(0, 1), cB + chB, cvB0, cvB1); PG8_STAGE(PG8_SA(0, 1), cA + chA, cvA0, cvA1);
        if (wr == 1) PG8_BAR;
        PG8_WAIT_V(4); PG8_BAR;
        PG8_STAGE(PG8_SB(1, 0), cB + kstep, cvB0, cvB1); PG8_STAGE(PG8_SA(1, 0), cA + kstep, cvA0, cvA1); PG8_STAGE(PG8_SB(1, 1), cB + chB + kstep, cvB0, cvB1);
        PG8_WAIT_V(6); PG8_BAR;
    }
    for (;;) {
        const bool has_next = S.next(ui + 1, nxt);
        const char* nA = has_next ? nxt.a : cA; const char* nB = has_next ? nxt.b : cB;
        int nt = cur.nt; asm volatile("" : "+s"(nt));
        for (int t = 0; t < nt; t += 2) {
            const bool last = (t == nt - 2);
            const char* a1 = cA + (size_t)(t + 1) * kstep;
            const char* a2 = last ? nA : cA + (size_t)(t + 2) * kstep; const char* b2 = last ? nB : cB + (size_t)(t + 2) * kstep;
            const char* a3 = a2 + kstep; const char* b3 = b2 + kstep;
            if constexpr (SP2) {
            PG8_LDB(B0, 0, 0); PG8_LDB(B1, 0, 1); PG8_SCHED; PG8_LDA(At, 0, 0); PG8_STAGE(PG8_SA(1, 1), a1 + chA, cvA0, cvA1);
            PG8_WAIT_V(8); PG8_WAIT_L(0); PG8_BAR; PG8_MMA(0, 0, At, B0); PG8_MMA(0, 1, At, B1); PG8_BAR; PG8_SCHED;
            PG8_LDA(At, 0, 1); PG8_STAGE(PG8_SB(0, 0), b2, cvB0, cvB1); PG8_STAGE(PG8_SB(0, 1), b2 + chB, cvB0, cvB1); PG8_STAGE(PG8_SA(0, 0), a2, cvA0, cvA1);
            PG8_WAIT_V(8); PG8_WAIT_L(0); PG8_BAR; PG8_MMA(1, 0, At, B0); PG8_MMA(1, 1, At, B1); PG8_BAR; PG8_SCHED;
            PG8_LDB(B0, 1, 0); PG8_LDB(B1, 1, 1); PG8_SCHED; PG8_LDA(At, 1, 0); PG8_STAGE(PG8_SA(0, 1), a2 + chA, cvA0, cvA1);
            PG8_WAIT_V(8); PG8_WAIT_L(0); PG8_BAR; PG8_MMA(0, 0, At, B0); PG8_MMA(0, 1, At, B1); PG8_BAR; PG8_SCHED;
            PG8_LDA(At, 1, 1); PG8_STAGE(PG8_SB(1, 0), b3, cvB0, cvB1); PG8_STAGE(PG8_SB(1, 1), b3 + chB, cvB0, cvB1); PG8_STAGE(PG8_SA(1, 0), a3, cvA0, cvA1);
            PG8_WAIT_V(8); PG8_WAIT_L(0); PG8_BAR; PG8_MMA(1, 0, At, B0); PG8_MMA(1, 1, At, B1); PG8_BAR; PG8_SCHED;
            } else {
            PG8_LDB(B0, 0, 0); PG8_SCHED; PG8_LDA(At, 0, 0); PG8_STAGE(PG8_SA(1, 1), a1 + chA, cvA0, cvA1);
            PG8_WAIT_L(8); PG8_BAR; PG8_WAIT_L(0); PG8_MMA(0, 0, At, B0); PG8_BAR; PG8_SCHED;
            PG8_LDB(B1, 0, 1); PG8_STAGE(PG8_SB(0, 0), b2, cvB0, cvB1);
            PG8_BAR; PG8_WAIT_L(0); PG8_MMA(0, 1, At, B1); PG8_BAR;
            PG8_LDA(At, 0, 1); PG8_STAGE(PG8_SA(0, 0), a2, cvA0, cvA1);
            PG8_BAR; PG8_WAIT_L(0); PG8_MMA(1, 0, At, B0); PG8_BAR; PG8_SCHED;
            PG8_STAGE(PG8_SB(0, 1), b2 + chB, cvB0, cvB1);
            PG8_WAIT_V(6); PG8_BAR; PG8_MMA(1, 1, At, B1); PG8_BAR;
            PG8_LDB(B0, 1, 0); PG8_SCHED; PG8_LDA(At, 1, 0); PG8_STAGE(PG8_SA(0, 1), a2 + chA, cvA0, cvA1);
            PG8_WAIT_L(8); PG8_BAR; PG8_WAIT_L(0); PG8_MMA(0, 0, At, B0); PG8_BAR; PG8_SCHED;
            PG8_LDB(B1, 1, 1); PG8_STAGE(PG8_SB(1, 0), b3, cvB0, cvB1);
            PG8_BAR; PG8_WAIT_L(0); PG8_MMA(0, 1, At, B1); PG8_BAR;
            PG8_LDA(At, 1, 1); PG8_STAGE(PG8_SA(1, 0), a3, cvA0, cvA1);
            PG8_BAR; PG8_WAIT_L(0); PG8_MMA(1, 0, At, B0); PG8_BAR; PG8_SCHED;
            PG8_STAGE(PG8_SB(1, 1), b3 + chB, cvB0, cvB1);
            PG8_WAIT_V(6); PG8_BAR; PG8_MMA(1, 1, At, B1); PG8_BAR;
            }
        }
        if constexpr (ALIGN_EPI) { if (wr == 0) PG8_BAR; }
        E(acc, cur, S, wr, wc, fr, fq);
        if (!has_next) break;
#pragma unroll
        for (int a = 0; a < 2; ++a)
#pragma unroll
            for (int b = 0; b < 2; ++b)
#pragma unroll
                for (int m = 0; m < 4; ++m)
#pragma unroll
                    for (int n = 0; n < 2; ++n) acc[a][b][m][n] = (f32x4){0.f, 0.f, 0.f, 0.f};
        cur = nxt; cA = nA; cB = nB; ++ui;
        if constexpr (ALIGN_EPI) { if (wr == 1) PG8_BAR; }
    }
    PG8_WAIT_V(0);
    if constexpr (!ALIGN_EPI) { if (wr == 0) PG8_BAR; }
    PG8_BAR;
#undef PG8_SA
#undef PG8_SB
#undef PG8_STAGE
#undef PG8_LDA
#undef PG8_LDB
#undef PG8_MMA
#undef PG8_WAIT_V
#undef PG8_WAIT_L
#undef PG8_BAR
#undef PG8_SCHED
}

struct SchedStd {
    const char* A; const char* Bt; int lda2, ldb2, nt; int nM, nN, nwg, G, c; char* O; int ldc, otile;
    __device__ __forceinline__ bool next(int i, GUnit& u) const {
        const long L = (long)i * G + c; if (L >= nwg) return false;
        int wgid = (int)L; { const int q = nwg / 8, r = nwg % 8, xcd = wgid % 8, off = wgid / 8; wgid = (xcd < r ? xcd * (q + 1) : r * (q + 1) + (xcd - r) * q) + off; }
        const int nig = 8 * nN, gid = wgid / nig, fm = gid * 8, gsz = (nM - fm) < 8 ? (nM - fm) : 8;
        u.pm = fm + ((wgid % nig) % gsz); u.pn = (wgid % nig) / gsz; u.ks = -1;
        u.a = A + (size_t)u.pm * 256 * lda2; u.b = Bt + (size_t)u.pn * 256 * ldb2; u.nt = nt;
        return true;
    }
    __device__ __forceinline__ void out(const GUnit& u, char*& o, int& ld) const { o = O + ((size_t)u.pm * 256 * ldc + (size_t)u.pn * otile) * 2; ld = ldc; }
};
struct SchedSplit {
    const char* A; const char* Bt; int lda2, ldb2, ntot, kq; int G, c;
    __device__ __forceinline__ bool next(int i, GUnit& u) const {
        const int L = i * G + c; if (L >= 512) return false;
        const int Lr = L & 255, x = Lr & 7, j = Lr >> 3; int kt0 = 0;
        if (L < 256) { u.pm = 4 * x + (j >> 3); u.pn = j & 7; u.ks = -1; u.nt = ntot; }
        else { u.pm = 32 + x; u.pn = j & 7; u.ks = j >> 3; kt0 = u.ks * kq; u.nt = (u.ks < 3) ? kq : ntot - 3 * kq; }
        u.a = A + (size_t)u.pm * 256 * lda2 + (size_t)kt0 * 128; u.b = Bt + (size_t)u.pn * 256 * ldb2 + (size_t)kt0 * 128;
        return true;
    }
};
struct SchedF1 {
    const char* T; const char* mixin; char* gtp; char* gts; int lda2, ldb2; int G, c;
    __device__ __forceinline__ bool next(int i, GUnit& u) const {
        const int L = i * G + c; if (L >= 320) return false;
        u.nt = 4; u.ks = L;
        if (L < 256) { const int bg = L >> 1, b = bg >> 2, g = bg & 3; u.pm = L & 1; u.pn = 0;
            u.b = mixin + ((size_t)(b * 256) * NIN_E + 2048 + g * 256) * 2; }
        else { const int l2 = L - 256, bg = l2 >> 3, b = bg >> 2, g = bg & 3; u.pm = (l2 >> 2) & 1; u.pn = l2 & 3;
            u.b = mixin + ((size_t)(MP + b * 1024 + u.pn * 256) * NIN_E + 2048 + g * 256) * 2; }
        u.a = T + (size_t)u.pm * 256 * 512;
        return true;
    }
    __device__ __forceinline__ void out(const GUnit& u, char*& o, int& ld) const { const int L = u.ks; ld = 2048;
        if (L < 256) o = gtp + ((size_t)(L >> 1) * 256 * 2048 + (size_t)u.pm * 256) * 2;
        else o = gts + ((size_t)((L - 256) >> 3) * 256 * 2048 + (size_t)u.pm * 1024 + u.pn * 256) * 2; }
};
struct SchedF2 {
    const char* cs256; const char* cs1024; const char* gtp; const char* gts; char* mixout; int lda2, ldb2; int G, c;
    __device__ __forceinline__ bool next(int i, GUnit& u) const {
        const int L = i * G + c; if (L >= 160) return false;
        u.ks = L; u.pn = 0;
        if (L < 32) { const int bg = L >> 2; u.pm = L & 3; u.nt = 32; u.a = cs1024 + (size_t)u.pm * 256 * 4096; u.b = gts + (size_t)bg * 256 * 2048 * 2; }
        else { const int bg = L - 32; u.pm = 0; u.nt = 8; u.a = cs256; u.b = gtp + (size_t)bg * 256 * 2048 * 2; }
        return true;
    }
    __device__ __forceinline__ void out(const GUnit& u, char*& o, int& ld) const { const int L = u.ks; ld = DM;
        if (L < 32) { const int bg = L >> 2, b = bg >> 2, g = bg & 3; o = mixout + ((size_t)(MP + b * 1024 + u.pm * 256) * DM + 1024 + g * 256) * 2; }
        else { const int bg = L - 32, b = bg >> 2, g = bg & 3; o = mixout + ((size_t)(b * 256) * DM + 1024 + g * 256) * 2; } }
};

struct EpiBf16 {
    static constexpr bool PERM = true;
    float scale; float* ssq;
    template <class Sched>
    __device__ __forceinline__ void operator()(const f32x4 (&acc)[2][2][4][2], const GUnit& u, const Sched& S, int wr, int wc, int fr, int fq) const {
        char* o; int ldc; S.out(u, o, ldc); bf16_t* T = (bf16_t*)o;
        const unsigned off0 = (unsigned)((wr * 64 + fr) * ldc + wc * 32 + 8 * fq);
        const bool do_ssq = (ssq != nullptr) && (u.pn >= 4) && (u.pn < 8);
#pragma unroll
        for (int ai = 0; ai < 2; ++ai)
#pragma unroll
            for (int m = 0; m < 4; ++m) { const unsigned off = off0 + (unsigned)((ai * HALF + m * 16) * ldc); float s = 0.f;
#pragma unroll
                for (int bj = 0; bj < 2; ++bj) { const f32x4 v0 = acc[ai][bj][m][0] * scale, v1 = acc[ai][bj][m][1] * scale;
                    s += (v0[0] * v0[0] + v0[1] * v0[1]) + (v0[2] * v0[2] + v0[3] * v0[3]) + (v1[0] * v1[0] + v1[1] * v1[1]) + (v1[2] * v1[2] + v1[3] * v1[3]);
                    u32x4 w; w.x = cvt_pk_bf16(v0[0], v0[1]); w.y = cvt_pk_bf16(v0[2], v0[3]); w.z = cvt_pk_bf16(v1[0], v1[1]); w.w = cvt_pk_bf16(v1[2], v1[3]);
                    *(u32x4*)(T + off + bj * HALF) = w; }
                if (do_ssq) { s += __shfl_xor(s, 16); s += __shfl_xor(s, 32);
                    if (fq == 0) ssq[(size_t)(u.pm * 256 + ai * HALF + wr * 64 + m * 16 + fr) * 16 + (u.pn - 4) * 4 + wc] = s; } }
    }
};
struct EpiF2 { static constexpr bool PERM = true;
    template <class Sched>
    __device__ __forceinline__ void operator()(const f32x4 (&acc)[2][2][4][2], const GUnit& u, const Sched& S, int wr, int wc, int fr, int fq) const {
        EpiBf16 e{u.nt == 32 ? 1.0f / 512.0f : 1.0f / 256.0f, nullptr}; e(acc, u, S, wr, wc, fr, fq); } };
struct EpiGU {
    static constexpr bool PERM = true;
    template <class Sched>
    __device__ __forceinline__ void operator()(const f32x4 (&acc)[2][2][4][2], const GUnit& u, const Sched& S, int wr, int wc, int fr, int fq) const {
        char* o; int ldc; S.out(u, o, ldc); bf16_t* T = (bf16_t*)o;
        const unsigned off0 = (unsigned)((wr * 64 + fr) * ldc + wc * 32 + 8 * fq);
#pragma unroll
        for (int ai = 0; ai < 2; ++ai)
#pragma unroll
            for (int m = 0; m < 4; ++m) { const unsigned off = off0 + (unsigned)((ai * HALF + m * 16) * ldc); float r[8];
#pragma unroll
                for (int n = 0; n < 2; ++n)
#pragma unroll
                    for (int j = 0; j < 4; ++j) { const float g = acc[ai][0][m][n][j], up = acc[ai][1][m][n][j];
                        const float sg = g * __builtin_amdgcn_rcpf(1.0f + __builtin_amdgcn_exp2f(-1.4426950408889634f * g)); r[n * 4 + j] = sg * up; }
                u32x4 w; w.x = cvt_pk_bf16(r[0], r[1]); w.y = cvt_pk_bf16(r[2], r[3]); w.z = cvt_pk_bf16(r[4], r[5]); w.w = cvt_pk_bf16(r[6], r[7]);
                *(u32x4*)(T + off) = w; }
    }
};
struct EpiResid {
    static constexpr bool PERM = false;
    float* x; const float* gate; float coef; float* slab;
    template <class Sched>
    __device__ __forceinline__ void operator()(const f32x4 (&acc)[2][2][4][2], const GUnit& u, const Sched& S, int wr, int wc, int fr, int fq) const {
        const unsigned off0 = (unsigned)((wr * 64 + fr) * DM + wc * 32 + 4 * fq);
        if (u.ks < 0) {
            float* T = x + (size_t)u.pm * BM * DM + u.pn * BM; const float* gt = gate + u.pn * BM + wc * 32 + 4 * fq;
            f32x4 gv[2][2];
#pragma unroll
            for (int bj = 0; bj < 2; ++bj)
#pragma unroll
                for (int n = 0; n < 2; ++n) gv[bj][n] = *(const f32x4*)(gt + bj * HALF + n * 16) * coef;
#pragma unroll
            for (int ai = 0; ai < 2; ++ai)
#pragma unroll
                for (int m = 0; m < 4; ++m) { const unsigned off = off0 + (unsigned)((ai * HALF + m * 16) * DM);
#pragma unroll
                    for (int bj = 0; bj < 2; ++bj)
#pragma unroll
                        for (int n = 0; n < 2; ++n) { f32x4* p = (f32x4*)(T + off + bj * HALF + n * 16); *p = *p + gv[bj][n] * acc[ai][bj][m][n]; }
                    if (m & 1) asm volatile("" ::: "memory"); }
        } else {
            float* T = slab + (size_t)u.ks * MS * DM + (size_t)(u.pm - 32) * BM * DM + u.pn * BM;
#pragma unroll
            for (int ai = 0; ai < 2; ++ai)
#pragma unroll
                for (int m = 0; m < 4; ++m) { const unsigned off = off0 + (unsigned)((ai * HALF + m * 16) * DM);
#pragma unroll
                    for (int bj = 0; bj < 2; ++bj)
#pragma unroll
                        for (int n = 0; n < 2; ++n) *(f32x4*)(T + off + bj * HALF + n * 16) = acc[ai][bj][m][n]; }
        }
    }
};
}

namespace att {
constexpr int D = 128, QBLK = 32, KVBLK = 64;
constexpr float SCALE = 0.088388347648318440f;
constexpr float THR = 8.f;
constexpr float NEG = -1e30f;
constexpr size_t SHM_V = KVBLK * D * 2, SHM_K = KVBLK * D * 2, SHM_ATTN = 2 * SHM_V + 2 * SHM_K + 8 * 64 * 4;
constexpr int RPB_OFF = (int)SHM_ATTN;
#define KSWZ(row, colB) ((row) * 256 + ((colB) ^ (((row) & 7) << 4)))
#define SBAR() __builtin_amdgcn_sched_barrier(0)
__device__ __forceinline__ int crow(int r, int hi) { return (r & 3) + 8 * (r >> 2) + 4 * hi; }

struct AUnit { const bf16_t* Q; bf16_t* O; const bf16_t* Kc; const bf16_t* Vc; const bf16_t* Kl; const bf16_t* Vl; int nctx, nloc, nt, mode, q0, kt0; float m0, l0; const float* rpb; };

__device__ __forceinline__ void partialSM(f32x16& p0, f32x16& p1, float& m_reg, float& mn, float& alpha) {
  constexpr float C = SCALE * 1.4426950408889634f;
  float pmax = p0[0];
#pragma unroll
  for (int r = 1; r < 16; ++r) pmax = fmaxf(pmax, p0[r]);
#pragma unroll
  for (int r = 0; r < 16; ++r) pmax = fmaxf(pmax, p1[r]);
  { auto rr = __builtin_amdgcn_permlane32_swap(__float_as_uint(pmax), __float_as_uint(pmax), false, false);
    pmax = fmaxf(__uint_as_float(rr[0]), __uint_as_float(rr[1])); }
  if (__builtin_expect(__all(pmax - m_reg <= THR / SCALE), 1)) { mn = m_reg; alpha = 1.f; }
  else { mn = fmaxf(m_reg, pmax); alpha = __builtin_amdgcn_exp2f((m_reg - mn) * C); m_reg = mn; }
  float mnC = -mn * C;
#pragma unroll
  for (int r = 0; r < 16; ++r) p0[r] = fmaf(p0[r], C, mnC);
#pragma unroll
  for (int r = 0; r < 16; ++r) p1[r] = fmaf(p1[r], C, mnC);
#pragma unroll
  for (int r = 0; r < 16; ++r) p0[r] = __builtin_amdgcn_exp2f(p0[r]);
}
__device__ __forceinline__ void finishSM(f32x16& p0, f32x16& p1, float alpha, float& l_reg, bf16x8& pa0, bf16x8& pa1, bf16x8& pa2, bf16x8& pa3) {
#pragma unroll
  for (int r = 0; r < 16; ++r) p1[r] = __builtin_amdgcn_exp2f(p1[r]);
  float ps = 0;
#pragma unroll
  for (int r = 0; r < 16; ++r) ps += p0[r];
#pragma unroll
  for (int r = 0; r < 16; ++r) ps += p1[r];
  { auto rr = __builtin_amdgcn_permlane32_swap(__float_as_uint(ps), __float_as_uint(ps), false, false);
    ps = __uint_as_float(rr[0]) + __uint_as_float(rr[1]); }
  l_reg = l_reg * alpha + ps;
#define PK4(P, BASE, OUT) do { unsigned a0 = cvt_pk_bf16(P[BASE + 0], P[BASE + 1]), a1 = cvt_pk_bf16(P[BASE + 2], P[BASE + 3]);   \
    unsigned b0 = cvt_pk_bf16(P[BASE + 4], P[BASE + 5]), b1 = cvt_pk_bf16(P[BASE + 6], P[BASE + 7]);                              \
    auto r0 = __builtin_amdgcn_permlane32_swap(a0, b0, false, false); auto r1 = __builtin_amdgcn_permlane32_swap(a1, b1, false, false); \
    u32x4 w = {r0[0], r1[0], r0[1], r1[1]}; OUT = *reinterpret_cast<bf16x8*>(&w); } while (0)
  PK4(p0, 0, pa0); PK4(p0, 8, pa1); PK4(p1, 0, pa2); PK4(p1, 8, pa3);
#undef PK4
}
__device__ __forceinline__ void qkt(f32x16& p0, f32x16& p1, const bf16_t* Ks, const bf16x8* qr, int r32, int hi) {
  p0 = f32x16{}; p1 = f32x16{};
#pragma unroll
  for (int d0 = 0; d0 < 8; ++d0) { int cb = (d0 * 16 + hi * 8) * 2;
    bf16x8 b0 = *reinterpret_cast<const bf16x8*>((const char*)Ks + KSWZ(r32, cb));
    bf16x8 b1 = *reinterpret_cast<const bf16x8*>((const char*)Ks + KSWZ(32 + r32, cb));
    p0 = __builtin_amdgcn_mfma_f32_32x32x16_bf16(b0, qr[d0], p0, 0, 0, 0);
    p1 = __builtin_amdgcn_mfma_f32_32x32x16_bf16(b1, qr[d0], p1, 0, 0, 0); }
}
__device__ __forceinline__ int v_st(int k, int c) { const int kk = (k & ~0xC) | ((k & 4) << 1) | ((k & 8) >> 1); return ((kk >> 3) * 4 + (c >> 5)) * 512 + ((kk & 7) * 32 + (c & 31)) * 2; }
__device__ __forceinline__ int v_rd_base(int lane) { return ((lane & 3) << 3) | (((lane >> 2) & 3) << 6) | (((lane >> 4) & 1) << 5) | (((lane >> 5) & 1) << 8); }
constexpr int v_rd_off(int d0, int ks, int half) { return d0 * 512 + ks * 4096 + half * 2048; }
template <int OFF> __device__ __forceinline__ s16x4 tr_read(int vb) {
  s16x4 r; asm volatile("ds_read_b64_tr_b16 %0, %1 offset:%2" : "=&v"(r) : "v"(vb), "i"(OFF) : "memory"); return r;
}
template <int D0> __device__ __forceinline__ void pv_one(f32x16& od, int vb, bf16x8 pa0, bf16x8 pa1, bf16x8 pa2, bf16x8 pa3) {
  const s16x4 l0 = tr_read<v_rd_off(D0, 0, 0)>(vb), h0 = tr_read<v_rd_off(D0, 0, 1)>(vb), l1 = tr_read<v_rd_off(D0, 1, 0)>(vb), h1 = tr_read<v_rd_off(D0, 1, 1)>(vb);
  const s16x4 l2 = tr_read<v_rd_off(D0, 2, 0)>(vb), h2 = tr_read<v_rd_off(D0, 2, 1)>(vb), l3 = tr_read<v_rd_off(D0, 3, 0)>(vb), h3 = tr_read<v_rd_off(D0, 3, 1)>(vb);
  asm volatile("s_waitcnt lgkmcnt(0)" ::: "memory"); SBAR();
#define PK(L, H) (bf16x8){L[0], L[1], L[2], L[3], H[0], H[1], H[2], H[3]}
  od = __builtin_amdgcn_mfma_f32_32x32x16_bf16(pa0, PK(l0, h0), od, 0, 0, 0);
  od = __builtin_amdgcn_mfma_f32_32x32x16_bf16(pa1, PK(l1, h1), od, 0, 0, 0);
  od = __builtin_amdgcn_mfma_f32_32x32x16_bf16(pa2, PK(l2, h2), od, 0, 0, 0);
  od = __builtin_amdgcn_mfma_f32_32x32x16_bf16(pa3, PK(l3, h3), od, 0, 0, 0);
#undef PK
}
__device__ __forceinline__ void pv_d0(f32x16* o, int vb, bf16x8 pa0, bf16x8 pa1, bf16x8 pa2, bf16x8 pa3) {
  pv_one<0>(o[0], vb, pa0, pa1, pa2, pa3); pv_one<1>(o[1], vb, pa0, pa1, pa2, pa3); pv_one<2>(o[2], vb, pa0, pa1, pa2, pa3); pv_one<3>(o[3], vb, pa0, pa1, pa2, pa3);
}
__device__ __forceinline__ void mask_tile(f32x16& p0, f32x16& p1, const AUnit& U, int j, int qrel, int hi, const float* rpbT) {
  if (j < U.nctx) return;
  const int jl = j - U.nctx;
  if (jl >= U.nloc) {
#pragma unroll
    for (int r = 0; r < 16; ++r) { p0[r] = NEG; p1[r] = NEG; }
    return; }
  if (U.mode == 1) {
    const int dq = (U.kt0 + jl) * 64 - (U.q0 + qrel) + 128;
#pragma unroll
    for (int r = 0; r < 16; ++r) { const int d0 = dq + crow(r, hi); if ((unsigned)d0 > 256u) p0[r] = NEG; if ((unsigned)(d0 + 32) > 256u) p1[r] = NEG; }
  } else if (U.mode == 2) {
    const int qpos = U.q0 + qrel, qrow = qpos >> 6, qcol = qpos & 63, krow = U.kt0 + jl;
    int rs = qrow - 4; rs = rs < 0 ? 0 : (rs > 8 ? 8 : rs);
    int cs = qcol - 8; cs = cs < 0 ? 0 : (cs > 48 ? 48 : cs);
    const bool rowok = (krow >= rs) && (krow < rs + 8);
    const int ib = (krow - qrow + 7) * 31 - qcol + 15;
#pragma unroll
    for (int r = 0; r < 16; ++r) { const int kc0 = crow(r, hi), kc1 = kc0 + 32;
      const bool ok0 = rowok && ((unsigned)(kc0 - cs) < 16u), ok1 = rowok && ((unsigned)(kc1 - cs) < 16u);
      const float b0 = rpbT[ok0 ? ib + kc0 : 0], b1 = rpbT[ok1 ? ib + kc1 : 0];
      p0[r] = ok0 ? p0[r] + b0 : NEG; p1[r] = ok1 ? p1[r] + b1 : NEG; }
  }
}
__device__ __forceinline__ void attn_unit(const AUnit& U, char* lds, int wv) {
  const int tid = ptid(wv);
  const int wid = wv, lane = tid & 63, r32 = lane & 31, hi = lane >> 5;
  bf16_t* V_lds = (bf16_t*)lds; bf16_t* K_lds = (bf16_t*)(lds + 2 * SHM_V);
  float* ws = (float*)(lds + 2 * SHM_V + 2 * SHM_K) + wid * 64; float* li_l = ws; float* al_l = ws + 32;
  float* rpbT = (float*)(lds + RPB_OFF);
  if (U.mode == 2) { for (int i = tid; i < 15 * 31; i += NTHR) rpbT[i] = U.rpb[i] * (1.0f / SCALE); }
  float m_reg = U.m0, l_reg = U.l0; f32x16 o[4] = {}; bf16x8 qr[8];
  const bf16_t* Qw = U.Q + (long)(wid * QBLK + r32) * D + hi * 8;
#pragma unroll
  for (int d0 = 0; d0 < 8; ++d0) qr[d0] = *reinterpret_cast<const bf16x8*>(Qw + d0 * 16);
  const int sr = tid >> 4, sc = (tid & 15) * 8, vst0 = v_st(sr, sc), vst1 = v_st(32 + sr, sc);
  const int vb0 = (int)(uintptr_t)V_lds + v_rd_base(lane);
  const int qrel = wid * QBLK + r32;
  struct { bf16x8 vs0, vs1, ks0, ks1; } sr_[1];
#define KTP(j) ((j) < U.nctx ? U.Kc + (long)(j) * 8192 : U.Kl + (long)(((j) - U.nctx) < U.nloc ? ((j) - U.nctx) : (U.nloc - 1)) * 8192)
#define VTP(j) ((j) < U.nctx ? U.Vc + (long)(j) * 8192 : U.Vl + (long)(((j) - U.nctx) < U.nloc ? ((j) - U.nctx) : (U.nloc - 1)) * 8192)
#define SLOAD(i, j) do { const bf16_t* kp_ = KTP(j); const bf16_t* vp_ = VTP(j); \
    sr_[i].vs0 = *reinterpret_cast<const bf16x8*>(&vp_[(long)(sr) * D + sc]); sr_[i].vs1 = *reinterpret_cast<const bf16x8*>(&vp_[(long)(32 + sr) * D + sc]); \
    sr_[i].ks0 = *reinterpret_cast<const bf16x8*>(&kp_[(long)(sr) * D + sc]); sr_[i].ks1 = *reinterpret_cast<const bf16x8*>(&kp_[(long)(32 + sr) * D + sc]); } while (0)
#define SWRITE(b, i) do { *(bf16x8*)((char*)V_lds + (b) * SHM_V + vst0) = sr_[i].vs0;          \
    *(bf16x8*)((char*)V_lds + (b) * SHM_V + vst1) = sr_[i].vs1; int kc = sc * 2;               \
    *(bf16x8*)((char*)K_lds + (b) * SHM_K + KSWZ(sr, kc)) = sr_[i].ks0;                       \
    *(bf16x8*)((char*)K_lds + (b) * SHM_K + KSWZ(32 + sr, kc)) = sr_[i].ks1; } while (0)
#define SWAIT() asm volatile("s_waitcnt vmcnt(0)" ::: "memory")
#define RESC(a) do { if (__any((a) < 1.f)) { if (hi == 0) al_l[r32] = (a); asm volatile("s_waitcnt lgkmcnt(0)" ::: "memory"); \
    _Pragma("unroll") for (int d = 0; d < 4; ++d) _Pragma("unroll") for (int r = 0; r < 16; ++r) o[d][r] *= al_l[crow(r, hi)]; } } while (0)
  f32x16 pA0, pA1, pB0, pB1; float mnA, mnB, alA, alB; bf16x8 pa0, pa1, pa2, pa3; const int NT = U.nt;
  SLOAD(0, 0); asm volatile("s_waitcnt vmcnt(0)" ::: "memory"); SWRITE(0, 0); __syncthreads();
  qkt(pA0, pA1, K_lds, qr, r32, hi); partialSM(pA0, pA1, m_reg, mnA, alA);
  SLOAD(0, 1);
  SWAIT(); SWRITE(1, 0); __syncthreads();
  for (int j = 1; j + 1 < NT; j += 2) {
    SBAR(); qkt(pB0, pB1, (bf16_t*)((char*)K_lds + SHM_K), qr, r32, hi);
    finishSM(pA0, pA1, alA, l_reg, pa0, pa1, pa2, pa3); SBAR();
    SLOAD(0, j + 1); SBAR();
    pv_d0(o, vb0, pa0, pa1, pa2, pa3); mask_tile(pB0, pB1, U, j, qrel, hi, rpbT); partialSM(pB0, pB1, m_reg, mnB, alB);
    __syncthreads(); SWAIT(); SWRITE(0, 0);
    RESC(alB); __syncthreads();
    SBAR(); qkt(pA0, pA1, K_lds, qr, r32, hi);
    finishSM(pB0, pB1, alB, l_reg, pa0, pa1, pa2, pa3); SBAR();
    SLOAD(0, j + 2); SBAR();
    pv_d0(o, vb0 + (int)SHM_V, pa0, pa1, pa2, pa3); mask_tile(pA0, pA1, U, j + 1, qrel, hi, rpbT); partialSM(pA0, pA1, m_reg, mnA, alA);
    __syncthreads(); SWAIT(); SWRITE(1, 0);
    RESC(alA); __syncthreads();
  }
  SBAR(); qkt(pB0, pB1, (bf16_t*)((char*)K_lds + SHM_K), qr, r32, hi);
  finishSM(pA0, pA1, alA, l_reg, pa0, pa1, pa2, pa3); SBAR();
  pv_d0(o, vb0, pa0, pa1, pa2, pa3); mask_tile(pB0, pB1, U, NT - 1, qrel, hi, rpbT); partialSM(pB0, pB1, m_reg, mnB, alB);
  __syncthreads(); RESC(alB);
  finishSM(pB0, pB1, alB, l_reg, pa0, pa1, pa2, pa3); SBAR();
  pv_d0(o, vb0 + (int)SHM_V, pa0, pa1, pa2, pa3);
  if (hi == 0) li_l[r32] = l_reg; asm volatile("s_waitcnt lgkmcnt(0)" ::: "memory");
  float rli[16];
#pragma unroll
  for (int r = 0; r < 16; ++r) rli[r] = __builtin_amdgcn_rcpf(li_l[crow(r, hi)]);
  bf16_t* Ow = U.O + (long)(wid * QBLK) * DM;
#pragma unroll
  for (int r = 0; r < 16; ++r) { int orow = crow(r, hi);
#pragma unroll
    for (int d0 = 0; d0 < 4; ++d0) Ow[(long)orow * DM + d0 * 32 + r32] = (bf16_t)f2bf(o[d0][r] * rli[r]); }
  __syncthreads();
#undef KTP
#undef VTP
#undef SLOAD
#undef SWRITE
#undef SWAIT
#undef RESC
}
#undef KSWZ
#undef SBAR
}

struct Args { const float* in[29]; float* out; unsigned char* ws; };
enum { I_XP = 0, I_XS, I_C, I_CCK, I_CCV, I_CDK, I_CDV, I_CCTX, I_WADA, I_BADA, I_GF1, I_WGU1, I_WDN1, I_GMIX, I_WOUT, I_GF2, I_WGU2, I_WDN2, I_WINE, I_GSGU, I_WSGU, I_BSGU, I_WINO,
       I_GQC, I_GKC, I_GQD, I_GKD, I_SINK, I_RPB };

__device__ __forceinline__ void transpose_item(const float* W, int K, int N, bf16_t* WT, int k0, int n0, int drow0, LAS float* scr, int lane) {
#pragma unroll 8
    for (int i = 0; i < 32; ++i) { const int kk = 2 * i + (lane >> 5); scr[kk * 33 + (lane & 31)] = W[(size_t)(k0 + kk) * N + n0 + (lane & 31)]; }
    LDS_WAIT(); asm volatile("" ::: "memory");
    const int c = lane & 7;
#pragma unroll
    for (int j = 0; j < 4; ++j) { const int n = (lane >> 3) + 8 * j; const LAS float* s = scr + (8 * c) * 33 + n;
        u32x4 o; o.x = pk2(s[0 * 33], s[1 * 33]); o.y = pk2(s[2 * 33], s[3 * 33]); o.z = pk2(s[4 * 33], s[5 * 33]); o.w = pk2(s[6 * 33], s[7 * 33]);
        *(u32x4*)(WT + (size_t)(drow0 + n) * K + k0 + 8 * c) = o; }
    LDS_WAIT(); asm volatile("" ::: "memory");
}
__device__ __forceinline__ int gu_row(int n) { return n < DFF ? ((n >> 7) * 256 + (n & 127)) : (((n - DFF) >> 7) * 256 + 128 + ((n - DFF) & 127)); }

__device__ __forceinline__ void prologue_a(const Args& A, LAS unsigned char* lds, int G, int wv) {
    const int tid = ptid(wv), lane = tid & 63, wave = wv;
    unsigned char* ws = A.ws;
    LAS float* sil = (LAS float*)(lds + 69632);
    for (int i = tid; i < 3 * DM; i += NTHR) { const int cv = i / DM, k = i % DM; const float v = cv == 0 ? A.in[I_CCTX][k] : A.in[I_C][(cv - 1) * DM + k]; sil[i] = v / (1.0f + __expf(-v)); }
    __syncthreads();
    const int gw = obid() * NWAVES + wave, NGW = G * NWAVES;
    for (int it = gw; it < 4 * 144 * 4; it += NGW) {
        const int l = it / 576, r = it % 576, cg = r >> 2, ks = r & 3;
        const float* w = A.in[I_WADA] + ((size_t)l * DM + ks * 512) * NMODV + cg * 128 + 2 * lane;
        f32x2 a0 = {0.f, 0.f}, a1 = {0.f, 0.f}, a2 = {0.f, 0.f};
        const LAS float* s0 = sil + ks * 512;
#pragma unroll 8
        for (int k = 0; k < 512; ++k) { const f32x2 wv = *(const f32x2*)(w + (size_t)k * NMODV); a0 += wv * s0[k]; a1 += wv * s0[DM + k]; a2 += wv * s0[2 * DM + k]; }
        float* P = (float*)(ws + WS_ADAP) + ((size_t)(l * 4 + ks) * 3) * NMODV + cg * 128 + 2 * lane;
        *(f32x2*)P = a0; *(f32x2*)(P + NMODV) = a1; *(f32x2*)(P + 2 * NMODV) = a2;
    }
    LAS float* scr = (LAS float*)(lds + wave * 8704);
    constexpr int PER_LAYER = 11008 * 2 + 5504 * 2 + 2048 + 4608;
    for (int it = gw; it < 4 * PER_LAYER; it += NGW) {
        const int l = it / PER_LAYER; int r = it % PER_LAYER;
        bf16_t* wl = (bf16_t*)(ws + WS_W) + (size_t)l * W_LAYER;
        if (r < 22016) { const int f = r / 11008; r %= 11008; const int kb = r / 344, nb = r % 344;
            transpose_item(A.in[f ? I_WGU2 : I_WGU1] + (size_t)l * DM * NGU, DM, NGU, wl + (f ? W_GU2 : W_GU1), kb * 64, nb * 32, gu_row(nb * 32), scr, lane); continue; }
        r -= 22016;
        if (r < 11008) { const int f = r / 5504; r %= 5504; const int kb = r / 64, nb = r % 64;
            transpose_item(A.in[f ? I_WDN2 : I_WDN1] + (size_t)l * DFF * DM, DFF, DM, wl + (f ? W_DN2 : W_DN1), kb * 64, nb * 32, nb * 32, scr, lane); continue; }
        r -= 11008;
        if (r < 2048) { const int kb = r / 64, nb = r % 64;
            transpose_item(A.in[I_WOUT] + (size_t)l * DM * DM, DM, DM, wl + W_OUT, kb * 64, nb * 32, nb * 32, scr, lane); continue; }
        r -= 2048;
        if (l & 1) { const int kb = r / 144, nb = r % 144;
            transpose_item(A.in[I_WINO] + (size_t)(l >> 1) * DM * NIN_O, DM, NIN_O, wl + W_IN, kb * 64, nb * 32, nb * 32, scr, lane); }
        else if (r < 3072) { const int kb = r / 96, nb = r % 96;
            transpose_item(A.in[I_WINE] + (size_t)(l >> 1) * DM * NIN_E, DM, NIN_E, wl + W_IN, kb * 64, nb * 32, nb * 32, scr, lane); }
    }
    const size_t gt = (size_t)obid() * NTHR + tid, GT = (size_t)G * NTHR;
    constexpr size_t N_CK = 524288 / 8, N_DK = 2097152 / 8, N_WS = 262144 / 8, N_T = 131072 / 8, N_CS = 2097152 / 8;
    constexpr size_t E0 = N_CK, E1 = E0 + N_CK, E2 = E1 + N_DK, E3 = E2 + N_DK, E4 = E3 + N_WS, E5 = E4 + N_T, E6 = E5 + N_T, E7 = E6 + N_CS;
    for (size_t i = gt; i < E7; i += GT) {
        if (i < E4) {
            const float* src; bf16_t* dst; size_t j;
            if (i < E0) { src = A.in[I_CCK]; dst = (bf16_t*)(ws + WS_CCK); j = i; }
            else if (i < E1) { src = A.in[I_CCV]; dst = (bf16_t*)(ws + WS_CCV); j = i - E0; }
            else if (i < E2) { src = A.in[I_CDK]; dst = (bf16_t*)(ws + WS_CDK); j = i - E1; }
            else if (i < E3) { src = A.in[I_CDV]; dst = (bf16_t*)(ws + WS_CDV); j = i - E2; }
            else { src = A.in[I_WSGU]; dst = (bf16_t*)(ws + WS_WSGU); j = i - E3; }
            const f32x4 x0 = *(const f32x4*)(src + j * 8), x1 = *(const f32x4*)(src + j * 8 + 4);
            u32x4 o; o.x = pk2(x0[0], x0[1]); o.y = pk2(x0[2], x0[3]); o.z = pk2(x1[0], x1[1]); o.w = pk2(x1[2], x1[3]);
            *(u32x4*)(dst + j * 8) = o;
        } else {
            float v[8]; bf16_t* dst; size_t j; size_t doff;
            if (i < E5) { j = i - E4; doff = j * 8; dst = (bf16_t*)(ws + WS_T256); const int m = (int)(j * 8) / 256, k0 = (int)(j * 8) % 256, cp = m & 255, h = m >> 8;
#pragma unroll
                for (int e = 0; e < 8; ++e) { const float ang = (float)(((cp * (k0 + e)) & 255) * 2) * (1.0f / 256.0f); v[e] = h ? sinpif(ang) : cospif(ang); } }
            else if (i < E6) { j = i - E5; dst = (bf16_t*)(ws + WS_CS256); const int sp = (int)(j * 8) / 512, kk0 = (int)(j * 8) % 512, h = kk0 / 256, s0 = kk0 % 256; doff = (size_t)sp * 2048 + kk0;
#pragma unroll
                for (int e = 0; e < 8; ++e) { const float ang = (float)(((sp * (s0 + e)) & 255) * 2) * (1.0f / 256.0f); v[e] = h ? -sinpif(ang) : cospif(ang); } }
            else { j = i - E6; doff = j * 8; dst = (bf16_t*)(ws + WS_CS1024); const int sp = (int)(j * 8) / 2048, kk0 = (int)(j * 8) % 2048, h = kk0 / 1024, s0 = kk0 % 1024;
#pragma unroll
                for (int e = 0; e < 8; ++e) { const float ang = (float)(((sp * (s0 + e)) & 1023) * 2) * (1.0f / 1024.0f); v[e] = h ? -sinpif(ang) : cospif(ang); } }
            u32x4 o; o.x = pk2(v[0], v[1]); o.y = pk2(v[2], v[3]); o.z = pk2(v[4], v[5]); o.w = pk2(v[6], v[7]);
            *(u32x4*)(dst + doff) = o;
        }
    }
    if (gt < 2048) { const int pos = (int)gt >> 5, f = (int)gt & 31; const float inv = powf(10000.0f, -(float)f / 32.0f), ang = (float)pos * inv;
        float* rt = (float*)(ws + WS_ROPE); rt[gt] = cosf(ang); rt[2048 + gt] = sinf(ang); }
}
__device__ __forceinline__ void prologue_b(const Args& A, int G, int wv) {
    const size_t gt = (size_t)obid() * NTHR + ptid(wv), GT = (size_t)G * NTHR;
    const float* P = (const float*)(A.ws + WS_ADAP); float* Mo = (float*)(A.ws + WS_MODS);
    for (size_t i = gt; i < (size_t)4 * 3 * NMODV; i += GT) { const int l = (int)(i / (3 * NMODV)), r = (int)(i % (3 * NMODV)), j = r % NMODV;
        float s = A.in[I_BADA][(size_t)l * NMODV + j];
#pragma unroll
        for (int ks = 0; ks < 4; ++ks) s += P[((size_t)(l * 4 + ks) * 3) * NMODV + r];
        Mo[i] = s; }
}

__device__ __forceinline__ void nm_phase(const Args& A, int G, bool first, bool do_slab, float coef, int layer_gate, int kgate, bool do_norm, const float* g, int layer, int kshift, int wv) {
    const int tid = ptid(wv);
    const int lane = tid & 63, wave = wv;
    const int gw = obid() * NWAVES + wave, NGW = G * NWAVES;
    float* xd = A.out; bf16_t* H = (bf16_t*)(A.ws + WS_H);
    const float* mods = (const float*)(A.ws + WS_MODS); const float* slab = (const float*)(A.ws + WS_SLAB);
    const int r_lo = do_norm ? 0 : MP;
    for (int r = r_lo + gw; r < MTOT; r += NGW) {
        const int cv = r < MP ? 0 : 1 + ((r - MP) >> 10);
        const float* xr = first ? (r < MP ? A.in[I_XP] + (size_t)r * DM : A.in[I_XS] + (size_t)(r - MP) * DM) : xd + (size_t)r * DM;
        f32x4 v[8];
#pragma unroll
        for (int j = 0; j < 8; ++j) v[j] = *(const f32x4*)(xr + 4 * lane + 256 * j);
        const bool wr_x = first || (do_slab && r >= MP);
        if (do_slab && r >= MP) {
            const float* gt_ = mods + ((size_t)(layer_gate * 3 + cv)) * NMODV + kgate * DM;
            const float* sb = slab + (size_t)(r - MP) * DM;
#pragma unroll
            for (int j = 0; j < 8; ++j) { const int c = 4 * lane + 256 * j;
                const f32x4 s = (*(const f32x4*)(sb + c) + *(const f32x4*)(sb + (size_t)MS * DM + c)) + (*(const f32x4*)(sb + (size_t)2 * MS * DM + c) + *(const f32x4*)(sb + (size_t)3 * MS * DM + c));
                v[j] = v[j] + (*(const f32x4*)(gt_ + c) * coef) * s; }
        }
        if (wr_x) {
#pragma unroll
            for (int j = 0; j < 8; ++j) *(f32x4*)(xd + (size_t)r * DM + 4 * lane + 256 * j) = v[j];
        }
        if (do_norm) {
            float ss = 0.f;
#pragma unroll
            for (int j = 0; j < 8; ++j) ss += (v[j][0] * v[j][0] + v[j][1] * v[j][1]) + (v[j][2] * v[j][2] + v[j][3] * v[j][3]);
            ss = wave_sum(ss);
            const float rstd = 1.0f / sqrtf(ss * (1.0f / DM) + EPS);
            const float* sh = mods + ((size_t)(layer * 3 + cv)) * NMODV + kshift * DM; const float* scp = sh + DM;
#pragma unroll
            for (int j = 0; j < 8; ++j) { const int c = 4 * lane + 256 * j;
                const f32x4 gg = *(const f32x4*)(g + c), s1 = *(const f32x4*)(scp + c), s0 = *(const f32x4*)(sh + c);
                const f32x4 y = ((v[j] * rstd) * gg) * (s1 + 1.0f) + s0;
                u32x2 w; w.x = cvt_pk_bf16(y[0], y[1]); w.y = cvt_pk_bf16(y[2], y[3]);
                *(u32x2*)(H + (size_t)r * DM + c) = w; }
        }
    }
}

__device__ __forceinline__ void sgu_phase(const Args& A, LAS unsigned char* lds, int G, int e, int wv) {
    const int tid = ptid(wv);
    const int lane = tid & 63, wave = wv;
    const bf16_t* mixin = (const bf16_t*)(A.ws + WS_MIXIN); bf16_t* mixout = (bf16_t*)(A.ws + WS_MIXOUT);
    const float* ssq = (const float*)(A.ws + WS_SSQ);
    const bf16_t* wsg = (const bf16_t*)(A.ws + WS_WSGU) + (size_t)e * 8 * 128 * 128;
    LAS bf16_t* LT = (LAS bf16_t*)lds;
    LAS float* rs = (LAS float*)(lds + 128 * 136 * 2);
    for (int u = obid(); u < 80 * 8; u += G) {
        const int ch = u >> 3, g = u & 7, t0 = ch * 128;
        __syncthreads();
        if (tid < 128) { const float* p = ssq + (size_t)(t0 + tid) * 16; float s = 0.f;
#pragma unroll
            for (int i = 0; i < 16; ++i) s += p[i];
            rs[tid] = 1.0f / sqrtf(s * (1.0f / 1024.0f) + EPS); }
        __syncthreads();
#pragma unroll
        for (int i = 0; i < 4; ++i) { const int idx = tid + NTHR * i, q = idx >> 4, cc = idx & 15;
            const u32x4 w = *(const u32x4*)(mixin + (size_t)(t0 + q) * NIN_E + 1024 + g * 128 + cc * 8);
            const float* gs = A.in[I_GSGU] + (size_t)e * 1024 + g * 128 + cc * 8; const float r = rs[q];
            const f32x4 g0 = *(const f32x4*)gs, g1 = *(const f32x4*)(gs + 4);
            float y[8] = {bf_lo(w.x) * r * g0[0], bf_hi(w.x) * r * g0[1], bf_lo(w.y) * r * g0[2], bf_hi(w.y) * r * g0[3], bf_lo(w.z) * r * g1[0], bf_hi(w.z) * r * g1[1], bf_lo(w.w) * r * g1[2], bf_hi(w.w) * r * g1[3]};
#pragma unroll
            for (int k = 0; k < 8; ++k) LT[(cc * 8 + k) * 136 + q] = (bf16_t)f2bf(y[k]); }
        __syncthreads();
        const int p = 16 * wave + (lane & 15), kq = lane >> 4;
        bf16x8 wf[4];
#pragma unroll
        for (int ks = 0; ks < 4; ++ks) wf[ks] = *(const bf16x8*)(wsg + ((size_t)g * 128 + p) * 128 + 32 * ks + 8 * kq);
        const float bias = A.in[I_BSGU][(size_t)e * 1024 + g * 128 + p];
#pragma unroll
        for (int nt = 0; nt < 8; ++nt) { f32x4 acc = {0.f, 0.f, 0.f, 0.f};
#pragma unroll
            for (int ks = 0; ks < 4; ++ks) { const bf16x8 vf = *(const LAS bf16x8*)(LT + (16 * nt + (lane & 15)) * 136 + 32 * ks + 8 * kq);
                acc = __builtin_amdgcn_mfma_f32_16x16x32_bf16(vf, wf[ks], acc, 0, 0, 0); }
            const int c = 16 * nt + 4 * kq;
            const u32x2 uu = *(const u32x2*)(mixin + (size_t)(t0 + p) * NIN_E + g * 128 + c);
            u32x2 o; o.x = cvt_pk_bf16(bf_lo(uu.x) * (acc[0] + bias), bf_hi(uu.x) * (acc[1] + bias)); o.y = cvt_pk_bf16(bf_lo(uu.y) * (acc[2] + bias), bf_hi(uu.y) * (acc[3] + bias));
            *(u32x2*)(mixout + (size_t)(t0 + p) * DM + g * 128 + c) = o; }
    }
    __syncthreads();
}

__device__ __forceinline__ void prep_phase(const Args& A, int G, int o, int wv) {
    const int tid = ptid(wv);
    const int lane = tid & 63, wave = wv, li = lane & 15, grp = lane >> 4;
    const int gw = obid() * NWAVES + wave, NGW = G * NWAVES;
    const bf16_t* mixin = (const bf16_t*)(A.ws + WS_MIXIN); bf16_t* qkv = (bf16_t*)(A.ws + WS_QKV);
    const float* rt = (const float*)(A.ws + WS_ROPE);
    for (int r = gw; r < MTOT; r += NGW) {
        const bool smp = r >= MP; const int b = smp ? (r - MP) >> 10 : r >> 8, s = smp ? (r - MP) & 1023 : r & 255, S = smp ? 1024 : 256;
        const int prow = s >> 6, pcol = s & 63;
#pragma unroll
        for (int j = 0; j < 9; ++j) {
            const int slot = 4 * j + grp;
            const u32x4 w = *(const u32x4*)(mixin + (size_t)r * NIN_O + slot * 128 + li * 8);
            float x[8] = {bf_lo(w.x), bf_hi(w.x), bf_lo(w.y), bf_hi(w.y), bf_lo(w.z), bf_hi(w.z), bf_lo(w.w), bf_hi(w.w)};
            int ty, hd, H;
            if (slot < 8) { ty = 0; hd = slot; H = 8; } else if (slot < 10) { ty = 1; hd = slot - 8; H = 2; } else if (slot < 12) { ty = 2; hd = slot - 10; H = 2; }
            else if (slot < 20) { ty = 3; hd = slot - 12; H = 8; } else if (slot < 28) { ty = 4; hd = slot - 20; H = 8; } else { ty = 5; hd = slot - 28; H = 8; }
            const bool isn = (ty != 2) && (ty != 5);
            float ss = 0.f;
#pragma unroll
            for (int k = 0; k < 8; ++k) ss += x[k] * x[k];
            ss += __shfl_xor(ss, 1); ss += __shfl_xor(ss, 2); ss += __shfl_xor(ss, 4); ss += __shfl_xor(ss, 8);
            const float rstd = 1.0f / sqrtf(ss * (1.0f / 128.0f) + EPS);
            const float* gp = A.in[ty == 0 ? I_GQC : ty == 1 ? I_GKC : ty == 3 ? I_GQD : I_GKD] + (size_t)o * 128 + li * 8;
            if (isn) {
                const f32x4 g0 = *(const f32x4*)gp, g1 = *(const f32x4*)(gp + 4);
#pragma unroll
                for (int k = 0; k < 4; ++k) { x[k] = x[k] * rstd * g0[k]; x[4 + k] = x[4 + k] * rstd * g1[k]; }
            }
            if (smp && j <= 2) {
                const int pos = (li < 8) ? prow : pcol; const float* ct = rt + pos * 32 + 8 * (li & 3); const float* st = ct + 2048;
                const bool lo = !(li & 4), dor = ty < 2;
#pragma unroll
                for (int k = 0; k < 8; ++k) { const float xp = __shfl_xor(x[k], 4); const float c = ct[k], sn = st[k];
                    const float rr = lo ? (x[k] * c - xp * sn) : (xp * sn + x[k] * c); x[k] = dor ? rr : x[k]; }
            }
            const size_t base = smp ? (ty == 0 ? Q_QCS : ty == 1 ? Q_KCS : ty == 2 ? Q_VCS : ty == 3 ? Q_QDS : ty == 4 ? Q_KDS : Q_VDS)
                                    : (ty == 0 ? Q_QCP : ty == 1 ? Q_KCP : ty == 2 ? Q_VCP : ty == 3 ? Q_QDP : ty == 4 ? Q_KDP : Q_VDP);
            u32x4 ov; ov.x = cvt_pk_bf16(x[0], x[1]); ov.y = cvt_pk_bf16(x[2], x[3]); ov.z = cvt_pk_bf16(x[4], x[5]); ov.w = cvt_pk_bf16(x[6], x[7]);
            *(u32x4*)(qkv + base + ((size_t)(b * H + hd) * S + s) * 128 + li * 8) = ov;
            if (!smp && (ty == 1 || ty == 2 || ty == 4 || ty == 5)) {
                float* sp = A.out + (ty == 1 ? O_SCK : ty == 2 ? O_SCV : ty == 4 ? O_SDK : O_SDV) + (((size_t)(b * 2 + o) * H + hd) * 256 + s) * 128 + li * 8;
                *(f32x4*)sp = (f32x4){x[0], x[1], x[2], x[3]}; *(f32x4*)(sp + 4) = (f32x4){x[4], x[5], x[6], x[7]};
            }
        }
    }
}

__device__ __forceinline__ void attn_phase(const Args& A, LAS unsigned char* lds, int G, int o, int wv) {
    const bf16_t* qkv = (const bf16_t*)(A.ws + WS_QKV); bf16_t* mixout = (bf16_t*)(A.ws + WS_MIXOUT);
    const int c = obid();
    for (int i = 0;; ++i) {
        int u;
        if (G == 256) { if (c < 128) { if (i > 0) break; u = c; } else { if (i >= 4) break; u = 128 + 4 * (c - 128) + i; } }
        else { u = c + i * G; if (u >= 640) break; }
        att::AUnit U;
        if (u < 64) {
            const int b = u >> 5, h = (u >> 2) & 7, qb = u & 3;
            U.q0 = qb * 256; U.kt0 = qb == 0 ? 0 : (qb == 1 ? 0 : (qb == 2 ? 4 : 8)); U.nloc = (qb == 0 || qb == 3) ? 8 : 11; U.nctx = 8; U.nt = 8 + ((U.nloc + 1) & ~1); U.mode = 2;
            U.Q = qkv + Q_QDS + ((size_t)(b * 8 + h) * 1024 + U.q0) * 128; U.O = mixout + (size_t)(MP + b * 1024 + U.q0) * DM + (8 + h) * 128;
            U.Kc = (const bf16_t*)(A.ws + WS_CDK) + ((size_t)((b * 2 + o) * 8 + h)) * 512 * 128; U.Vc = (const bf16_t*)(A.ws + WS_CDV) + ((size_t)((b * 2 + o) * 8 + h)) * 512 * 128;
            U.Kl = qkv + Q_KDS + ((size_t)(b * 8 + h) * 1024 + U.kt0 * 64) * 128; U.Vl = qkv + Q_VDS + ((size_t)(b * 8 + h) * 1024 + U.kt0 * 64) * 128;
            U.m0 = -1e30f; U.l0 = 0.f; U.rpb = A.in[I_RPB] + ((size_t)o * 8 + h) * 15 * 31;
        } else if (u < 128) {
            const int v = u - 64, b = v >> 5, h = (v >> 2) & 7, qb = v & 3, kvh = h >> 2;
            U.q0 = qb * 256; const int k_lo = qb == 0 ? 0 : 4 * qb - 2, k_hi = qb == 3 ? 15 : 4 * qb + 5;
            U.kt0 = k_lo; U.nloc = k_hi - k_lo + 1; U.nctx = 8; U.nt = 8 + U.nloc; U.mode = 1;
            U.Q = qkv + Q_QCS + ((size_t)(b * 8 + h) * 1024 + U.q0) * 128; U.O = mixout + (size_t)(MP + b * 1024 + U.q0) * DM + h * 128;
            U.Kc = (const bf16_t*)(A.ws + WS_CCK) + ((size_t)((b * 2 + o) * 2 + kvh)) * 512 * 128; U.Vc = (const bf16_t*)(A.ws + WS_CCV) + ((size_t)((b * 2 + o) * 2 + kvh)) * 512 * 128;
            U.Kl = qkv + Q_KCS + ((size_t)(b * 2 + kvh) * 1024 + U.kt0 * 64) * 128; U.Vl = qkv + Q_VCS + ((size_t)(b * 2 + kvh) * 1024 + U.kt0 * 64) * 128;
            U.m0 = A.in[I_SINK][o * 8 + h] * (1.0f / att::SCALE); U.l0 = 1.f; U.rpb = nullptr;
        } else {
            const int v = u - 128, b = v >> 4, hh = v & 15;
            U.q0 = 0; U.kt0 = 0; U.nloc = 0; U.nctx = 4; U.nt = 4; U.mode = 0; U.rpb = nullptr; U.Kl = nullptr; U.Vl = nullptr;
            U.O = mixout + (size_t)(b * 256) * DM + hh * 128;
            if (hh < 8) { const int kvh = hh >> 2;
                U.Q = qkv + Q_QCP + ((size_t)(b * 8 + hh) * 256) * 128; U.Kc = qkv + Q_KCP + ((size_t)(b * 2 + kvh) * 256) * 128; U.Vc = qkv + Q_VCP + ((size_t)(b * 2 + kvh) * 256) * 128;
                U.m0 = A.in[I_SINK][o * 8 + hh] * (1.0f / att::SCALE); U.l0 = 1.f; }
            else { const int h = hh - 8;
                U.Q = qkv + Q_QDP + ((size_t)(b * 8 + h) * 256) * 128; U.Kc = qkv + Q_KDP + ((size_t)(b * 8 + h) * 256) * 128; U.Vc = qkv + Q_VDP + ((size_t)(b * 8 + h) * 256) * 128;
                U.m0 = -1e30f; U.l0 = 0.f; }
        }
        att::attn_unit(U, (char*)lds, wv);
    }
}

#ifndef ONLY_PH
#define ONLY_PH (-1)
#endif
#define PH(n) (ONLY_PH < 0 || ONLY_PH == (n))
__global__ void __launch_bounds__(NTHR, 2) mega_fwd(Args args) {
    extern __shared__ __attribute__((aligned(16))) unsigned char lds_raw[];
    LAS unsigned char* lds = (LAS unsigned char*)lds_raw;
    const int G = gridDim.x, wv = __builtin_amdgcn_readfirstlane((int)(threadIdx.x >> 6));
    volatile LAS unsigned* MISC = (volatile LAS unsigned*)(lds + LDS_MISC);
    { const int t0 = ptid(wv); if (t0 < 16) MISC[t0] = 0u; }
    __syncthreads();
    unsigned char* ws = args.ws;
    XcdBarrier bar = xcd_barrier_post((unsigned*)(ws + WS_CTL), MISC + 8, ptid(wv));
    const float* mods = (const float*)(ws + WS_MODS);

    if (PH(0)) prologue_a(args, lds, G, wv);
    xcd_barrier(bar, wv);
    if (PH(1)) prologue_b(args, G, wv);
    xcd_barrier(bar, wv);

    for (int layer = 0; layer < 4; ++layer) {
        const bf16_t* wl = (const bf16_t*)(ws + WS_W) + (size_t)layer * W_LAYER;
        const bool odd = layer & 1; const int eo = layer >> 1;
        if (PH(2)) nm_phase(args, G, layer == 0, layer > 0, 0.5f, layer - 1, 8, true, args.in[I_GF1] + (size_t)layer * DM, layer, 0, wv);
        xcd_barrier(bar, wv);
        if (PH(3)) { pg8::SchedStd S{(const char*)(ws + WS_H), (const char*)(wl + W_GU1), DM * 2, DM * 2, DM / 64, MTOT / 256, NGU / 256, (MTOT / 256) * (NGU / 256), G, obid(), (char*)(ws + WS_ACT), DFF, 128};
          pg8::EpiGU E; pg8::gemm_phase<pg8::EpiGU, pg8::SchedStd, true, true>(lds, S, E, wv); }
        xcd_barrier(bar, wv);
        if (PH(4)) { pg8::SchedSplit S{(const char*)(ws + WS_ACT), (const char*)(wl + W_DN1), DFF * 2, DFF * 2, DFF / 64, 22, G, obid()};
          pg8::EpiResid E{args.out, mods + ((size_t)layer * 3) * NMODV + 2 * DM, 0.5f, (float*)(ws + WS_SLAB)};
          pg8::gemm_phase<pg8::EpiResid, pg8::SchedSplit, true, true>(lds, S, E, wv); }
        xcd_barrier(bar, wv);
        if (PH(5)) nm_phase(args, G, false, true, 0.5f, layer, 2, true, args.in[I_GMIX] + (size_t)layer * DM, layer, 3, wv);
        xcd_barrier(bar, wv);
        if (PH(6)) { const int nin = odd ? NIN_O : NIN_E;
          pg8::SchedStd S{(const char*)(ws + WS_H), (const char*)(wl + W_IN), DM * 2, DM * 2, DM / 64, MTOT / 256, nin / 256, (MTOT / 256) * (nin / 256), G, obid(), (char*)(ws + WS_MIXIN), nin, 256};
          pg8::EpiBf16 E{1.0f, odd ? nullptr : (float*)(ws + WS_SSQ)};
          pg8::gemm_phase<pg8::EpiBf16, pg8::SchedStd, true, true>(lds, S, E, wv); }
        xcd_barrier(bar, wv);
        if (!odd) {
            if (PH(7)) { pg8::SchedF1 S{(const char*)(ws + WS_T256), (const char*)(ws + WS_MIXIN), (char*)(ws + WS_GT), (char*)(ws + WS_GTS), 512, NIN_E * 2, G, obid()};
              pg8::EpiBf16 E{1.0f, nullptr};
              pg8::gemm_phase<pg8::EpiBf16, pg8::SchedF1, true, true>(lds, S, E, wv); }
            if (PH(8)) sgu_phase(args, lds, G, eo, wv);
            xcd_barrier(bar, wv);
            if (PH(9)) { pg8::SchedF2 S{(const char*)(ws + WS_CS256), (const char*)(ws + WS_CS1024), (const char*)(ws + WS_GT), (const char*)(ws + WS_GTS), (char*)(ws + WS_MIXOUT), 4096, 4096, G, obid()};
              pg8::EpiF2 E2;
              pg8::gemm_phase<pg8::EpiF2, pg8::SchedF2, true, true>(lds, S, E2, wv); }
            xcd_barrier(bar, wv);
        } else {
            if (PH(10)) prep_phase(args, G, eo, wv);
            xcd_barrier(bar, wv);
            if (PH(11)) attn_phase(args, lds, G, eo, wv);
            xcd_barrier(bar, wv);
        }
        if (PH(12)) { pg8::SchedSplit S{(const char*)(ws + WS_MIXOUT), (const char*)(wl + W_OUT), DM * 2, DM * 2, DM / 64, 8, G, obid()};
          pg8::EpiResid E{args.out, mods + ((size_t)layer * 3) * NMODV + 5 * DM, 1.0f, (float*)(ws + WS_SLAB)};
          pg8::gemm_phase<pg8::EpiResid, pg8::SchedSplit, true, true>(lds, S, E, wv); }
        xcd_barrier(bar, wv);
        if (PH(13)) nm_phase(args, G, false, true, 1.0f, layer, 5, true, args.in[I_GF2] + (size_t)layer * DM, layer, 6, wv);
        xcd_barrier(bar, wv);
        if (PH(14)) { pg8::SchedStd S{(const char*)(ws + WS_H), (const char*)(wl + W_GU2), DM * 2, DM * 2, DM / 64, MTOT / 256, NGU / 256, (MTOT / 256) * (NGU / 256), G, obid(), (char*)(ws + WS_ACT), DFF, 128};
          pg8::EpiGU E; pg8::gemm_phase<pg8::EpiGU, pg8::SchedStd, true, true>(lds, S, E, wv); }
        xcd_barrier(bar, wv);
        if (PH(15)) { pg8::SchedSplit S{(const char*)(ws + WS_ACT), (const char*)(wl + W_DN2), DFF * 2, DFF * 2, DFF / 64, 22, G, obid()};
          pg8::EpiResid E{args.out, mods + ((size_t)layer * 3) * NMODV + 8 * DM, 0.5f, (float*)(ws + WS_SLAB)};
          pg8::gemm_phase<pg8::EpiResid, pg8::SchedSplit, true, true>(lds, S, E, wv); }
        xcd_barrier(bar, wv);
    }
    if (PH(16)) nm_phase(args, G, false, true, 0.5f, 3, 8, false, nullptr, 0, 0, wv);
}

extern "C" void kernel_launch(void* const* d_in, const int* in_sizes, int n_in, void* d_out, int out_size, void* d_ws, size_t ws_size, hipStream_t stream) {
    static int grid = 0;
    if (grid == 0) {
        if (n_in != 29 || (size_t)out_size != O_END || ws_size < WS_END) {
            fprintf(stderr, "kernel_launch: unexpected shapes: n_in %d out %d ws %zu (need %zu)\n", n_in, out_size, ws_size, (size_t)WS_END); grid = -1; return; }
        int dev = 0, cus = 0, per_cu = 0;
        if (hipGetDevice(&dev) != hipSuccess || hipDeviceGetAttribute(&cus, hipDeviceAttributeMultiprocessorCount, dev) != hipSuccess) { grid = -1; return; }
        if (hipFuncSetAttribute((const void*)mega_fwd, hipFuncAttributeMaxDynamicSharedMemorySize, LDS_BYTES) != hipSuccess) { fprintf(stderr, "kernel_launch: hipFuncSetAttribute failed\n"); grid = -1; return; }
        if (hipOccupancyMaxActiveBlocksPerMultiprocessor(&per_cu, (const void*)mega_fwd, NTHR, LDS_BYTES) != hipSuccess || per_cu < 1)
            fprintf(stderr, "kernel_launch: occupancy query reports %d\n", per_cu);
        (void)hipGetLastError();
        grid = cus;
    }
    if (grid < 0) return;
    if (hipMemsetAsync((char*)d_ws + WS_CTL, 0, CTL_ZERO_BYTES, stream) != hipSuccess) { fprintf(stderr, "kernel_launch: memset failed\n"); return; }
    Args a{};
    for (int i = 0; i < 29; ++i) a.in[i] = (const float*)d_in[i];
    a.out = (float*)d_out; a.ws = (unsigned char*)d_ws;
    hipLaunchKernelGGL(mega_fwd, dim3(grid), dim3(NTHR), LDS_BYTES, stream, a);
    const hipError_t le = hipPeekAtLastError();
    if (le != hipSuccess) fprintf(stderr, "kernel_launch: launch failed: %s\n", hipGetErrorName(le));
}
```

```cpp
#include <hip/hip_runtime.h>
#include <cstdio>
#include <cstdint>

#define LAS __attribute__((address_space(3)))
#define GAS __attribute__((address_space(1)))
typedef unsigned short bf16_t;
typedef short bf16x8 __attribute__((ext_vector_type(8)));
typedef short s16x4 __attribute__((ext_vector_type(4)));
typedef float f32x2 __attribute__((ext_vector_type(2)));
typedef float f32x4 __attribute__((ext_vector_type(4)));
typedef float f32x8 __attribute__((ext_vector_type(8)));
typedef float f32x16 __attribute__((ext_vector_type(16)));
typedef unsigned u32x2 __attribute__((ext_vector_type(2)));
typedef unsigned u32x4 __attribute__((ext_vector_type(4)));
typedef int i32x4 __attribute__((ext_vector_type(4)));

#ifndef TSMASK
#define TSMASK 0
#endif
#ifndef TSBAR
#define TSBAR 0
#endif
constexpr int DM = 2048, MP = 8192, MS = 2048, MTOT = 10240, DFF = 5504, NGU = 11008, NIN_E = 3072, NIN_O = 4608, NMODV = 18432;
constexpr float EPS = 1e-6f;
constexpr int NWAVES = 8, NTHR = 512;
#ifndef G_ALIGN
#define G_ALIGN true
#endif
#ifndef G_SP2
#define G_SP2 true
#endif

constexpr size_t MiB = 1u << 20;
constexpr size_t WS_CTL = 0, CTL_ZERO_BYTES = 1024 * 1024;
constexpr size_t WS_CMAX = 512 * 1024;
constexpr size_t WS_MODS = 1 * MiB;
constexpr size_t WS_ADAP = 2 * MiB;
constexpr size_t WS_SSQ_OLD = 6 * MiB;
constexpr size_t WS_RSC = 6 * MiB + 704 * 1024;
constexpr size_t WS_RSC2 = 6 * MiB + 768 * 1024;
constexpr size_t WS_CMAX2 = 6 * MiB + 832 * 1024;
constexpr size_t WS_T256 = 7 * MiB;
constexpr size_t WS_ROPE = WS_T256 + 262144;
constexpr size_t WS_WSGU = 8 * MiB;
constexpr size_t WS_CS1024 = 9 * MiB;
constexpr size_t WS_CS256 = 23 * MiB;
constexpr size_t WS_CCK = 13 * MiB;
constexpr size_t WS_CCV = 14 * MiB, WS_CDK = 15 * MiB, WS_CDV = 19 * MiB;
constexpr size_t WS_H = 24 * MiB;
constexpr size_t WS_ACT = 64 * MiB;
constexpr size_t WS_MIXIN = 172 * MiB;
constexpr size_t WS_MIXOUT = 262 * MiB;
constexpr size_t WS_SLAB = 302 * MiB;
constexpr size_t WS_GT = 366 * MiB;
constexpr size_t WS_GTS = WS_GT + 128 * MiB;
constexpr size_t WS_QKV = 366 * MiB;
constexpr size_t WS_W = 502 * MiB;
constexpr size_t W_GU1 = 0, W_DN1 = (size_t)NGU * DM, W_GU2 = W_DN1 + (size_t)DM * DFF, W_DN2 = W_GU2 + (size_t)NGU * DM, W_OUT = W_DN2 + (size_t)DM * DFF,
                 W_IN = W_OUT + (size_t)DM * DM, W_LAYER = W_IN + (size_t)NIN_O * DM;
constexpr size_t WS_ACT8 = WS_W + 4 * W_LAYER * 2;
constexpr int KD8 = 5632;
constexpr size_t WS_SSQ = WS_ACT8 + (size_t)MTOT * KD8;
constexpr size_t WS_END = WS_SSQ + (size_t)MTOT * 4;
constexpr size_t Q_QCP = 0, Q_KCP = Q_QCP + (size_t)MP * 1024, Q_VCP = Q_KCP + (size_t)MP * 256, Q_QDP = Q_VCP + (size_t)MP * 256, Q_KDP = Q_QDP + (size_t)MP * 1024,
                 Q_VDP = Q_KDP + (size_t)MP * 1024, Q_QCS = Q_VDP + (size_t)MP * 1024, Q_KCS = Q_QCS + (size_t)MS * 1024, Q_VCS = Q_KCS + (size_t)MS * 256,
                 Q_QDS = Q_VCS + (size_t)MS * 256, Q_KDS = Q_QDS + (size_t)MS * 1024, Q_VDS = Q_KDS + (size_t)MS * 1024, Q_END = Q_VDS + (size_t)MS * 1024;
static_assert(WS_QKV + Q_END * 2 <= WS_W, "qkv region");
constexpr size_t O_YP = 0, O_YS = (size_t)MP * DM, O_SCK = O_YS + (size_t)MS * DM, O_SCV = O_SCK + (size_t)32 * 2 * 2 * 256 * 128, O_SDK = O_SCV + (size_t)32 * 2 * 2 * 256 * 128,
                 O_SDV = O_SDK + (size_t)32 * 2 * 8 * 256 * 128, O_END = O_SDV + (size_t)32 * 2 * 8 * 256 * 128;

constexpr int LDS_BYTES = 147456;
constexpr int LDS_MISC = 135168;

#define LDS_WAIT() asm volatile("s_waitcnt lgkmcnt(0)" ::: "memory")
#define VM_WAIT() asm volatile("s_waitcnt vmcnt(0)" ::: "memory")
__device__ __forceinline__ unsigned f2bf(float f) { unsigned u = __builtin_bit_cast(unsigned, f); return (u + 0x7fffu + ((u >> 16) & 1u)) >> 16; }
__device__ __forceinline__ unsigned pk2(float lo, float hi) { return f2bf(lo) | (f2bf(hi) << 16); }
__device__ __forceinline__ unsigned cvt_pk_bf16(float lo, float hi) { unsigned r; asm volatile("v_cvt_pk_bf16_f32 %0, %1, %2" : "=v"(r) : "v"(lo), "v"(hi)); return r; }
typedef __bf16 bf16x2_t __attribute__((ext_vector_type(2)));
__device__ __forceinline__ unsigned cvt_pk_bf16_b(float lo, float hi) { f32x2 v = {lo, hi}; bf16x2_t b = __builtin_convertvector(v, bf16x2_t); return __builtin_bit_cast(unsigned, b); }
__device__ __forceinline__ float bf_lo(unsigned w) { return __uint_as_float(w << 16); }
__device__ __forceinline__ float bf_hi(unsigned w) { return __uint_as_float(w & 0xffff0000u); }
__device__ __forceinline__ int ptid(int wv) { int t = wv * 64 + (int)__builtin_amdgcn_mbcnt_hi(~0u, __builtin_amdgcn_mbcnt_lo(~0u, 0u)); asm volatile("" : "+v"(t)); return t; }
__device__ __forceinline__ unsigned char* ws_opaque(unsigned char* p) { asm volatile("" : "+s"(p)); return p; }
__device__ __forceinline__ int obid() { int b = (int)blockIdx.x; asm volatile("" : "+s"(b)); return b; }
template <int M> __device__ __forceinline__ float sx(float v) { return __int_as_float(__builtin_amdgcn_ds_swizzle(__float_as_int(v), (M << 10) | 0x1f)); }
__device__ __forceinline__ float sum32(float v) { auto rr = __builtin_amdgcn_permlane32_swap(__float_as_uint(v), __float_as_uint(v), false, false); return __uint_as_float(rr[0]) + __uint_as_float(rr[1]); }
__device__ __forceinline__ float max32(float v) { auto rr = __builtin_amdgcn_permlane32_swap(__float_as_uint(v), __float_as_uint(v), false, false); return fmaxf(__uint_as_float(rr[0]), __uint_as_float(rr[1])); }
__device__ __forceinline__ float wave_sum(float v) { v += sx<1>(v); v += sx<2>(v); v += sx<4>(v); v += sx<8>(v); v += sx<16>(v); return sum32(v); }
__device__ __forceinline__ float wave_max(float v) { v = fmaxf(v, sx<1>(v)); v = fmaxf(v, sx<2>(v)); v = fmaxf(v, sx<4>(v)); v = fmaxf(v, sx<8>(v)); v = fmaxf(v, sx<16>(v)); return max32(v); }

#define XB_TMO      128
#define XB_XCNT(j)  (256  + 64 * (j))
#define XB_XSUB(j)  (1280 + 64 * (j))
#define XB_XGEN(j)  (2304 + 64 * (j))
#define XB_TOP      3328
#define XB_TOPGEN   3392
#define XCD_BAR_WORDS 3456
#define XB_SPIN_CAP (1u << 18)
__device__ __forceinline__ unsigned xb_ld(unsigned* p)              { return __hip_atomic_load(p, __ATOMIC_RELAXED, __HIP_MEMORY_SCOPE_AGENT); }
__device__ __forceinline__ unsigned xb_add(unsigned* p, unsigned v) { return __hip_atomic_fetch_add(p, v, __ATOMIC_RELAXED, __HIP_MEMORY_SCOPE_AGENT); }
__device__ __forceinline__ unsigned xb_xcc_id() { return (unsigned)__builtin_amdgcn_s_getreg((3 << 11) | 20) & 0xFu; }
#define XB_SPIN(cond, bar) do { unsigned _sp = 0; while (cond) { __builtin_amdgcn_s_sleep(1); \
    if ((++_sp & 255u) == 0u) { if (xb_ld(&(bar)[XB_TMO])) break; if (_sp > XB_SPIN_CAP) { atomicAdd(&(bar)[XB_TMO], 1u); break; } } } } while (0)
struct XcdBarrier { unsigned* bar; unsigned x; volatile LAS unsigned* st; };
__device__ __forceinline__ XcdBarrier xcd_barrier_post(unsigned* bar, volatile LAS unsigned* st, int tid) {
    XcdBarrier b; b.bar = bar; b.x = 0; b.st = st;
    if (tid == 0) { const unsigned xcc = xb_xcc_id(); st[2] = xb_add(&bar[XB_XCNT(xcc)], 1u); st[3] = xcc; }
    return b;
}
__device__ __forceinline__ void xcd_barrier_complete(unsigned* bar, unsigned x, unsigned& nloc, unsigned& nx) {
    const unsigned G = gridDim.x * gridDim.y * gridDim.z;
    unsigned sum, cnt, mine, sp = 0u;
    for (;;) {
        sum = 0u; cnt = 0u; mine = 0u;
#pragma unroll
        for (unsigned j = 0; j < 16; ++j) { const unsigned c = xb_ld(&bar[XB_XCNT(j)]); sum += c; cnt += (c > 0u) ? 1u : 0u; mine = (j == x) ? c : mine; }
        if (sum == G) break;
        __builtin_amdgcn_s_sleep(1);
        if ((++sp & 255u) == 0u) { if (xb_ld(&bar[XB_TMO])) break; if (sp > XB_SPIN_CAP) { atomicAdd(&bar[XB_TMO], 1u); break; } }
    }
    nloc = mine > 0u ? mine : 1u; nx = cnt > 0u ? cnt : 1u;
}
__device__ __forceinline__ void xcd_barrier(const XcdBarrier& b, int wv) {
    asm volatile("s_waitcnt vmcnt(0)" ::: "memory");
    __syncthreads();
    if (ptid(wv) == 0) {
        unsigned* bar = b.bar; const unsigned bx = xb_xcc_id();
        __builtin_amdgcn_s_waitcnt(0);
        unsigned nloc = b.st[0], nx = b.st[1];
        if (nloc == 0u) { xcd_barrier_complete(bar, bx, nloc, nx); b.st[0] = nloc; b.st[1] = nx; }
        const unsigned old = xb_add(&bar[XB_XSUB(bx)], 1u);
        const unsigned gen = old / nloc;
        if (old + 1u == (gen + 1u) * nloc) {
            __builtin_amdgcn_fence(__ATOMIC_RELEASE, "agent");
            asm volatile("s_waitcnt vmcnt(0)" ::: "memory");
            const unsigned og = xb_add(&bar[XB_TOP], 1u);
            const unsigned tg = og / nx;
            if (og + 1u == (tg + 1u) * nx) xb_add(&bar[XB_TOPGEN], 1u);
            else XB_SPIN(xb_ld(&bar[XB_TOPGEN]) == tg, bar);
            __builtin_amdgcn_fence(__ATOMIC_ACQUIRE, "agent");
            xb_add(&bar[XB_XGEN(bx)], 1u);
            asm volatile("s_waitcnt vmcnt(0)" ::: "memory");
        } else {
            XB_SPIN(xb_ld(&bar[XB_XGEN(bx)]) == gen, bar);
            __builtin_amdgcn_fence(__ATOMIC_ACQUIRE, "agent");
            asm volatile("s_waitcnt vmcnt(0)" ::: "memory");
        }
    }
    __syncthreads();
}

__device__ __forceinline__ void local_barrier(unsigned* bar, unsigned* lb, unsigned gsize, int wv) {
    asm volatile("s_waitcnt vmcnt(0)" ::: "memory");
    __syncthreads();
    if (ptid(wv) == 0) {
        __builtin_amdgcn_s_waitcnt(0);
        const unsigned old = xb_add(lb, 1u), target = (old / gsize + 1u) * gsize;
        XB_SPIN(xb_ld(lb) < target, bar);
        __builtin_amdgcn_fence(__ATOMIC_ACQUIRE, "agent");
        asm volatile("s_waitcnt vmcnt(0)" ::: "memory");
    }
    __syncthreads();
}

namespace pg8 {
constexpr int BM = 256, BK = 64, HALF = 128, HTB = HALF * BK * 2, STAGE_BYTES = 8 * HTB;
__device__ __forceinline__ int lds_byte(int r, int c) { const int st = (r >> 4) * 2 + (c >> 5), rr = r & 15, cc = c & 31, ob = rr * 64 + cc * 2; return st * 1024 + (ob ^ (((ob >> 9) & 1) << 5)); }
__device__ __forceinline__ void stage_rc(int b, int& R, int& C) { const int st = b / 1024, sb = b % 1024, swz = sb ^ (((sb >> 9) & 1) << 5); R = (st >> 1) * 16 + swz / 64; C = (st & 1) * 32 + (swz % 64) / 2; }
__device__ __forceinline__ int perm32(int rho) { const int n = rho >> 4, i = rho & 15; return 8 * (i >> 2) + 4 * n + (i & 3); }

struct GUnit { const char* a; const char* b; int nt; int pm, pn, ks; };

template <bool I8> struct AccT { typedef f32x4 T; };
template <> struct AccT<true> { typedef i32x4 T; };
template <class Epi, class Sched, bool ALIGN_EPI, bool SP2, bool I8 = false>
__device__ __forceinline__ void gemm_phase(LAS unsigned char* lds, const Sched& S, const Epi& E, int wv) {
    const int tid = ptid(wv);
    const int wid = wv, lane = tid & 63, wr = wid >> 2, wc = wid & 3, fr = lane & 15, fq = lane >> 4;
    unsigned cvA0, cvA1, cvB0, cvB1;
    { int R0, C0, R1, C1; stage_rc(tid * 16, R0, C0); stage_rc(tid * 16 + 8192, R1, C1);
      const int Rb0 = Epi::PERM ? ((R0 & ~31) + perm32(R0 & 31)) : R0, Rb1 = Epi::PERM ? ((R1 & ~31) + perm32(R1 & 31)) : R1;
      cvA0 = (unsigned)(R0 * S.lda2 + C0 * 2); cvA1 = (unsigned)(R1 * S.lda2 + C1 * 2); cvB0 = (unsigned)(Rb0 * S.ldb2 + C0 * 2); cvB1 = (unsigned)(Rb1 * S.ldb2 + C1 * 2); }
    const unsigned ldsw = (unsigned)wid * 1024u;
    const int aoff = lds_byte(wr * 64 + fr, fq * 8), boff = lds_byte(wc * 32 + fr, fq * 8);
#define PG8_SA(b, h) (((b) * 2 + (h)) * HTB)
#define PG8_SB(b, h) ((4 + (b) * 2 + (h)) * HTB)
#define PG8_STAGE(bufoff, gbase, v0, v1) do { \
        __builtin_amdgcn_global_load_lds((const unsigned*)((const char*)(gbase) + (v0)), (LAS unsigned*)(lds + (bufoff) + ldsw), 16, 0, 0); \
        __builtin_amdgcn_global_load_lds((const unsigned*)((const char*)(gbase) + (v1)), (LAS unsigned*)(lds + (bufoff) + ldsw + 8192), 16, 0, 0); } while (0)
#define PG8_LDA(dst, b, h) do { _Pragma("unroll") for (int m = 0; m < 4; ++m) _Pragma("unroll") for (int k = 0; k < 2; ++k) dst[m][k] = *(const LAS bf16x8*)(lds + PG8_SA(b, h) + aoff + m * 2048 + k * 1024); } while (0)
#define PG8_LDB(dst, b, h) do { _Pragma("unroll") for (int n = 0; n < 2; ++n) _Pragma("unroll") for (int k = 0; k < 2; ++k) dst[n][k] = *(const LAS bf16x8*)(lds + PG8_SB(b, h) + boff + n * 2048 + k * 1024); } while (0)
#define PG8_MMA(ai, bj, At, Bt) do { __builtin_amdgcn_s_setprio(1); _Pragma("unroll") for (int m = 0; m < 4; ++m) _Pragma("unroll") for (int n = 0; n < 2; ++n) _Pragma("unroll") for (int k = 0; k < 2; ++k) { \
        if constexpr (I8) acc[ai][bj][m][n] = __builtin_amdgcn_mfma_i32_16x16x64_i8(__builtin_bit_cast(i32x4, Bt[n][k]), __builtin_bit_cast(i32x4, At[m][k]), acc[ai][bj][m][n], 0, 0, 0); \
        else acc[ai][bj][m][n] = __builtin_amdgcn_mfma_f32_16x16x32_bf16(Bt[n][k], At[m][k], acc[ai][bj][m][n], 0, 0, 0); } __builtin_amdgcn_s_setprio(0); } while (0)
#define PG8_WAIT_V(n) asm volatile("s_waitcnt vmcnt(" #n ")" ::: "memory")
#define PG8_WAIT_L(n) asm volatile("s_waitcnt lgkmcnt(" #n ")" ::: "memory")
#define PG8_BAR __builtin_amdgcn_s_barrier()
#define PG8_SCHED __builtin_amdgcn_sched_barrier(0)
    GUnit cur, nxt; int ui = 0;
    if (!S.next(0, cur)) return;
    typedef typename AccT<I8>::T acc_t;
    acc_t acc[2][2][4][2];
    acc_t zz = (acc_t){0, 0, 0, 0}; asm volatile("" : "+v"(zz));
#pragma unroll
    for (int a = 0; a < 2; ++a)
#pragma unroll
        for (int b = 0; b < 2; ++b)
#pragma unroll
            for (int m = 0; m < 4; ++m)
#pragma unroll
                for (int n = 0; n < 2; ++n) acc[a][b][m][n] = zz;
    bf16x8 At[4][2], B0[2][2], B1[2][2];
    const size_t chA = (size_t)HALF * S.lda2, chB = (size_t)HALF * S.ldb2;
    const size_t kstep = (size_t)(BK * 2);
    const char* cA = cur.a; const char* cB = cur.b;
    if constexpr (SP2) {
        PG8_STAGE(PG8_SB(0, 0), cB, cvB0, cvB1); PG8_STAGE(PG8_SB(0, 1), cB + chB, cvB0, cvB1); PG8_STAGE(PG8_SA(0, 0), cA, cvA0, cvA1); PG8_STAGE(PG8_SA(0, 1), cA + chA, cvA0, cvA1);
        if (wr == 1) PG8_BAR;
        PG8_WAIT_V(2); PG8_BAR;
        PG8_STAGE(PG8_SB(1, 0), cB + kstep, cvB0, cvB1); PG8_STAGE(PG8_SA(1, 0), cA + kstep, cvA0, cvA1); PG8_STAGE(PG8_SB(1, 1), cB + chB + kstep, cvB0, cvB1);
        PG8_WAIT_V(6); PG8_BAR;
    } else {
        PG8_STAGE(PG8_SB(0, 0), cB, cvB0, cvB1); PG8_STAGE(PG8_SA(0, 0), cA, cvA0, cvA1); PG8_STAGE(PG8_SB(0, 1), cB + chB, cvB0, cvB1); PG8_STAGE(PG8_SA(0, 1), cA + chA, cvA0, cvA1);
        if (wr == 1) PG8_BAR;
        PG8_WAIT_V(4); PG8_BAR;
        PG8_STAGE(PG8_SB(1, 0), cB + kstep, cvB0, cvB1); PG8_STAGE(PG8_SA(1, 0), cA + kstep, cvA0, cvA1); PG8_STAGE(PG8_SB(1, 1), cB + chB + kstep, cvB0, cvB1);
        PG8_WAIT_V(6); PG8_BAR;
    }
    for (;;) {
        const bool has_next = S.next(ui + 1, nxt);
        const char* nA = has_next ? nxt.a : cA; const char* nB = has_next ? nxt.b : cB;
        int nt = cur.nt; asm volatile("" : "+s"(nt));
        for (int t = 0; t < nt; t += 2) {
            const bool last = (t == nt - 2);
            const char* a1 = cA + (size_t)(t + 1) * kstep;
            const char* a2 = last ? nA : cA + (size_t)(t + 2) * kstep; const char* b2 = last ? nB : cB + (size_t)(t + 2) * kstep;
            const char* a3 = a2 + kstep; const char* b3 = b2 + kstep;
            if constexpr (SP2) {
            PG8_LDB(B0, 0, 0); PG8_LDB(B1, 0, 1); PG8_SCHED; PG8_LDA(At, 0, 0); PG8_STAGE(PG8_SA(1, 1), a1 + chA, cvA0, cvA1);
            PG8_WAIT_V(8); PG8_WAIT_L(0); PG8_BAR; PG8_MMA(0, 0, At, B0); PG8_MMA(0, 1, At, B1); PG8_BAR; PG8_SCHED;
            PG8_LDA(At, 0, 1); PG8_STAGE(PG8_SB(0, 0), b2, cvB0, cvB1); PG8_STAGE(PG8_SB(0, 1), b2 + chB, cvB0, cvB1); PG8_STAGE(PG8_SA(0, 0), a2, cvA0, cvA1);
            PG8_WAIT_V(8); PG8_WAIT_L(0); PG8_BAR; PG8_MMA(1, 0, At, B0); PG8_MMA(1, 1, At, B1); PG8_BAR; PG8_SCHED;
            PG8_LDB(B0, 1, 0); PG8_LDB(B1, 1, 1); PG8_SCHED; PG8_LDA(At, 1, 0); PG8_STAGE(PG8_SA(0, 1), a2 + chA, cvA0, cvA1);
            PG8_WAIT_V(8); PG8_WAIT_L(0); PG8_BAR; PG8_MMA(0, 0, At, B0); PG8_MMA(0, 1, At, B1); PG8_BAR; PG8_SCHED;
            PG8_LDA(At, 1, 1); PG8_STAGE(PG8_SB(1, 0), b3, cvB0, cvB1); PG8_STAGE(PG8_SB(1, 1), b3 + chB, cvB0, cvB1); PG8_STAGE(PG8_SA(1, 0), a3, cvA0, cvA1);
            PG8_WAIT_V(8); PG8_WAIT_L(0); PG8_BAR; PG8_MMA(1, 0, At, B0); PG8_MMA(1, 1, At, B1); PG8_BAR; PG8_SCHED;
            } else {
            PG8_LDB(B0, 0, 0); PG8_SCHED; PG8_LDA(At, 0, 0); PG8_STAGE(PG8_SA(1, 1), a1 + chA, cvA0, cvA1);
            PG8_WAIT_L(8); PG8_BAR; PG8_WAIT_L(0); PG8_MMA(0, 0, At, B0); PG8_BAR; PG8_SCHED;
            PG8_LDB(B1, 0, 1); PG8_STAGE(PG8_SB(0, 0), b2, cvB0, cvB1);
            PG8_BAR; PG8_WAIT_L(0); PG8_MMA(0, 1, At, B1); PG8_BAR;
            PG8_LDA(At, 0, 1); PG8_STAGE(PG8_SA(0, 0), a2, cvA0, cvA1);
            PG8_BAR; PG8_WAIT_L(0); PG8_MMA(1, 0, At, B0); PG8_BAR; PG8_SCHED;
            PG8_STAGE(PG8_SB(0, 1), b2 + chB, cvB0, cvB1);
            PG8_WAIT_V(6); PG8_BAR; PG8_MMA(1, 1, At, B1); PG8_BAR;
            PG8_LDB(B0, 1, 0); PG8_SCHED; PG8_LDA(At, 1, 0); PG8_STAGE(PG8_SA(0, 1), a2 + chA, cvA0, cvA1);
            PG8_WAIT_L(8); PG8_BAR; PG8_WAIT_L(0); PG8_MMA(0, 0, At, B0); PG8_BAR; PG8_SCHED;
            PG8_LDB(B1, 1, 1); PG8_STAGE(PG8_SB(1, 0), b3, cvB0, cvB1);
            PG8_BAR; PG8_WAIT_L(0); PG8_MMA(0, 1, At, B1); PG8_BAR;
            PG8_LDA(At, 1, 1); PG8_STAGE(PG8_SA(1, 0), a3, cvA0, cvA1);
            PG8_BAR; PG8_WAIT_L(0); PG8_MMA(1, 0, At, B0); PG8_BAR; PG8_SCHED;
            PG8_STAGE(PG8_SB(1, 1), b3 + chB, cvB0, cvB1);
            PG8_WAIT_V(6); PG8_BAR; PG8_MMA(1, 1, At, B1); PG8_BAR;
            }
        }
        unsigned long long te0_ = 0; const bool tse_ = ((TSMASK >> 12) & 1) && blockIdx.x == 0 && wv == 0;
        if (tse_) te0_ = __builtin_amdgcn_s_memrealtime();
        if constexpr (ALIGN_EPI) { if (wr == 0) PG8_BAR; }
        E(acc, cur, S, wr, wc, fr, fq);
        if (tse_) { volatile LAS unsigned* ta_ = (volatile LAS unsigned*)(lds + 135168 + 8); ta_[0] += (unsigned)(__builtin_amdgcn_s_memrealtime() - te0_); }
        if (!has_next) break;
        acc_t z2 = (acc_t){0, 0, 0, 0}; asm volatile("" : "+v"(z2));
#pragma unroll
        for (int a = 0; a < 2; ++a)
#pragma unroll
            for (int b = 0; b < 2; ++b)
#pragma unroll
                for (int m = 0; m < 4; ++m)
#pragma unroll
                    for (int n = 0; n < 2; ++n) acc[a][b][m][n] = z2;
        cur = nxt; cA = nA; cB = nB; ++ui;
        if constexpr (ALIGN_EPI) { if (wr == 1) PG8_BAR; }
    }
    PG8_WAIT_V(0);
    if constexpr (!ALIGN_EPI) { if (wr == 0) PG8_BAR; }
    PG8_BAR;
#undef PG8_SA
#undef PG8_SB
#undef PG8_STAGE
#undef PG8_LDA
#undef PG8_LDB
#undef PG8_MMA
#undef PG8_WAIT_V
#undef PG8_WAIT_L
#undef PG8_BAR
#undef PG8_SCHED
}

struct SchedStd {
    const char* A; const char* Bt; int lda2, ldb2, nt; int nM, nN, nwg, G, c; char* O; int ldc, otile;
    int gx, grk;
    __device__ __forceinline__ bool next(int i, GUnit& u) const {
        if (G == 256) { const int uu = i * 32 + grk; if (uu >= 5 * nN) return false;
            const int pl = uu % 5; u.pm = pl < 4 ? 4 * gx + pl : 32 + gx; u.pn = uu / 5; u.ks = -1;
            u.a = A + (size_t)u.pm * 256 * lda2; u.b = Bt + (size_t)u.pn * 256 * ldb2; u.nt = nt; return true; }
        const long L = (long)i * G + c; if (L >= nwg) return false;
        int wgid = (int)L; { const int q = nwg / 8, r = nwg % 8, xcd = wgid % 8, off = wgid / 8; wgid = (xcd < r ? xcd * (q + 1) : r * (q + 1) + (xcd - r) * q) + off; }
        const int nig = 8 * nN, gid = wgid / nig, fm = gid * 8, gsz = (nM - fm) < 8 ? (nM - fm) : 8;
        u.pm = fm + ((wgid % nig) % gsz); u.pn = (wgid % nig) / gsz; u.ks = -1;
        u.a = A + (size_t)u.pm * 256 * lda2; u.b = Bt + (size_t)u.pn * 256 * ldb2; u.nt = nt;
        return true;
    }
    __device__ __forceinline__ void out(const GUnit& u, char*& o, int& ld) const { o = O + ((size_t)u.pm * 256 * ldc + (size_t)u.pn * otile) * 2; ld = ldc; }
};
struct SchedSplit {
    const char* A; const char* Bt; int lda2, ldb2, ntot, kq; int G, c; int gx, grk;
    __device__ __forceinline__ bool next(int i, GUnit& u) const {
        int L = i * G + c; if (L >= 512) return false;
        const int Lr = L & 255; int x = Lr & 7, j = Lr >> 3, kt0 = 0;
        if (G == 256) { x = gx; j = grk; if (grk & 1) L ^= 256; }
        if (L < 256) { u.pm = 4 * x + (j >> 3); u.pn = j & 7; u.ks = -1; u.nt = ntot; }
        else { u.pm = 32 + x; u.pn = j & 7; u.ks = j >> 3; kt0 = u.ks * kq; u.nt = (u.ks < 3) ? kq : ntot - 3 * kq; }
        u.a = A + (size_t)u.pm * 256 * lda2 + (size_t)kt0 * 128; u.b = Bt + (size_t)u.pn * 256 * ldb2 + (size_t)kt0 * 128;
        return true;
    }
};
struct SchedF1 {
    const char* T; const char* mixin; char* gtp; char* gts; int lda2, ldb2; int G, c;
    __device__ __forceinline__ bool next(int i, GUnit& u) const {
        const int L = i * G + c; if (L >= 320) return false;
        u.nt = 4; u.ks = L;
        if (L < 256) { const int bg = L >> 1, b = bg >> 2, g = bg & 3; u.pm = L & 1; u.pn = 0;
            u.b = mixin + ((size_t)(b * 256) * NIN_E + 2048 + g * 256) * 2; }
        else { const int l2 = L - 256, bg = l2 >> 3, b = bg >> 2, g = bg & 3; u.pm = (l2 >> 2) & 1; u.pn = l2 & 3;
            u.b = mixin + ((size_t)(MP + b * 1024 + u.pn * 256) * NIN_E + 2048 + g * 256) * 2; }
        u.a = T + (size_t)u.pm * 256 * 512;
        return true;
    }
    __device__ __forceinline__ void out(const GUnit& u, char*& o, int& ld) const { const int L = u.ks; ld = 2048;
        if (L < 256) o = gtp + ((size_t)(L >> 1) * 256 * 2048 + (size_t)u.pm * 256) * 2;
        else o = gts + ((size_t)((L - 256) >> 3) * 256 * 2048 + (size_t)u.pm * 1024 + u.pn * 256) * 2; }
};
struct SchedF2 {
    const char* cs256; const char* cs1024; const char* gtp; const char* gts; char* mixout; int lda2, ldb2; int G, c;
    __device__ __forceinline__ bool next(int i, GUnit& u) const {
        const int L = i * G + c; if (L >= 160) return false;
        u.ks = L; u.pn = 0;
        if (L < 32) { const int bg = L >> 2; u.pm = L & 3; u.nt = 32; u.a = cs1024 + (size_t)u.pm * 256 * 4096; u.b = gts + (size_t)bg * 256 * 2048 * 2; }
        else { const int bg = L - 32; u.pm = 0; u.nt = 8; u.a = cs256; u.b = gtp + (size_t)bg * 256 * 2048 * 2; }
        return true;
    }
    __device__ __forceinline__ void out(const GUnit& u, char*& o, int& ld) const { const int L = u.ks; ld = DM;
        if (L < 32) { const int bg = L >> 2, b = bg >> 2, g = bg & 3; o = mixout + ((size_t)(MP + b * 1024 + u.pm * 256) * DM + 1024 + g * 256) * 2; }
        else { const int bg = L - 32, b = bg >> 2, g = bg & 3; o = mixout + ((size_t)(b * 256) * DM + 1024 + g * 256) * 2; } }
};

struct EpiBf16 {
    static constexpr bool PERM = true;
    float scale;
    template <class Sched>
    __device__ __forceinline__ void operator()(const f32x4 (&acc)[2][2][4][2], const GUnit& u, const Sched& S, int wr, int wc, int fr, int fq) const {
        char* o; int ldc; S.out(u, o, ldc); bf16_t* T = (bf16_t*)o;
        const unsigned off0 = (unsigned)((wr * 64 + fr) * ldc + wc * 32 + 8 * fq);
#pragma unroll
        for (int ai = 0; ai < 2; ++ai)
#pragma unroll
            for (int m = 0; m < 4; ++m) { const unsigned off = off0 + (unsigned)((ai * HALF + m * 16) * ldc);
#pragma unroll
                for (int bj = 0; bj < 2; ++bj) { const f32x4 v0 = acc[ai][bj][m][0] * scale, v1 = acc[ai][bj][m][1] * scale;
                    u32x4 w; w.x = cvt_pk_bf16(v0[0], v0[1]); w.y = cvt_pk_bf16(v0[2], v0[3]); w.z = cvt_pk_bf16(v1[0], v1[1]); w.w = cvt_pk_bf16(v1[2], v1[3]);
                    *(u32x4*)(T + off + bj * HALF) = w; } }
    }
};
struct EpiF2 { static constexpr bool PERM = true;
    template <class Sched>
    __device__ __forceinline__ void operator()(const f32x4 (&acc)[2][2][4][2], const GUnit& u, const Sched& S, int wr, int wc, int fr, int fq) const {
        EpiBf16 e{u.nt == 32 ? 1.0f / 512.0f : 1.0f / 256.0f}; e(acc, u, S, wr, wc, fr, fq); } };
struct EpiGU {
    static constexpr bool PERM = true;
    template <class Sched>
    __device__ __forceinline__ void operator()(const f32x4 (&acc)[2][2][4][2], const GUnit& u, const Sched& S, int wr, int wc, int fr, int fq) const {
        char* o; int ldc; S.out(u, o, ldc); bf16_t* T = (bf16_t*)o;
        const unsigned off0 = (unsigned)((wr * 64 + fr) * ldc + wc * 32 + 8 * fq);
#pragma unroll
        for (int ai = 0; ai < 2; ++ai)
#pragma unroll
            for (int m = 0; m < 4; ++m) { const unsigned off = off0 + (unsigned)((ai * HALF + m * 16) * ldc); float t[8], r[8];
#pragma unroll
                for (int i = 0; i < 8; ++i) t[i] = acc[ai][0][m][i >> 2][i & 3] * -1.4426950408889634f;
#pragma unroll
                for (int i = 0; i < 8; ++i) t[i] = __builtin_amdgcn_exp2f(t[i]);
#pragma unroll
                for (int i = 0; i < 8; ++i) t[i] = t[i] + 1.0f;
#pragma unroll
                for (int i = 0; i < 8; ++i) t[i] = __builtin_amdgcn_rcpf(t[i]);
#pragma unroll
                for (int i = 0; i < 8; ++i) r[i] = (acc[ai][0][m][i >> 2][i & 3] * acc[ai][1][m][i >> 2][i & 3]) * t[i];
                asm volatile("" : "+v"(r[0]), "+v"(r[1]), "+v"(r[2]), "+v"(r[3]), "+v"(r[4]), "+v"(r[5]), "+v"(r[6]), "+v"(r[7]));
                u32x4 w; w.x = cvt_pk_bf16(r[0], r[1]); w.y = cvt_pk_bf16(r[2], r[3]); w.z = cvt_pk_bf16(r[4], r[5]); w.w = cvt_pk_bf16(r[6], r[7]);
                *(u32x4*)(T + off) = w; }
    }
};
struct EpiGU8 {
    static constexpr bool PERM = true;
    const float* rsc; const float* cmax;
    template <class Sched>
    __device__ __forceinline__ void operator()(const i32x4 (&acc)[2][2][4][2], const GUnit& u, const Sched& S, int wr, int wc, int fr, int fq) const {
        char* o; int ldc; S.out(u, o, ldc); bf16_t* T = (bf16_t*)o;
        const unsigned off0 = (unsigned)((wr * 64 + fr) * ldc + wc * 32 + 4 * fq);
        bf16x8 hf[2];
#pragma unroll
        for (int nt = 0; nt < 2; ++nt) { u32x4 hw;
#pragma unroll
            for (int p = 0; p < 4; ++p) { const unsigned s0 = __builtin_popcount((unsigned)((8 * fq + 2 * p) & (16 * nt + fr))) & 1u, s1 = __builtin_popcount((unsigned)((8 * fq + 2 * p + 1) & (16 * nt + fr))) & 1u;
                hw[p] = (s0 ? 0xbf80u : 0x3f80u) | ((s1 ? 0xbf80u : 0x3f80u) << 16); }
            hf[nt] = __builtin_bit_cast(bf16x8, hw); }
        const float* cp = cmax + u.pn * BM + wc * 32 + 8 * fq;
        f32x4 cs[2][2];
#pragma unroll
        for (int bj = 0; bj < 2; ++bj)
#pragma unroll
            for (int n = 0; n < 2; ++n) cs[bj][n] = *(const f32x4*)(cp + bj * HALF + 4 * n) * (1.0f / 127.0f);
        const float* rp = rsc + u.pm * BM + wr * 64 + fr;
#pragma unroll
        for (int ai = 0; ai < 2; ++ai)
#pragma unroll
            for (int m = 0; m < 4; ++m) { const unsigned off = off0 + (unsigned)((ai * HALF + m * 16) * ldc); float t[8], gg[8], r[8];
                const float rs = rp[ai * HALF + m * 16];
#pragma unroll
                for (int i = 0; i < 8; ++i) gg[i] = (float)acc[ai][0][m][i >> 2][i & 3] * (rs * cs[0][i >> 2][i & 3]);
#pragma unroll
                for (int i = 0; i < 8; ++i) t[i] = gg[i] * -1.4426950408889634f;
#pragma unroll
                for (int i = 0; i < 8; ++i) t[i] = __builtin_amdgcn_exp2f(t[i]);
#pragma unroll
                for (int i = 0; i < 8; ++i) t[i] = t[i] + 1.0f;
#pragma unroll
                for (int i = 0; i < 8; ++i) t[i] = __builtin_amdgcn_rcpf(t[i]);
#pragma unroll
                for (int i = 0; i < 8; ++i) r[i] = (gg[i] * ((float)acc[ai][1][m][i >> 2][i & 3] * (rs * cs[1][i >> 2][i & 3]))) * t[i];
                asm volatile("" : "+v"(r[0]), "+v"(r[1]), "+v"(r[2]), "+v"(r[3]), "+v"(r[4]), "+v"(r[5]), "+v"(r[6]), "+v"(r[7]));
                u32x4 w; w.x = cvt_pk_bf16_b(r[0], r[1]); w.y = cvt_pk_bf16_b(r[2], r[3]); w.z = cvt_pk_bf16_b(r[4], r[5]); w.w = cvt_pk_bf16_b(r[6], r[7]);
                const bf16x8 af = __builtin_bit_cast(bf16x8, w);
                float zf = 0.f; asm volatile("" : "+v"(zf));
                const f32x4 z4 = {zf, zf, zf, zf};
                const f32x4 h0 = __builtin_amdgcn_mfma_f32_16x16x32_bf16(hf[0], af, z4, 0, 0, 0), h1 = __builtin_amdgcn_mfma_f32_16x16x32_bf16(hf[1], af, z4, 0, 0, 0);
                u32x2 o0, o1; o0.x = cvt_pk_bf16_b(h0[0], h0[1]); o0.y = cvt_pk_bf16_b(h0[2], h0[3]); o1.x = cvt_pk_bf16_b(h1[0], h1[1]); o1.y = cvt_pk_bf16_b(h1[2], h1[3]);
                *(u32x2*)(T + off) = o0; *(u32x2*)(T + off + 16) = o1;
                __builtin_amdgcn_sched_barrier(0); }
    }
};
struct EpiResid8 {
    static constexpr bool PERM = false;
    float* x; const float* gate; float coef; float* slab; const float* rsc; const float* cmax;
    template <class Sched>
    __device__ __forceinline__ void operator()(const i32x4 (&acc)[2][2][4][2], const GUnit& u, const Sched& S, int wr, int wc, int fr, int fq) const {
        const unsigned off0 = (unsigned)((wr * 64 + fr) * DM + wc * 32 + 4 * fq);
        const float* cp = cmax + u.pn * BM + wc * 32 + 4 * fq;
        const float* rp = rsc + u.pm * BM + wr * 64 + fr;
        float rsv[8];
#pragma unroll
        for (int i = 0; i < 8; ++i) rsv[i] = rp[(i >> 2) * HALF + (i & 3) * 16];
        f32x4 gv[2][2];
        if (u.ks < 0) { const float* gt = gate + u.pn * BM + wc * 32 + 4 * fq;
#pragma unroll
            for (int bj = 0; bj < 2; ++bj)
#pragma unroll
                for (int n = 0; n < 2; ++n) gv[bj][n] = (*(const f32x4*)(gt + bj * HALF + n * 16) * coef) * (*(const f32x4*)(cp + bj * HALF + n * 16) * (1.0f / 127.0f));
        } else {
#pragma unroll
            for (int bj = 0; bj < 2; ++bj)
#pragma unroll
                for (int n = 0; n < 2; ++n) gv[bj][n] = *(const f32x4*)(cp + bj * HALF + n * 16) * (1.0f / 127.0f);
        }
        asm volatile("" : "+v"(rsv[0]), "+v"(rsv[1]), "+v"(rsv[2]), "+v"(rsv[3]), "+v"(rsv[4]), "+v"(rsv[5]), "+v"(rsv[6]), "+v"(rsv[7]));
        if (u.ks < 0) {
            float* T = x + (size_t)u.pm * BM * DM + u.pn * BM;
#pragma unroll
            for (int ai = 0; ai < 2; ++ai)
#pragma unroll
                for (int m = 0; m < 4; ++m) { const unsigned off = off0 + (unsigned)((ai * HALF + m * 16) * DM); const float rs = rsv[ai * 4 + m];
#pragma unroll
                    for (int bj = 0; bj < 2; ++bj)
#pragma unroll
                        for (int n = 0; n < 2; ++n) { f32x4* p = (f32x4*)(T + off + bj * HALF + n * 16); const i32x4 a = acc[ai][bj][m][n];
                            const f32x4 af = {(float)a[0], (float)a[1], (float)a[2], (float)a[3]}; *p = *p + (gv[bj][n] * rs) * af; }
                    if (m == 3) asm volatile("" ::: "memory"); }
        } else {
            bf16_t* T = (bf16_t*)slab + (size_t)u.ks * MS * DM + (size_t)(u.pm - 32) * BM * DM + u.pn * BM;
#pragma unroll
            for (int ai = 0; ai < 2; ++ai)
#pragma unroll
                for (int m = 0; m < 4; ++m) { const unsigned off = off0 + (unsigned)((ai * HALF + m * 16) * DM); const float rs = rsv[ai * 4 + m];
#pragma unroll
                    for (int bj = 0; bj < 2; ++bj)
#pragma unroll
                        for (int n = 0; n < 2; ++n) { const i32x4 a = acc[ai][bj][m][n]; const f32x4 v = (f32x4){(float)a[0], (float)a[1], (float)a[2], (float)a[3]} * (gv[bj][n] * rs);
                            u32x2 w; w.x = cvt_pk_bf16(v[0], v[1]); w.y = cvt_pk_bf16(v[2], v[3]); *(u32x2*)(T + off + bj * HALF + n * 16) = w; } }
        }
    }
};
struct EpiResid {
    static constexpr bool PERM = false;
    float* x; const float* gate; float coef; float* slab;
    template <class Sched>
    __device__ __forceinline__ void operator()(const f32x4 (&acc)[2][2][4][2], const GUnit& u, const Sched& S, int wr, int wc, int fr, int fq) const {
        const unsigned off0 = (unsigned)((wr * 64 + fr) * DM + wc * 32 + 4 * fq);
        if (u.ks < 0) {
            float* T = x + (size_t)u.pm * BM * DM + u.pn * BM; const float* gt = gate + u.pn * BM + wc * 32 + 4 * fq;
            f32x4 gv[2][2];
#pragma unroll
            for (int bj = 0; bj < 2; ++bj)
#pragma unroll
                for (int n = 0; n < 2; ++n) gv[bj][n] = *(const f32x4*)(gt + bj * HALF + n * 16) * coef;
#pragma unroll
            for (int ai = 0; ai < 2; ++ai)
#pragma unroll
                for (int m = 0; m < 4; ++m) { const unsigned off = off0 + (unsigned)((ai * HALF + m * 16) * DM);
#pragma unroll
                    for (int bj = 0; bj < 2; ++bj)
#pragma unroll
                        for (int n = 0; n < 2; ++n) { f32x4* p = (f32x4*)(T + off + bj * HALF + n * 16); *p = *p + gv[bj][n] * acc[ai][bj][m][n]; }
                    if (m == 3) asm volatile("" ::: "memory"); }
        } else {
            bf16_t* T = (bf16_t*)slab + (size_t)u.ks * MS * DM + (size_t)(u.pm - 32) * BM * DM + u.pn * BM;
#pragma unroll
            for (int ai = 0; ai < 2; ++ai)
#pragma unroll
                for (int m = 0; m < 4; ++m) { const unsigned off = off0 + (unsigned)((ai * HALF + m * 16) * DM);
#pragma unroll
                    for (int bj = 0; bj < 2; ++bj)
#pragma unroll
                        for (int n = 0; n < 2; ++n) { const f32x4 v = acc[ai][bj][m][n]; u32x2 w; w.x = cvt_pk_bf16(v[0], v[1]); w.y = cvt_pk_bf16(v[2], v[3]); *(u32x2*)(T + off + bj * HALF + n * 16) = w; } }
        }
    }
};
}

namespace att {
constexpr int D = 128, QBLK = 32, KVBLK = 64;
constexpr float SCALE = 0.088388347648318440f;
constexpr float THR = 8.f;
constexpr float NEG = -1e30f;
constexpr size_t SHM_V = KVBLK * D * 2, SHM_K = KVBLK * D * 2, SHM_ATTN = 2 * SHM_V + 2 * SHM_K + 8 * 64 * 4;
constexpr int RPB_OFF = (int)SHM_ATTN;
#define KSWZ(row, colB) ((row) * 256 + ((colB) ^ (((row) & 7) << 4)))
#define SBAR() __builtin_amdgcn_sched_barrier(0)
__device__ __forceinline__ int crow(int r, int hi) { return (r & 3) + 8 * (r >> 2) + 4 * hi; }

struct AUnit { const bf16_t* Q; bf16_t* O; const bf16_t* Kc; const bf16_t* Vc; const bf16_t* Kl; const bf16_t* Vl; int nctx, nloc, nt, mode, q0, kt0; float m0, l0; const float* rpb; };

__device__ __forceinline__ void partialSM(f32x16& p0, f32x16& p1, float& m_reg, float& mn, float& alpha) {
  constexpr float C = SCALE * 1.4426950408889634f;
  float pmax = p0[0];
#pragma unroll
  for (int r = 1; r < 16; ++r) pmax = fmaxf(pmax, p0[r]);
#pragma unroll
  for (int r = 0; r < 16; ++r) pmax = fmaxf(pmax, p1[r]);
  { auto rr = __builtin_amdgcn_permlane32_swap(__float_as_uint(pmax), __float_as_uint(pmax), false, false);
    pmax = fmaxf(__uint_as_float(rr[0]), __uint_as_float(rr[1])); }
  if (__builtin_expect(__all(pmax - m_reg <= THR / SCALE), 1)) { mn = m_reg; alpha = 1.f; }
  else { mn = fmaxf(m_reg, pmax); alpha = __builtin_amdgcn_exp2f((m_reg - mn) * C); m_reg = mn; }
  float mnC = -mn * C;
#pragma unroll
  for (int r = 0; r < 16; ++r) p0[r] = fmaf(p0[r], C, mnC);
#pragma unroll
  for (int r = 0; r < 16; ++r) p1[r] = fmaf(p1[r], C, mnC);
#pragma unroll
  for (int r = 0; r < 16; ++r) p0[r] = __builtin_amdgcn_exp2f(p0[r]);
}
__device__ __forceinline__ void finishSM(f32x16& p0, f32x16& p1, float alpha, float& l_reg, bf16x8& pa0, bf16x8& pa1, bf16x8& pa2, bf16x8& pa3) {
#pragma unroll
  for (int r = 0; r < 16; ++r) p1[r] = __builtin_amdgcn_exp2f(p1[r]);
  float ps = 0;
#pragma unroll
  for (int r = 0; r < 16; ++r) ps += p0[r];
#pragma unroll
  for (int r = 0; r < 16; ++r) ps += p1[r];
  { auto rr = __builtin_amdgcn_permlane32_swap(__float_as_uint(ps), __float_as_uint(ps), false, false);
    ps = __uint_as_float(rr[0]) + __uint_as_float(rr[1]); }
  l_reg = l_reg * alpha + ps;
#define PK4(P, BASE, OUT) do { unsigned a0 = cvt_pk_bf16(P[BASE + 0], P[BASE + 1]), a1 = cvt_pk_bf16(P[BASE + 2], P[BASE + 3]);   \
    unsigned b0 = cvt_pk_bf16(P[BASE + 4], P[BASE + 5]), b1 = cvt_pk_bf16(P[BASE + 6], P[BASE + 7]);                              \
    auto r0 = __builtin_amdgcn_permlane32_swap(a0, b0, false, false); auto r1 = __builtin_amdgcn_permlane32_swap(a1, b1, false, false); \
    u32x4 w = {r0[0], r1[0], r0[1], r1[1]}; OUT = *reinterpret_cast<bf16x8*>(&w); } while (0)
  PK4(p0, 0, pa0); PK4(p0, 8, pa1); PK4(p1, 0, pa2); PK4(p1, 8, pa3);
#undef PK4
}
__device__ __forceinline__ void qkt(f32x16& p0, f32x16& p1, const bf16_t* Ks, const bf16x8* qr, int r32, int hi) {
  p0 = f32x16{}; p1 = f32x16{};
#pragma unroll
  for (int d0 = 0; d0 < 8; ++d0) { int cb = (d0 * 16 + hi * 8) * 2;
    bf16x8 b0 = *reinterpret_cast<const bf16x8*>((const char*)Ks + KSWZ(r32, cb));
    bf16x8 b1 = *reinterpret_cast<const bf16x8*>((const char*)Ks + KSWZ(32 + r32, cb));
    p0 = __builtin_amdgcn_mfma_f32_32x32x16_bf16(b0, qr[d0], p0, 0, 0, 0);
    p1 = __builtin_amdgcn_mfma_f32_32x32x16_bf16(b1, qr[d0], p1, 0, 0, 0); }
}
__device__ __forceinline__ int v_st(int k, int c) { const int kk = (k & ~0xC) | ((k & 4) << 1) | ((k & 8) >> 1); return ((kk >> 3) * 4 + (c >> 5)) * 512 + ((kk & 7) * 32 + (c & 31)) * 2; }
__device__ __forceinline__ int v_rd_base(int lane) { return ((lane & 3) << 3) | (((lane >> 2) & 3) << 6) | (((lane >> 4) & 1) << 5) | (((lane >> 5) & 1) << 8); }
constexpr int v_rd_off(int d0, int ks, int half) { return d0 * 512 + ks * 4096 + half * 2048; }
template <int OFF> __device__ __forceinline__ s16x4 tr_read(int vb) {
  s16x4 r; asm volatile("ds_read_b64_tr_b16 %0, %1 offset:%2" : "=&v"(r) : "v"(vb), "i"(OFF) : "memory"); return r;
}
template <int D0> __device__ __forceinline__ void pv_one(f32x16& od, int vb, bf16x8 pa0, bf16x8 pa1, bf16x8 pa2, bf16x8 pa3) {
  const s16x4 l0 = tr_read<v_rd_off(D0, 0, 0)>(vb), h0 = tr_read<v_rd_off(D0, 0, 1)>(vb), l1 = tr_read<v_rd_off(D0, 1, 0)>(vb), h1 = tr_read<v_rd_off(D0, 1, 1)>(vb);
  const s16x4 l2 = tr_read<v_rd_off(D0, 2, 0)>(vb), h2 = tr_read<v_rd_off(D0, 2, 1)>(vb), l3 = tr_read<v_rd_off(D0, 3, 0)>(vb), h3 = tr_read<v_rd_off(D0, 3, 1)>(vb);
  asm volatile("s_waitcnt lgkmcnt(0)" ::: "memory"); SBAR();
#define PK(L, H) (bf16x8){L[0], L[1], L[2], L[3], H[0], H[1], H[2], H[3]}
  od = __builtin_amdgcn_mfma_f32_32x32x16_bf16(pa0, PK(l0, h0), od, 0, 0, 0);
  od = __builtin_amdgcn_mfma_f32_32x32x16_bf16(pa1, PK(l1, h1), od, 0, 0, 0);
  od = __builtin_amdgcn_mfma_f32_32x32x16_bf16(pa2, PK(l2, h2), od, 0, 0, 0);
  od = __builtin_amdgcn_mfma_f32_32x32x16_bf16(pa3, PK(l3, h3), od, 0, 0, 0);
#undef PK
}
__device__ __forceinline__ void pv_d0(f32x16* o, int vb, bf16x8 pa0, bf16x8 pa1, bf16x8 pa2, bf16x8 pa3) {
  pv_one<0>(o[0], vb, pa0, pa1, pa2, pa3); pv_one<1>(o[1], vb, pa0, pa1, pa2, pa3); pv_one<2>(o[2], vb, pa0, pa1, pa2, pa3); pv_one<3>(o[3], vb, pa0, pa1, pa2, pa3);
}
__device__ __forceinline__ void mask_tile(f32x16& p0, f32x16& p1, const AUnit& U, int j, int qrel, int hi, const float* rpbT) {
  if (j < U.nctx) return;
  const int jl = j - U.nctx;
  if (jl >= U.nloc) {
#pragma unroll
    for (int r = 0; r < 16; ++r) { p0[r] = NEG; p1[r] = NEG; }
    return; }
  if (U.mode == 1) {
    const int dq = (U.kt0 + jl) * 64 - (U.q0 + qrel) + 128;
#pragma unroll
    for (int r = 0; r < 16; ++r) { const int d0 = dq + crow(r, hi); if ((unsigned)d0 > 256u) p0[r] = NEG; if ((unsigned)(d0 + 32) > 256u) p1[r] = NEG; }
  } else if (U.mode == 2) {
    const int qpos = U.q0 + qrel, qrow = qpos >> 6, qcol = qpos & 63, krow = U.kt0 + jl;
    int rs = qrow - 4; rs = rs < 0 ? 0 : (rs > 8 ? 8 : rs);
    int cs = qcol - 8; cs = cs < 0 ? 0 : (cs > 48 ? 48 : cs);
    const bool rowok = (krow >= rs) && (krow < rs + 8);
    const int ib = (krow - qrow + 7) * 31 - qcol + 15;
#pragma unroll
    for (int r = 0; r < 16; ++r) { const int kc0 = crow(r, hi), kc1 = kc0 + 32;
      const bool ok0 = rowok && ((unsigned)(kc0 - cs) < 16u), ok1 = rowok && ((unsigned)(kc1 - cs) < 16u);
      const float b0 = rpbT[ok0 ? ib + kc0 : 0], b1 = rpbT[ok1 ? ib + kc1 : 0];
      p0[r] = ok0 ? p0[r] + b0 : NEG; p1[r] = ok1 ? p1[r] + b1 : NEG; }
  }
}
__device__ __forceinline__ void attn_unit(const AUnit& U, char* lds, int wv) {
  const int tid = ptid(wv);
  const int wid = wv, lane = tid & 63, r32 = lane & 31, hi = lane >> 5;
  bf16_t* V_lds = (bf16_t*)lds; bf16_t* K_lds = (bf16_t*)(lds + 2 * SHM_V);
  float* ws = (float*)(lds + 2 * SHM_V + 2 * SHM_K) + wid * 64; float* li_l = ws; float* al_l = ws + 32;
  float* rpbT = (float*)(lds + RPB_OFF);
  if (U.mode == 2) { for (int i = tid; i < 15 * 31; i += NTHR) rpbT[i] = U.rpb[i] * (1.0f / SCALE); }
  float m_reg = U.m0, l_reg = U.l0; f32x16 o[4] = {}; bf16x8 qr[8];
  const bf16_t* Qw = U.Q + (long)(wid * QBLK + r32) * D + hi * 8;
#pragma unroll
  for (int d0 = 0; d0 < 8; ++d0) qr[d0] = *reinterpret_cast<const bf16x8*>(Qw + d0 * 16);
  const int sr = tid >> 4, sc = (tid & 15) * 8, vst0 = v_st(sr, sc), vst1 = v_st(32 + sr, sc);
  const int vb0 = (int)(uintptr_t)V_lds + v_rd_base(lane);
  const int qrel = wid * QBLK + r32;
  struct { bf16x8 vs0, vs1, ks0, ks1; } sr_[1];
#define KTP(j) ((j) < U.nctx ? U.Kc + (long)(j) * 8192 : U.Kl + (long)(((j) - U.nctx) < U.nloc ? ((j) - U.nctx) : (U.nloc - 1)) * 8192)
#define VTP(j) ((j) < U.nctx ? U.Vc + (long)(j) * 8192 : U.Vl + (long)(((j) - U.nctx) < U.nloc ? ((j) - U.nctx) : (U.nloc - 1)) * 8192)
#define SLOAD(i, j) do { const bf16_t* kp_ = KTP(j); const bf16_t* vp_ = VTP(j); \
    sr_[i].vs0 = *reinterpret_cast<const bf16x8*>(&vp_[(long)(sr) * D + sc]); sr_[i].vs1 = *reinterpret_cast<const bf16x8*>(&vp_[(long)(32 + sr) * D + sc]); \
    sr_[i].ks0 = *reinterpret_cast<const bf16x8*>(&kp_[(long)(sr) * D + sc]); sr_[i].ks1 = *reinterpret_cast<const bf16x8*>(&kp_[(long)(32 + sr) * D + sc]); } while (0)
#define SWRITE(b, i) do { *(bf16x8*)((char*)V_lds + (b) * SHM_V + vst0) = sr_[i].vs0;          \
    *(bf16x8*)((char*)V_lds + (b) * SHM_V + vst1) = sr_[i].vs1; int kc = sc * 2;               \
    *(bf16x8*)((char*)K_lds + (b) * SHM_K + KSWZ(sr, kc)) = sr_[i].ks0;                       \
    *(bf16x8*)((char*)K_lds + (b) * SHM_K + KSWZ(32 + sr, kc)) = sr_[i].ks1; } while (0)
#define SWAIT() asm volatile("s_waitcnt vmcnt(0)" ::: "memory")
#define RESC(a) do { if (__any((a) < 1.f)) { if (hi == 0) al_l[r32] = (a); asm volatile("s_waitcnt lgkmcnt(0)" ::: "memory"); \
    _Pragma("unroll") for (int d = 0; d < 4; ++d) _Pragma("unroll") for (int r = 0; r < 16; ++r) o[d][r] *= al_l[crow(r, hi)]; } } while (0)
  f32x16 pA0, pA1, pB0, pB1; float mnA, mnB, alA, alB; bf16x8 pa0, pa1, pa2, pa3; const int NT = U.nt;
  SLOAD(0, 0); asm volatile("s_waitcnt vmcnt(0)" ::: "memory"); SWRITE(0, 0); __syncthreads();
  qkt(pA0, pA1, K_lds, qr, r32, hi); partialSM(pA0, pA1, m_reg, mnA, alA);
  SLOAD(0, 1);
  SWAIT(); SWRITE(1, 0); __syncthreads();
  for (int j = 1; j + 1 < NT; j += 2) {
    SBAR(); SLOAD(0, j + 1); SBAR();
    qkt(pB0, pB1, (bf16_t*)((char*)K_lds + SHM_K), qr, r32, hi);
    finishSM(pA0, pA1, alA, l_reg, pa0, pa1, pa2, pa3); SBAR();
    pv_d0(o, vb0, pa0, pa1, pa2, pa3); mask_tile(pB0, pB1, U, j, qrel, hi, rpbT); partialSM(pB0, pB1, m_reg, mnB, alB);
    __syncthreads(); SWAIT(); SWRITE(0, 0);
    RESC(alB); __syncthreads();
    SBAR(); SLOAD(0, j + 2); SBAR();
    qkt(pA0, pA1, K_lds, qr, r32, hi);
    finishSM(pB0, pB1, alB, l_reg, pa0, pa1, pa2, pa3); SBAR();
    pv_d0(o, vb0 + (int)SHM_V, pa0, pa1, pa2, pa3); mask_tile(pA0, pA1, U, j + 1, qrel, hi, rpbT); partialSM(pA0, pA1, m_reg, mnA, alA);
    __syncthreads(); SWAIT(); SWRITE(1, 0);
    RESC(alA); __syncthreads();
  }
  SBAR(); qkt(pB0, pB1, (bf16_t*)((char*)K_lds + SHM_K), qr, r32, hi);
  finishSM(pA0, pA1, alA, l_reg, pa0, pa1, pa2, pa3); SBAR();
  pv_d0(o, vb0, pa0, pa1, pa2, pa3); mask_tile(pB0, pB1, U, NT - 1, qrel, hi, rpbT); partialSM(pB0, pB1, m_reg, mnB, alB);
  __syncthreads(); RESC(alB);
  finishSM(pB0, pB1, alB, l_reg, pa0, pa1, pa2, pa3); SBAR();
  pv_d0(o, vb0 + (int)SHM_V, pa0, pa1, pa2, pa3);
  if (hi == 0) li_l[r32] = l_reg; asm volatile("s_waitcnt lgkmcnt(0)" ::: "memory");
  float rli[16];
#pragma unroll
  for (int r = 0; r < 16; ++r) rli[r] = __builtin_amdgcn_rcpf(li_l[crow(r, hi)]);
  bf16_t* Ow = U.O + (long)(wid * QBLK) * DM;
#pragma unroll
  for (int r = 0; r < 16; ++r) { int orow = crow(r, hi);
#pragma unroll
    for (int d0 = 0; d0 < 4; ++d0) Ow[(long)orow * DM + d0 * 32 + r32] = (bf16_t)f2bf(o[d0][r] * rli[r]); }
  __syncthreads();
#undef KTP
#undef VTP
#undef SLOAD
#undef SWRITE
#undef SWAIT
#undef RESC
}
#undef KSWZ
#undef SBAR
}

struct Args { const float* in[29]; float* out; unsigned char* ws; };
enum { I_XP = 0, I_XS, I_C, I_CCK, I_CCV, I_CDK, I_CDV, I_CCTX, I_WADA, I_BADA, I_GF1, I_WGU1, I_WDN1, I_GMIX, I_WOUT, I_GF2, I_WGU2, I_WDN2, I_WINE, I_GSGU, I_WSGU, I_BSGU, I_WINO,
       I_GQC, I_GKC, I_GQD, I_GKD, I_SINK, I_RPB };

__device__ __forceinline__ void transpose_item(const float* W, int K, int N, bf16_t* WT, int k0, int n0, int drow0, LAS float* scr, int lane) {
#pragma unroll 8
    for (int i = 0; i < 32; ++i) { const int kk = 2 * i + (lane >> 5); scr[kk * 33 + (lane & 31)] = __builtin_nontemporal_load(W + (size_t)(k0 + kk) * N + n0 + (lane & 31)); }
    LDS_WAIT(); asm volatile("" ::: "memory");
    const int c = lane & 7;
#pragma unroll
    for (int j = 0; j < 4; ++j) { const int n = (lane >> 3) + 8 * j; const LAS float* s = scr + (8 * c) * 33 + n;
        u32x4 o; o.x = pk2(s[0 * 33], s[1 * 33]); o.y = pk2(s[2 * 33], s[3 * 33]); o.z = pk2(s[4 * 33], s[5 * 33]); o.w = pk2(s[6 * 33], s[7 * 33]);
        __builtin_nontemporal_store(o, (u32x4*)(WT + (size_t)(drow0 + n) * K + k0 + 8 * c)); }
    LDS_WAIT(); asm volatile("" ::: "memory");
}
__device__ __forceinline__ void transpose_item_q8(const float* W, int K, int N, signed char* WT, int k0, int n0, int drow0, const float* cmax, LAS float* scr, int lane) {
#pragma unroll 8
    for (int i = 0; i < 32; ++i) { const int kk = 2 * i + (lane >> 5); scr[kk * 33 + (lane & 31)] = W[(size_t)(k0 + kk) * N + n0 + (lane & 31)]; }
    LDS_WAIT(); asm volatile("" ::: "memory");
    const int c = lane & 7;
#pragma unroll
    for (int j = 0; j < 4; ++j) { const int n = (lane >> 3) + 8 * j; const LAS float* s = scr + (8 * c) * 33 + n;
        const float inv = 127.0f / fmaxf(cmax[drow0 + n], 1e-30f); int q[8];
#pragma unroll
        for (int i = 0; i < 8; ++i) { int v = (int)__builtin_rintf(s[i * 33] * inv); v = v > 127 ? 127 : (v < -127 ? -127 : v); q[i] = v & 255; }
        u32x2 o; o.x = (unsigned)q[0] | ((unsigned)q[1] << 8) | ((unsigned)q[2] << 16) | ((unsigned)q[3] << 24); o.y = (unsigned)q[4] | ((unsigned)q[5] << 8) | ((unsigned)q[6] << 16) | ((unsigned)q[7] << 24);
        *(u32x2*)(WT + (size_t)(drow0 + n) * K + k0 + 8 * c) = o; }
    LDS_WAIT(); asm volatile("" ::: "memory");
}
__device__ __forceinline__ int gu_row(int n) { return n < DFF ? ((n >> 7) * 256 + (n & 127)) : (((n - DFF) >> 7) * 256 + 128 + ((n - DFF) & 127)); }

constexpr int CONV_PER_LAYER = 11008 * 2 + 5504 * 2 + 2048 + 4608;
__device__ __forceinline__ void convert_item(const Args& A, int l, int r, LAS float* scr, int lane) {
    bf16_t* wl = (bf16_t*)(ws_opaque(A.ws) + WS_W) + (size_t)l * W_LAYER;
    if (r < 22016) { const int f = r / 11008; r %= 11008; const int kb = r / 344, nb = r % 344;
        transpose_item_q8(A.in[f ? I_WGU2 : I_WGU1] + (size_t)l * DM * NGU, DM, NGU, (signed char*)(wl + (f ? W_GU2 : W_GU1)), kb * 64, nb * 32, gu_row(nb * 32),
                          (const float*)(ws_opaque(A.ws) + WS_CMAX) + (size_t)(l * 2 + f) * NGU, scr, lane); return; }
    r -= 22016;
    if (r < 11008) { const int f = r / 5504; r %= 5504; const int kb = r / 64, nb = r % 64;
        transpose_item(A.in[f ? I_WDN2 : I_WDN1] + (size_t)l * DFF * DM, DFF, DM, wl + (f ? W_DN2 : W_DN1), kb * 64, nb * 32, nb * 32, scr, lane); return; }
    r -= 11008;
    if (r < 2048) { const int kb = r / 64, nb = r % 64;
        transpose_item(A.in[I_WOUT] + (size_t)l * DM * DM, DM, DM, wl + W_OUT, kb * 64, nb * 32, nb * 32, scr, lane); return; }
    r -= 2048;
    if (l & 1) { const int kb = r / 144, nb = r % 144;
        transpose_item(A.in[I_WINO] + (size_t)(l >> 1) * DM * NIN_O, DM, NIN_O, wl + W_IN, kb * 64, nb * 32, nb * 32, scr, lane); }
    else if (r < 3072) { const int kb = r / 96, nb = r % 96;
        transpose_item(A.in[I_WINE] + (size_t)(l >> 1) * DM * NIN_E, DM, NIN_E, wl + W_IN, kb * 64, nb * 32, nb * 32, scr, lane); }
}
__device__ __forceinline__ void gu_q8_wg_item(const Args& A, LAS unsigned char* lds, int l, int f, int nb, int wv) {
    const int tid = ptid(wv), lane = tid & 63;
    const float* W = A.in[f ? I_WGU2 : I_WGU1] + (size_t)l * DM * NGU;
    LAS float* wmax = (LAS float*)(lds + 69632);
    LAS float* cm = wmax + 256;
    { const float* w = W + (size_t)(wv * 256 + (lane >> 3)) * NGU + nb * 32 + (lane & 7) * 4;
      f32x4 mx = {0.f, 0.f, 0.f, 0.f};
#pragma unroll 8
      for (int i = 0; i < 32; ++i) { const f32x4 v = *(const f32x4*)(w + (size_t)(8 * i) * NGU); mx[0] = fmaxf(mx[0], fabsf(v[0])); mx[1] = fmaxf(mx[1], fabsf(v[1])); mx[2] = fmaxf(mx[2], fabsf(v[2])); mx[3] = fmaxf(mx[3], fabsf(v[3])); }
#pragma unroll
      for (int q = 0; q < 4; ++q) { mx[q] = fmaxf(mx[q], sx<8>(mx[q])); mx[q] = fmaxf(mx[q], sx<16>(mx[q])); mx[q] = max32(mx[q]); }
      if (lane < 8) { wmax[wv * 32 + lane * 4 + 0] = mx[0]; wmax[wv * 32 + lane * 4 + 1] = mx[1]; wmax[wv * 32 + lane * 4 + 2] = mx[2]; wmax[wv * 32 + lane * 4 + 3] = mx[3]; } }
    __syncthreads();
    const int drow0 = gu_row(nb * 32);
    if (tid < 32) { float m = wmax[tid];
#pragma unroll
        for (int w8 = 1; w8 < 8; ++w8) m = fmaxf(m, wmax[w8 * 32 + tid]);
        cm[tid] = m; ((float*)(ws_opaque(A.ws) + WS_CMAX))[(size_t)(l * 2 + f) * NGU + drow0 + tid] = m; }
    __syncthreads();
    signed char* WT = (signed char*)((bf16_t*)(ws_opaque(A.ws) + WS_W) + (size_t)l * W_LAYER + (f ? W_GU2 : W_GU1));
    LAS float* scr = (LAS float*)(lds + wv * 8704);
    for (int kb = 0; kb < 4; ++kb) {
        const int k0 = wv * 256 + kb * 64;
#pragma unroll 8
        for (int i = 0; i < 32; ++i) { const int kk = 2 * i + (lane >> 5); scr[kk * 33 + (lane & 31)] = W[(size_t)(k0 + kk) * NGU + nb * 32 + (lane & 31)]; }
        LDS_WAIT(); asm volatile("" ::: "memory");
        const int c = lane & 7;
#pragma unroll
        for (int j = 0; j < 4; ++j) { const int n = (lane >> 3) + 8 * j; const LAS float* sp = scr + (8 * c) * 33 + n;
            const float inv = 127.0f / fmaxf(cm[n], 1e-30f); int q[8];
#pragma unroll
            for (int i = 0; i < 8; ++i) { int v = (int)__builtin_rintf(sp[i * 33] * inv); v = v > 127 ? 127 : (v < -127 ? -127 : v); q[i] = v & 255; }
            u32x2 o; o.x = (unsigned)q[0] | ((unsigned)q[1] << 8) | ((unsigned)q[2] << 16) | ((unsigned)q[3] << 24); o.y = (unsigned)q[4] | ((unsigned)q[5] << 8) | ((unsigned)q[6] << 16) | ((unsigned)q[7] << 24);
            __builtin_nontemporal_store(o, (u32x2*)(WT + (size_t)(drow0 + n) * DM + k0 + 8 * c)); }
        LDS_WAIT(); asm volatile("" ::: "memory");
    }
    __syncthreads();
}
__device__ __forceinline__ void wht32_lane(float (&v)[8], int c) {
#pragma unroll
    for (int st = 1; st < 8; st <<= 1)
#pragma unroll
        for (int i = 0; i < 8; ++i) if (!(i & st)) { const float a = v[i], b = v[i + st]; v[i] = a + b; v[i + st] = a - b; }
#pragma unroll
    for (int i = 0; i < 8; ++i) { const float p = sx<1>(v[i]); v[i] = (c & 1) ? (p - v[i]) : (v[i] + p); }
#pragma unroll
    for (int i = 0; i < 8; ++i) { const float p = sx<2>(v[i]); v[i] = (c & 2) ? (p - v[i]) : (v[i] + p); }
}
__device__ __forceinline__ void dn_q8_wg_item(const Args& A, LAS unsigned char* lds, int l, int f, int nb, int wv) {
    const int tid = ptid(wv), lane = tid & 63, c = lane & 7;
    const float* W = A.in[f ? I_WDN2 : I_WDN1] + (size_t)l * DFF * DM;
    LAS float* wmax = (LAS float*)(lds + 69632);
    LAS float* cm = wmax + 256;
    LAS float* scr = (LAS float*)(lds + wv * 8704);
    signed char* WT = (signed char*)((bf16_t*)(ws_opaque(A.ws) + WS_W) + (size_t)l * W_LAYER + (f ? W_DN2 : W_DN1));
    float mx[4] = {0.f, 0.f, 0.f, 0.f};
    for (int pass = 0; pass < 2; ++pass) {
        for (int kb = wv; kb < 86; kb += 8) {
            const int k0 = kb * 64;
#pragma unroll 8
            for (int i = 0; i < 32; ++i) { const int kk = 2 * i + (lane >> 5); scr[kk * 33 + (lane & 31)] = W[(size_t)(k0 + kk) * DM + nb * 32 + (lane & 31)]; }
            LDS_WAIT(); asm volatile("" ::: "memory");
#pragma unroll
            for (int j = 0; j < 4; ++j) { const int n = (lane >> 3) + 8 * j; const LAS float* sp = scr + (8 * c) * 33 + n; float v[8];
#pragma unroll
                for (int i = 0; i < 8; ++i) v[i] = sp[i * 33];
                wht32_lane(v, c);
                if (pass == 0) {
#pragma unroll
                    for (int i = 0; i < 8; ++i) mx[j] = fmaxf(mx[j], fabsf(v[i]));
                } else {
                    const float inv = (127.0f * 32.0f) / fmaxf(cm[n], 1e-30f); int q[8];
#pragma unroll
                    for (int i = 0; i < 8; ++i) { int t = (int)__builtin_rintf(v[i] * (1.0f / 32.0f) * inv); t = t > 127 ? 127 : (t < -127 ? -127 : t); q[i] = t & 255; }
                    u32x2 o; o.x = (unsigned)q[0] | ((unsigned)q[1] << 8) | ((unsigned)q[2] << 16) | ((unsigned)q[3] << 24); o.y = (unsigned)q[4] | ((unsigned)q[5] << 8) | ((unsigned)q[6] << 16) | ((unsigned)q[7] << 24);
                    __builtin_nontemporal_store(o, (u32x2*)(WT + (size_t)(nb * 32 + n) * KD8 + k0 + 8 * c)); } }
            LDS_WAIT(); asm volatile("" ::: "memory");
        }
        if (pass == 0) {
#pragma unroll
            for (int j = 0; j < 4; ++j) { mx[j] = fmaxf(mx[j], sx<1>(mx[j])); mx[j] = fmaxf(mx[j], sx<2>(mx[j])); mx[j] = fmaxf(mx[j], sx<4>(mx[j])); }
            if (c == 0) {
#pragma unroll
                for (int j = 0; j < 4; ++j) wmax[wv * 32 + (lane >> 3) + 8 * j] = mx[j]; }
            __syncthreads();
            if (tid < 32) { float m = wmax[tid];
#pragma unroll
                for (int w8 = 1; w8 < 8; ++w8) m = fmaxf(m, wmax[w8 * 32 + tid]);
                cm[tid] = m; ((float*)(ws_opaque(A.ws) + WS_CMAX2))[(size_t)(l * 2 + f) * DM + nb * 32 + tid] = m * (1.0f / 32.0f); }
            __syncthreads();
        }
    }
    if (tid < 256) { u32x4 zv = {0u, 0u, 0u, 0u}; asm volatile("" : "+v"(zv)); *(u32x4*)(WT + (size_t)(nb * 32 + (tid >> 3)) * KD8 + DFF + (tid & 7) * 16) = zv; }
    __syncthreads();
}
constexpr int CONV_GU_ROUNDS = 688, CONV_DN_ROUNDS = 128, CONV_ROUNDS = CONV_GU_ROUNDS + CONV_DN_ROUNDS + (CONV_PER_LAYER - 33024) / 8;
__device__ __forceinline__ void conv_round(const Args& A, LAS unsigned char* lds, int l, int r, int wv) {
    if (r < CONV_GU_ROUNDS) { gu_q8_wg_item(A, lds, l, r / 344, r % 344, wv); return; }
    if (r < CONV_GU_ROUNDS + CONV_DN_ROUNDS) { const int rr = r - CONV_GU_ROUNDS; dn_q8_wg_item(A, lds, l, rr >> 6, rr & 63, wv); return; }
    const int lane = ptid(wv) & 63;
    convert_item(A, l, 33024 + 8 * (r - CONV_GU_ROUNDS - CONV_DN_ROUNDS) + wv, (LAS float*)(lds + wv * 8704), lane);
}
__device__ __forceinline__ void ada_wg_round(const Args& A, LAS unsigned char* lds, int l, int cg, int wv) {
    const int tid = ptid(wv), lane = tid & 63;
    LAS float* sil = (LAS float*)(lds + 98304); LAS float* part = (LAS float*)(lds + 73728);
    for (int i = tid; i < 3 * DM; i += NTHR) { const int cv = i / DM, k = i % DM; const float v = cv == 0 ? A.in[I_CCTX][k] : A.in[I_C][(cv - 1) * DM + k]; sil[i] = v / (1.0f + __expf(-v)); }
    __syncthreads();
    const float* w = A.in[I_WADA] + ((size_t)l * DM + wv * 256) * NMODV + cg * 256 + 4 * lane;
    f32x4 a0 = {0.f, 0.f, 0.f, 0.f}, a1 = a0, a2 = a0;
    const LAS float* s0 = sil + wv * 256;
#pragma unroll 8
    for (int k = 0; k < 256; ++k) { const f32x4 wq = __builtin_nontemporal_load((const f32x4*)(w + (size_t)k * NMODV)); a0 += wq * s0[k]; a1 += wq * s0[DM + k]; a2 += wq * s0[2 * DM + k]; }
    *(LAS f32x4*)(part + (wv * 3 + 0) * 256 + 4 * lane) = a0; *(LAS f32x4*)(part + (wv * 3 + 1) * 256 + 4 * lane) = a1; *(LAS f32x4*)(part + (wv * 3 + 2) * 256 + 4 * lane) = a2;
    __syncthreads();
    for (int o = tid; o < 768; o += NTHR) { const int cv = o >> 8, c = o & 255; float sum = A.in[I_BADA][(size_t)l * NMODV + cg * 256 + c];
#pragma unroll
        for (int w8 = 0; w8 < 8; ++w8) sum += part[(w8 * 3 + cv) * 256 + c];
        ((float*)(ws_opaque(A.ws) + WS_MODS))[((size_t)(l * 3 + cv)) * NMODV + cg * 256 + c] = sum; }
    __syncthreads();
}
constexpr int CONV0_ROUNDS = 880;
__device__ __forceinline__ void conv_round0(const Args& A, LAS unsigned char* lds, int r, int wv) {
    if (r < 344) { gu_q8_wg_item(A, lds, 0, 1, r, wv); return; }
    if (r < 408) { dn_q8_wg_item(A, lds, 0, 1, r - 344, wv); return; }
    if (r < 664) { const int lane = ptid(wv) & 63; convert_item(A, 0, 33024 + 8 * (r - 408) + wv, (LAS float*)(lds + wv * 8704), lane); return; }
    ada_wg_round(A, lds, 1 + (r - 664) / 72, (r - 664) % 72, wv);
}
#define QH(l) (8192 + 64 * (l))
__device__ __forceinline__ bool fill_round(const Args& A, LAS unsigned char* lds, int l, int wv) {
    volatile LAS unsigned* MISC = (volatile LAS unsigned*)(lds + LDS_MISC);
    const int tid = ptid(wv);
    if (tid == 0) MISC[4] = __hip_atomic_fetch_add((unsigned*)(ws_opaque(A.ws) + WS_CTL) + QH(l), 1u, __ATOMIC_RELAXED, __HIP_MEMORY_SCOPE_AGENT);
    __syncthreads();
    const int base = (int)MISC[4];
    __syncthreads();
    if (base >= (l == 0 ? CONV0_ROUNDS : CONV_ROUNDS)) return false;
    if (l == 0) conv_round0(A, lds, base, wv); else conv_round(A, lds, l, base, wv);
    return true;
}
__device__ __forceinline__ void fill_wait(const Args& A, LAS unsigned char* lds, int G, int wv, int nbar, int& ql) {
    volatile LAS unsigned* MISC = (volatile LAS unsigned*)(lds + LDS_MISC);
    while (ql < 4) {
        const int tid = ptid(wv);
        if (tid == 0) { unsigned* bar = (unsigned*)(ws_opaque(A.ws) + WS_CTL); unsigned sum = 0u;
#pragma unroll
            for (unsigned j = 0; j < 16; ++j) sum += xb_ld(&bar[XB_XSUB(j)]);
            MISC[5] = ((sum - (unsigned)nbar * (unsigned)G) * 2u >= (unsigned)G) ? 1u : 0u; }
        __syncthreads();
        const unsigned stop = MISC[5];
        __syncthreads();
        if (stop) break;
        if (!fill_round(A, lds, ql, wv)) ++ql;
    }
}

__device__ __forceinline__ void prologue_a(const Args& A, LAS unsigned char* lds, int G, int wv) {
    const int tid = ptid(wv), lane = tid & 63, wave = wv;
    unsigned char* ws = ws_opaque(A.ws);
    LAS float* sil = (LAS float*)(lds + 69632);
    for (int i = tid; i < 3 * DM; i += NTHR) { const int cv = i / DM, k = i % DM; const float v = cv == 0 ? A.in[I_CCTX][k] : A.in[I_C][(cv - 1) * DM + k]; sil[i] = v / (1.0f + __expf(-v)); }
    __syncthreads();
    const int gw = obid() * NWAVES + wave, NGW = G * NWAVES;
    for (int it = gw; it < 144 * 4; it += NGW) {
        const int l = 0, r = it, cg = r >> 2, ks = r & 3;
        const float* w = A.in[I_WADA] + ((size_t)l * DM + ks * 512) * NMODV + cg * 128 + 2 * lane;
        f32x2 a0 = {0.f, 0.f}, a1 = {0.f, 0.f}, a2 = {0.f, 0.f};
        const LAS float* s0 = sil + ks * 512;
#pragma unroll 8
        for (int k = 0; k < 512; ++k) { const f32x2 wv = __builtin_nontemporal_load((const f32x2*)(w + (size_t)k * NMODV)); a0 += wv * s0[k]; a1 += wv * s0[DM + k]; a2 += wv * s0[2 * DM + k]; }
        float* P = (float*)(ws + WS_ADAP) + ((size_t)(l * 4 + ks) * 3) * NMODV + cg * 128 + 2 * lane;
        *(f32x2*)P = a0; *(f32x2*)(P + NMODV) = a1; *(f32x2*)(P + 2 * NMODV) = a2;
    }
    __syncthreads();
    for (int q = obid(); q < 984; q += G) { const int r = q < 344 ? q : (q < 408 ? 688 + (q - 344) : 1072 + (q - 408)); conv_round(A, lds, 0, r, wv); }
    const size_t gt = (size_t)obid() * NTHR + tid, GT = (size_t)G * NTHR;
    constexpr size_t N_CK = 524288 / 8, N_DK = 2097152 / 8, N_WS = 262144 / 8, N_T = 131072 / 8, N_CS = 2097152 / 8;
    constexpr size_t E0 = N_CK, E1 = E0 + N_CK, E2 = E1 + N_DK, E3 = E2 + N_DK, E4 = E3 + N_WS, E5 = E4 + N_T, E6 = E5 + N_T, E7 = E6 + N_CS;
    for (size_t i = gt; i < E7; i += GT) {
        if (i < E4) {
            const float* src; bf16_t* dst; size_t j;
            if (i < E0) { src = A.in[I_CCK]; dst = (bf16_t*)(ws + WS_CCK); j = i; }
            else if (i < E1) { src = A.in[I_CCV]; dst = (bf16_t*)(ws + WS_CCV); j = i - E0; }
            else if (i < E2) { src = A.in[I_CDK]; dst = (bf16_t*)(ws + WS_CDK); j = i - E1; }
            else if (i < E3) { src = A.in[I_CDV]; dst = (bf16_t*)(ws + WS_CDV); j = i - E2; }
            else { src = A.in[I_WSGU]; dst = (bf16_t*)(ws + WS_WSGU); j = i - E3; }
            const f32x4 x0 = *(const f32x4*)(src + j * 8), x1 = *(const f32x4*)(src + j * 8 + 4);
            u32x4 o; o.x = pk2(x0[0], x0[1]); o.y = pk2(x0[2], x0[3]); o.z = pk2(x1[0], x1[1]); o.w = pk2(x1[2], x1[3]);
            *(u32x4*)(dst + j * 8) = o;
        } else {
            float v[8]; bf16_t* dst; size_t j; size_t doff;
            if (i < E5) { j = i - E4; doff = j * 8; dst = (bf16_t*)(ws + WS_T256); const int m = (int)(j * 8) / 256, k0 = (int)(j * 8) % 256, cp = m & 255, h = m >> 8;
#pragma unroll
                for (int e = 0; e < 8; ++e) { const float ang = (float)(((cp * (k0 + e)) & 255) * 2) * (1.0f / 256.0f); v[e] = h ? sinpif(ang) : cospif(ang); } }
            else if (i < E6) { j = i - E5; dst = (bf16_t*)(ws + WS_CS256); const int sp = (int)(j * 8) / 512, kk0 = (int)(j * 8) % 512, h = kk0 / 256, s0 = kk0 % 256; doff = (size_t)sp * 2048 + kk0;
#pragma unroll
                for (int e = 0; e < 8; ++e) { const float ang = (float)(((sp * (s0 + e)) & 255) * 2) * (1.0f / 256.0f); v[e] = h ? -sinpif(ang) : cospif(ang); } }
            else { j = i - E6; doff = j * 8; dst = (bf16_t*)(ws + WS_CS1024); const int sp = (int)(j * 8) / 2048, kk0 = (int)(j * 8) % 2048, h = kk0 / 1024, s0 = kk0 % 1024;
#pragma unroll
                for (int e = 0; e < 8; ++e) { const float ang = (float)(((sp * (s0 + e)) & 1023) * 2) * (1.0f / 1024.0f); v[e] = h ? -sinpif(ang) : cospif(ang); } }
            u32x4 o; o.x = pk2(v[0], v[1]); o.y = pk2(v[2], v[3]); o.z = pk2(v[4], v[5]); o.w = pk2(v[6], v[7]);
            *(u32x4*)(dst + doff) = o;
        }
    }
    if (gt < 2048) { const int pos = (int)gt >> 5, f = (int)gt & 31; const float inv = powf(10000.0f, -(float)f / 32.0f), ang = (float)pos * inv;
        float* rt = (float*)(ws + WS_ROPE); rt[gt] = cosf(ang); rt[2048 + gt] = sinf(ang); }
}
__device__ __forceinline__ void prologue_b(const Args& A, LAS unsigned char* lds, int G, int wv) {
    const size_t gt = (size_t)obid() * NTHR + ptid(wv), GT = (size_t)G * NTHR;
    const float* P = (const float*)(ws_opaque(A.ws) + WS_ADAP); float* Mo = (float*)(ws_opaque(A.ws) + WS_MODS);
    for (size_t i = gt; i < (size_t)3 * NMODV; i += GT) { const int l = 0, r = (int)i, j = r % NMODV;
        float s = A.in[I_BADA][(size_t)l * NMODV + j];
#pragma unroll
        for (int ks = 0; ks < 4; ++ks) s += P[((size_t)(l * 4 + ks) * 3) * NMODV + r];
        Mo[i] = s; }
}

__device__ __forceinline__ void nm_phase(const Args& A, int G, bool first, bool do_slab, float coef, int layer_gate, int kgate, bool do_norm, const float* g, int layer, int kshift, int wv, bool q8, int gx, int grk) {
    const int tid = ptid(wv);
    const int lane = tid & 63, wave = wv;
    const int gw = obid() * NWAVES + wave, NGW = G * NWAVES;
    float* xd = A.out; bf16_t* H = (bf16_t*)(ws_opaque(A.ws) + WS_H);
    const float* mods = (const float*)(ws_opaque(A.ws) + WS_MODS); const float* slab = (const float*)(ws_opaque(A.ws) + WS_SLAB);
    const int r_lo = do_norm ? 0 : MP;
    for (int it = do_norm ? 0 : 4; it < 5; ++it) {
        const int r = (it < 4 ? 4 * gx + it : 32 + gx) * 256 + grk * 8 + wave;
        const int cv = r < MP ? 0 : 1 + ((r - MP) >> 10);
        const float* xr = first ? (r < MP ? A.in[I_XP] + (size_t)r * DM : A.in[I_XS] + (size_t)(r - MP) * DM) : xd + (size_t)r * DM;
        f32x4 v[8];
#pragma unroll
        for (int j = 0; j < 8; ++j) v[j] = *(const f32x4*)(xr + 4 * lane + 256 * j);
        const bool wr_x = first || (do_slab && r >= MP);
        if (do_slab && r >= MP) {
            const float* gt_ = mods + ((size_t)(layer_gate * 3 + cv)) * NMODV + kgate * DM;
            const bf16_t* sb = (const bf16_t*)slab + (size_t)(r - MP) * DM;
#pragma unroll
            for (int j = 0; j < 8; ++j) { const int c = 4 * lane + 256 * j;
                const u32x2 w0 = *(const u32x2*)(sb + c), w1 = *(const u32x2*)(sb + (size_t)MS * DM + c), w2 = *(const u32x2*)(sb + (size_t)2 * MS * DM + c), w3 = *(const u32x2*)(sb + (size_t)3 * MS * DM + c);
                const f32x4 s = {(bf_lo(w0.x) + bf_lo(w1.x)) + (bf_lo(w2.x) + bf_lo(w3.x)), (bf_hi(w0.x) + bf_hi(w1.x)) + (bf_hi(w2.x) + bf_hi(w3.x)),
                                 (bf_lo(w0.y) + bf_lo(w1.y)) + (bf_lo(w2.y) + bf_lo(w3.y)), (bf_hi(w0.y) + bf_hi(w1.y)) + (bf_hi(w2.y) + bf_hi(w3.y))};
                v[j] = v[j] + (*(const f32x4*)(gt_ + c) * coef) * s; }
        }
        if (wr_x) {
#pragma unroll
            for (int j = 0; j < 8; ++j) *(f32x4*)(xd + (size_t)r * DM + 4 * lane + 256 * j) = v[j];
        }
        if (do_norm) {
            float ss = 0.f;
#pragma unroll
            for (int j = 0; j < 8; ++j) ss += (v[j][0] * v[j][0] + v[j][1] * v[j][1]) + (v[j][2] * v[j][2] + v[j][3] * v[j][3]);
            ss = wave_sum(ss);
            const float rstd = 1.0f / sqrtf(ss * (1.0f / DM) + EPS);
            const float* sh = mods + ((size_t)(layer * 3 + cv)) * NMODV + kshift * DM; const float* scp = sh + DM;
            if (!q8) {
#pragma unroll
                for (int j = 0; j < 8; ++j) { const int c = 4 * lane + 256 * j;
                    const f32x4 gg = *(const f32x4*)(g + c), s1 = *(const f32x4*)(scp + c), s0 = *(const f32x4*)(sh + c);
                    const f32x4 y = ((v[j] * rstd) * gg) * (s1 + 1.0f) + s0;
                    u32x2 w; w.x = cvt_pk_bf16(y[0], y[1]); w.y = cvt_pk_bf16(y[2], y[3]);
                    *(u32x2*)(H + (size_t)r * DM + c) = w; }
            } else {
                float amax = 0.f;
#pragma unroll
                for (int j = 0; j < 8; ++j) { const int c = 4 * lane + 256 * j;
                    const f32x4 gg = *(const f32x4*)(g + c), s1 = *(const f32x4*)(scp + c), s0 = *(const f32x4*)(sh + c);
                    v[j] = ((v[j] * rstd) * gg) * (s1 + 1.0f) + s0;
                    amax = fmaxf(fmaxf(amax, fmaxf(fabsf(v[j][0]), fabsf(v[j][1]))), fmaxf(fabsf(v[j][2]), fabsf(v[j][3]))); }
                amax = wave_max(amax);
                amax = fmaxf(amax, 1e-30f);
                const float inv = 127.0f / amax;
                signed char* H8 = (signed char*)H;
#pragma unroll
                for (int j = 0; j < 8; ++j) { const int c = 4 * lane + 256 * j; unsigned w = 0u;
#pragma unroll
                    for (int e = 0; e < 4; ++e) { int q = (int)__builtin_rintf(v[j][e] * inv); q = q > 127 ? 127 : (q < -127 ? -127 : q); w |= (unsigned)(q & 255) << (8 * e); }
                    *(unsigned*)(H8 + (size_t)r * DM + c) = w; }
                if (lane == 0) ((float*)(ws_opaque(A.ws) + WS_RSC))[r] = amax * (1.0f / 127.0f);
            }
        }
    }
}

__device__ __forceinline__ void q8act_phase(const Args& A, int wv, int gx, int grk) {
    const int tid = ptid(wv), lane = tid & 63;
    const bf16_t* act = (const bf16_t*)(ws_opaque(A.ws) + WS_ACT); signed char* a8 = (signed char*)(ws_opaque(A.ws) + WS_ACT8); float* rs2 = (float*)(ws_opaque(A.ws) + WS_RSC2);
    for (int it = 0; it < 5; ++it) {
        const int r = (it < 4 ? 4 * gx + it : 32 + gx) * 256 + grk * 8 + wv;
        const bf16_t* row = act + (size_t)r * DFF;
        u32x4 v[11]; float amax = 0.f;
#pragma unroll
        for (int j = 0; j < 11; ++j) { const int idx = lane + 64 * j;
            v[j] = (idx < 688) ? __builtin_nontemporal_load((const u32x4*)(row + idx * 8)) : (u32x4){0u, 0u, 0u, 0u};
#pragma unroll
            for (int e = 0; e < 4; ++e) amax = fmaxf(amax, fmaxf(fabsf(bf_lo(v[j][e])), fabsf(bf_hi(v[j][e])))); }
        amax = wave_max(amax);
        amax = fmaxf(amax, 1e-30f);
        const float inv = 127.0f / amax;
        signed char* orow = a8 + (size_t)r * KD8;
#pragma unroll
        for (int j = 0; j < 11; ++j) { const int idx = lane + 64 * j; u32x2 o;
#pragma unroll
            for (int h = 0; h < 2; ++h) { unsigned w = 0u;
#pragma unroll
                for (int e = 0; e < 2; ++e) { const unsigned src = v[j][2 * h + e];
                    int q0 = (int)__builtin_rintf(bf_lo(src) * inv), q1 = (int)__builtin_rintf(bf_hi(src) * inv);
                    q0 = q0 > 127 ? 127 : (q0 < -127 ? -127 : q0); q1 = q1 > 127 ? 127 : (q1 < -127 ? -127 : q1);
                    w |= ((unsigned)(q0 & 255) | ((unsigned)(q1 & 255) << 8)) << (16 * e); }
                o[h] = w; }
            if (idx < 688) *(u32x2*)(orow + idx * 8) = o; }
        if (lane < 16) { u32x2 zv = {0u, 0u}; asm volatile("" : "+v"(zv)); *(u32x2*)(orow + DFF + lane * 8) = zv; }
        if (lane == 0) rs2[r] = amax * (1.0f / 127.0f);
    }
}

__device__ __forceinline__ void vstat_phase(const Args& A, int G, int wv) {
    const int tid = ptid(wv), lane = tid & 63;
    const bf16_t* mixin = (const bf16_t*)(ws_opaque(A.ws) + WS_MIXIN); float* rst = (float*)(ws_opaque(A.ws) + WS_SSQ);
    for (int r = obid() * NWAVES + wv; r < MTOT; r += G * NWAVES) {
        const bf16_t* p = mixin + (size_t)r * NIN_E + 1024 + lane * 8;
        const u32x4 a = *(const u32x4*)p, b = *(const u32x4*)(p + 512);
        float ss = 0.f;
#pragma unroll
        for (int e = 0; e < 4; ++e) { const float x0 = bf_lo(a[e]), x1 = bf_hi(a[e]), y0 = bf_lo(b[e]), y1 = bf_hi(b[e]); ss += (x0 * x0 + x1 * x1) + (y0 * y0 + y1 * y1); }
        ss = wave_sum(ss);
        if (lane == 0) rst[r] = 1.0f / sqrtf(ss * (1.0f / 1024.0f) + EPS);
    }
}

__device__ __forceinline__ void sgu_phase(const Args& A, LAS unsigned char* lds, int G, int e, int wv) {
    const int tid = ptid(wv);
    const int lane = tid & 63, wave = wv;
    const bf16_t* mixin = (const bf16_t*)(ws_opaque(A.ws) + WS_MIXIN); bf16_t* mixout = (bf16_t*)(ws_opaque(A.ws) + WS_MIXOUT);
    const float* ssq = (const float*)(ws_opaque(A.ws) + WS_SSQ);
    const bf16_t* wsg = (const bf16_t*)(ws_opaque(A.ws) + WS_WSGU) + (size_t)e * 8 * 128 * 128;
    LAS bf16_t* LT = (LAS bf16_t*)lds;
    LAS float* rs = (LAS float*)(lds + 128 * 136 * 2);
    volatile LAS unsigned* MISCq = (volatile LAS unsigned*)(lds + LDS_MISC);
    for (;;) {
        if (tid == 0) MISCq[6] = __hip_atomic_fetch_add((unsigned*)(ws_opaque(A.ws) + WS_CTL) + (8192 + 64 * (12 + e)), 1u, __ATOMIC_RELAXED, __HIP_MEMORY_SCOPE_AGENT);
        __syncthreads();
        const int u = (int)MISCq[6];
        if (u >= 80 * 8) break;
        const int ch = u >> 3, g = u & 7, t0 = ch * 128;
        __syncthreads();
        if (tid < 128) rs[tid] = ssq[t0 + tid];
        __syncthreads();
#pragma unroll
        for (int i = 0; i < 4; ++i) { const int idx = tid + NTHR * i, q = idx >> 4, cc = idx & 15;
            const u32x4 w = *(const u32x4*)(mixin + (size_t)(t0 + q) * NIN_E + 1024 + g * 128 + cc * 8);
            const float* gs = A.in[I_GSGU] + (size_t)e * 1024 + g * 128 + cc * 8; const float r = rs[q];
            const f32x4 g0 = *(const f32x4*)gs, g1 = *(const f32x4*)(gs + 4);
            float y[8] = {bf_lo(w.x) * r * g0[0], bf_hi(w.x) * r * g0[1], bf_lo(w.y) * r * g0[2], bf_hi(w.y) * r * g0[3], bf_lo(w.z) * r * g1[0], bf_hi(w.z) * r * g1[1], bf_lo(w.w) * r * g1[2], bf_hi(w.w) * r * g1[3]};
#pragma unroll
            for (int k = 0; k < 8; ++k) LT[(cc * 8 + k) * 136 + q] = (bf16_t)f2bf(y[k]); }
        __syncthreads();
        const int p = 16 * wave + (lane & 15), kq = lane >> 4;
        bf16x8 wf[4];
#pragma unroll
        for (int ks = 0; ks < 4; ++ks) wf[ks] = *(const bf16x8*)(wsg + ((size_t)g * 128 + p) * 128 + 32 * ks + 8 * kq);
        const float bias = A.in[I_BSGU][(size_t)e * 1024 + g * 128 + p];
#pragma unroll
        for (int nt = 0; nt < 8; ++nt) { f32x4 acc = {0.f, 0.f, 0.f, 0.f};
#pragma unroll
            for (int ks = 0; ks < 4; ++ks) { const bf16x8 vf = *(const LAS bf16x8*)(LT + (16 * nt + (lane & 15)) * 136 + 32 * ks + 8 * kq);
                acc = __builtin_amdgcn_mfma_f32_16x16x32_bf16(vf, wf[ks], acc, 0, 0, 0); }
            const int c = 16 * nt + 4 * kq;
            const u32x2 uu = *(const u32x2*)(mixin + (size_t)(t0 + p) * NIN_E + g * 128 + c);
            u32x2 o; o.x = cvt_pk_bf16(bf_lo(uu.x) * (acc[0] + bias), bf_hi(uu.x) * (acc[1] + bias)); o.y = cvt_pk_bf16(bf_lo(uu.y) * (acc[2] + bias), bf_hi(uu.y) * (acc[3] + bias));
            *(u32x2*)(mixout + (size_t)(t0 + p) * DM + g * 128 + c) = o; }
    }
    __syncthreads();
}

__device__ __forceinline__ void prep_phase(const Args& A, int G, int o, int wv, int gx, int grk) {
    const int tid = ptid(wv);
    const int lane = tid & 63, wave = wv, li = lane & 15, grp = lane >> 4;
    const int gw = obid() * NWAVES + wave, NGW = G * NWAVES;
    const bf16_t* mixin = (const bf16_t*)(ws_opaque(A.ws) + WS_MIXIN); bf16_t* qkv = (bf16_t*)(ws_opaque(A.ws) + WS_QKV);
    const float* rt = (const float*)(ws_opaque(A.ws) + WS_ROPE);
    for (int it = 0; it < 5; ++it) {
        const int r = (it < 4 ? 4 * gx + it : 32 + gx) * 256 + grk * 8 + wave;
        const bool smp = r >= MP; const int b = smp ? (r - MP) >> 10 : r >> 8, s = smp ? (r - MP) & 1023 : r & 255, S = smp ? 1024 : 256;
        const int prow = s >> 6, pcol = s & 63;
#pragma unroll
        for (int j = 0; j < 9; ++j) {
            const int slot = 4 * j + grp;
            const u32x4 w = __builtin_nontemporal_load((const u32x4*)(mixin + (size_t)r * NIN_O + slot * 128 + li * 8));
            float x[8] = {bf_lo(w.x), bf_hi(w.x), bf_lo(w.y), bf_hi(w.y), bf_lo(w.z), bf_hi(w.z), bf_lo(w.w), bf_hi(w.w)};
            int ty, hd, H;
            if (slot < 8) { ty = 0; hd = slot; H = 8; } else if (slot < 10) { ty = 1; hd = slot - 8; H = 2; } else if (slot < 12) { ty = 2; hd = slot - 10; H = 2; }
            else if (slot < 20) { ty = 3; hd = slot - 12; H = 8; } else if (slot < 28) { ty = 4; hd = slot - 20; H = 8; } else { ty = 5; hd = slot - 28; H = 8; }
            const bool isn = (ty != 2) && (ty != 5);
            float ss = 0.f;
#pragma unroll
            for (int k = 0; k < 8; ++k) ss += x[k] * x[k];
            ss += sx<1>(ss); ss += sx<2>(ss); ss += sx<4>(ss); ss += sx<8>(ss);
            const float rstd = 1.0f / sqrtf(ss * (1.0f / 128.0f) + EPS);
            const float* gp = A.in[ty == 0 ? I_GQC : ty == 1 ? I_GKC : ty == 3 ? I_GQD : I_GKD] + (size_t)o * 128 + li * 8;
            if (isn) {
                const f32x4 g0 = *(const f32x4*)gp, g1 = *(const f32x4*)(gp + 4);
#pragma unroll
                for (int k = 0; k < 4; ++k) { x[k] = x[k] * rstd * g0[k]; x[4 + k] = x[4 + k] * rstd * g1[k]; }
            }
            if (smp && j <= 2) {
                const int pos = (li < 8) ? prow : pcol; const float* ct = rt + pos * 32 + 8 * (li & 3); const float* st = ct + 2048;
                const bool lo = !(li & 4), dor = ty < 2;
#pragma unroll
                for (int k = 0; k < 8; ++k) { const float xp = sx<4>(x[k]); const float c = ct[k], sn = st[k];
                    const float rr = lo ? (x[k] * c - xp * sn) : (xp * sn + x[k] * c); x[k] = dor ? rr : x[k]; }
            }
            const size_t base = smp ? (ty == 0 ? Q_QCS : ty == 1 ? Q_KCS : ty == 2 ? Q_VCS : ty == 3 ? Q_QDS : ty == 4 ? Q_KDS : Q_VDS)
                                    : (ty == 0 ? Q_QCP : ty == 1 ? Q_KCP : ty == 2 ? Q_VCP : ty == 3 ? Q_QDP : ty == 4 ? Q_KDP : Q_VDP);
            u32x4 ov; ov.x = cvt_pk_bf16(x[0], x[1]); ov.y = cvt_pk_bf16(x[2], x[3]); ov.z = cvt_pk_bf16(x[4], x[5]); ov.w = cvt_pk_bf16(x[6], x[7]);
            *(u32x4*)(qkv + base + ((size_t)(b * H + hd) * S + s) * 128 + li * 8) = ov;
            if (!smp && (ty == 1 || ty == 2 || ty == 4 || ty == 5)) {
                float* sp = A.out + (ty == 1 ? O_SCK : ty == 2 ? O_SCV : ty == 4 ? O_SDK : O_SDV) + (((size_t)(b * 2 + o) * H + hd) * 256 + s) * 128 + li * 8;
                __builtin_nontemporal_store((f32x4){x[0], x[1], x[2], x[3]}, (f32x4*)sp); __builtin_nontemporal_store((f32x4){x[4], x[5], x[6], x[7]}, (f32x4*)(sp + 4));
            }
        }
    }
}

__device__ __forceinline__ void attn_phase(const Args& A, LAS unsigned char* lds, int G, int o, int wv) {
    const bf16_t* qkv = (const bf16_t*)(ws_opaque(A.ws) + WS_QKV); bf16_t* mixout = (bf16_t*)(ws_opaque(A.ws) + WS_MIXOUT);
    const int c = obid();
    for (int i = 0;; ++i) {
        int u;
        if (G == 256) { if (c < 128) { if (i > 0) break; u = c; } else { if (i >= 4) break; u = 128 + 4 * (c - 128) + i; } }
        else { u = c + i * G; if (u >= 640) break; }
        att::AUnit U;
        if (u < 64) {
            const int b = u >> 5, h = (u >> 2) & 7, qb = u & 3;
            U.q0 = qb * 256; U.kt0 = qb == 0 ? 0 : (qb == 1 ? 0 : (qb == 2 ? 4 : 8)); U.nloc = (qb == 0 || qb == 3) ? 8 : 11; U.nctx = 8; U.nt = 8 + ((U.nloc + 1) & ~1); U.mode = 2;
            U.Q = qkv + Q_QDS + ((size_t)(b * 8 + h) * 1024 + U.q0) * 128; U.O = mixout + (size_t)(MP + b * 1024 + U.q0) * DM + (8 + h) * 128;
            U.Kc = (const bf16_t*)(ws_opaque(A.ws) + WS_CDK) + ((size_t)((b * 2 + o) * 8 + h)) * 512 * 128; U.Vc = (const bf16_t*)(ws_opaque(A.ws) + WS_CDV) + ((size_t)((b * 2 + o) * 8 + h)) * 512 * 128;
            U.Kl = qkv + Q_KDS + ((size_t)(b * 8 + h) * 1024 + U.kt0 * 64) * 128; U.Vl = qkv + Q_VDS + ((size_t)(b * 8 + h) * 1024 + U.kt0 * 64) * 128;
            U.m0 = -1e30f; U.l0 = 0.f; U.rpb = A.in[I_RPB] + ((size_t)o * 8 + h) * 15 * 31;
        } else if (u < 128) {
            const int v = u - 64, b = v >> 5, h = (v >> 2) & 7, qb = v & 3, kvh = h >> 2;
            U.q0 = qb * 256; const int k_lo = qb == 0 ? 0 : 4 * qb - 2, k_hi = qb == 3 ? 15 : 4 * qb + 5;
            U.kt0 = k_lo; U.nloc = k_hi - k_lo + 1; U.nctx = 8; U.nt = 8 + U.nloc; U.mode = 1;
            U.Q = qkv + Q_QCS + ((size_t)(b * 8 + h) * 1024 + U.q0) * 128; U.O = mixout + (size_t)(MP + b * 1024 + U.q0) * DM + h * 128;
            U.Kc = (const bf16_t*)(ws_opaque(A.ws) + WS_CCK) + ((size_t)((b * 2 + o) * 2 + kvh)) * 512 * 128; U.Vc = (const bf16_t*)(ws_opaque(A.ws) + WS_CCV) + ((size_t)((b * 2 + o) * 2 + kvh)) * 512 * 128;
            U.Kl = qkv + Q_KCS + ((size_t)(b * 2 + kvh) * 1024 + U.kt0 * 64) * 128; U.Vl = qkv + Q_VCS + ((size_t)(b * 2 + kvh) * 1024 + U.kt0 * 64) * 128;
            U.m0 = A.in[I_SINK][o * 8 + h] * (1.0f / att::SCALE); U.l0 = 1.f; U.rpb = nullptr;
        } else {
            const int v = u - 128, b = v >> 4, hh = v & 15;
            U.q0 = 0; U.kt0 = 0; U.nloc = 0; U.nctx = 4; U.nt = 4; U.mode = 0; U.rpb = nullptr; U.Kl = nullptr; U.Vl = nullptr;
            U.O = mixout + (size_t)(b * 256) * DM + hh * 128;
            if (hh < 8) { const int kvh = hh >> 2;
                U.Q = qkv + Q_QCP + ((size_t)(b * 8 + hh) * 256) * 128; U.Kc = qkv + Q_KCP + ((size_t)(b * 2 + kvh) * 256) * 128; U.Vc = qkv + Q_VCP + ((size_t)(b * 2 + kvh) * 256) * 128;
                U.m0 = A.in[I_SINK][o * 8 + hh] * (1.0f / att::SCALE); U.l0 = 1.f; }
            else { const int h = hh - 8;
                U.Q = qkv + Q_QDP + ((size_t)(b * 8 + h) * 256) * 128; U.Kc = qkv + Q_KDP + ((size_t)(b * 8 + h) * 256) * 128; U.Vc = qkv + Q_VDP + ((size_t)(b * 8 + h) * 256) * 128;
                U.m0 = -1e30f; U.l0 = 0.f; }
        }
        att::attn_unit(U, (char*)lds, wv);
    }
}

#ifndef ONLY_PH
#define ONLY_PH (-1)
#endif
#define PH(n) (ONLY_PH < 0 || ONLY_PH == (n))
#ifndef DUPMASK
#define DUPMASK 0
#endif
#define DUPN(g) (((DUPMASK >> (g)) & 1) ? 2 : 1)
#define TSMULT 8
#define TS0() do { if (ts_on) ts_t0 = __builtin_amdgcn_s_memrealtime(); } while (0)
#define TSC0() do { if (((TSMASK >> 13) & 1) && ts_on) ts_c0 = (unsigned long long)__builtin_readcyclecounter(); } while (0)
#define TSC1() do { if (((TSMASK >> 13) & 1) && ts_on) { const unsigned long long d_ = (unsigned long long)__builtin_readcyclecounter() - ts_c0; TSACC[0] += (unsigned)(d_ / 20ull); } } while (0)
#define TS1(g) do { if (((TSMASK >> (g)) & 1) && ts_on) { const unsigned long long d_ = __builtin_amdgcn_s_memrealtime() - ts_t0; TSACC[0] += (unsigned)d_; } } while (0)
__global__ void __launch_bounds__(NTHR, 2) mega_fwd(Args args) {
    extern __shared__ __attribute__((aligned(16))) unsigned char lds_raw[];
    LAS unsigned char* lds = (LAS unsigned char*)lds_raw;
    const int G = gridDim.x, wv = __builtin_amdgcn_readfirstlane((int)(threadIdx.x >> 6));
    volatile LAS unsigned* MISC = (volatile LAS unsigned*)(lds + LDS_MISC);
    { const int t0 = ptid(wv); if (t0 < 16) MISC[t0] = 0u; }
    __syncthreads();
    unsigned char* ws = args.ws;
    const bool ts_on = (TSMASK != 0 || TSBAR != 0) && (blockIdx.x == 0) && (wv == 0); unsigned long long ts_t0 = 0, ts_c0 = 0; (void)ts_c0; volatile LAS unsigned* TSACC = MISC + 2; (void)ts_on; (void)ts_t0; (void)TSACC;
    XcdBarrier bar = xcd_barrier_post((unsigned*)(ws + WS_CTL), MISC + 8, ptid(wv));
    const float* mods = (const float*)(ws + WS_MODS);

    int ql = 0, nbar = 0; int lok = 0; int gx = 0, grk = 0;
#ifndef LOCAL_BAR
#define LOCAL_BAR 1
#endif
#define BARRIER2(g, loc) do { TS0(); \
    if (LOCAL_BAR && (loc) && lok) { local_barrier((unsigned*)(ws + WS_CTL), (unsigned*)(ws + WS_CTL) + 8192 + 64 * (20 + gx), 32u, wv); } \
    else { fill_wait(args, lds, G, wv, nbar, ql); for (int br_ = 0; br_ < DUPN(10); ++br_) { xcd_barrier(bar, wv); ++nbar; } } \
    TS1(10); if (((TSBAR >> (g)) & 1) && ts_on) { TSACC[0] += (unsigned)(__builtin_amdgcn_s_memrealtime() - ts_t0); } } while (0)
#define BARRIER(g) BARRIER2(g, false)
    for (int rep = 0; rep < DUPN(0); ++rep) { TS0(); if (PH(0)) prologue_a(args, lds, G, wv); TS1(0); BARRIER(0); }
    if (ptid(wv) == 0) { unsigned* barw = (unsigned*)(ws + WS_CTL); const unsigned myx = MISC[11]; unsigned npop = 0u, below = 0u; bool uni = (G == 256);
        for (unsigned j = 0; j < 16; ++j) { const unsigned cnt = xb_ld(&barw[XB_XCNT(j)]); if (cnt) { ++npop; if (j < myx) ++below; if (cnt != 32u) uni = false; } }
        uni = uni && (npop == 8u); MISC[12] = below; MISC[13] = uni ? 1u : 0u; }
    __syncthreads();
    lok = __builtin_amdgcn_readfirstlane((int)MISC[13]); asm volatile("" : "+s"(lok));
    gx = lok ? __builtin_amdgcn_readfirstlane((int)MISC[12]) : (int)(blockIdx.x & 7);
    grk = lok ? __builtin_amdgcn_readfirstlane((int)MISC[10]) : (int)(blockIdx.x >> 3);
    TS0(); if (PH(1)) prologue_b(args, lds, G, wv); TS1(11);
    BARRIER(11);

    for (int layer = 0; layer < 4; ++layer) {
        const bf16_t* wl = (const bf16_t*)(ws + WS_W) + (size_t)layer * W_LAYER;
        const bool odd = layer & 1; const int eo = layer >> 1;
        for (int rep = 0; rep < DUPN(5); ++rep) {
            TS0(); if (PH(2)) nm_phase(args, G, layer == 0 && rep == 0, layer > 0 && rep == 0, 0.5f, layer - 1, 8, true, args.in[I_GF1] + (size_t)layer * DM, layer, 0, wv, true, gx, grk); TS1(5);
            BARRIER2(5, true); }
        for (int rep = 0; rep < DUPN(1); ++rep) {
            TS0(); TSC0(); if (PH(3)) { pg8::SchedStd S{(const char*)(ws + WS_H), (const char*)(wl + W_GU1), DM, DM, DM / 128, MTOT / 256, NGU / 256, (MTOT / 256) * (NGU / 256), G, obid(), (char*)(ws + WS_ACT), DFF, 128, gx, grk};
              pg8::EpiGU8 E{(const float*)(ws + WS_RSC), (const float*)(ws + WS_CMAX) + (size_t)(layer * 2 + 0) * NGU}; pg8::gemm_phase<pg8::EpiGU8, pg8::SchedStd, G_ALIGN, G_SP2, true>(lds, S, E, wv); } TS1(1); TSC1();
            BARRIER2(1, true); }
        for (int rep = 0; rep < DUPN(2); ++rep) {
            TS0(); if (PH(4)) { q8act_phase(args, wv, gx, grk); BARRIER2(2, true);
              pg8::SchedSplit S{(const char*)(ws + WS_ACT8), (const char*)(wl + W_DN1), KD8, KD8, KD8 / 128, 12, G, obid(), gx, grk};
              pg8::EpiResid8 E{args.out, mods + ((size_t)layer * 3) * NMODV + 2 * DM, rep == 0 ? 0.5f : 0.0f, (float*)(ws + WS_SLAB), (const float*)(ws + WS_RSC2), (const float*)(ws + WS_CMAX2) + (size_t)(layer * 2 + 0) * DM};
              pg8::gemm_phase<pg8::EpiResid8, pg8::SchedSplit, G_ALIGN, G_SP2, true>(lds, S, E, wv); } TS1(2);
            BARRIER2(2, true); }
        for (int rep = 0; rep < DUPN(5); ++rep) {
            TS0(); if (PH(5)) nm_phase(args, G, false, rep == 0, 0.5f, layer, 2, true, args.in[I_GMIX] + (size_t)layer * DM, layer, 3, wv, false, gx, grk); TS1(5);
            BARRIER2(5, true); }
        for (int rep = 0; rep < DUPN(3); ++rep) {
            TS0(); if (PH(6)) { const int nin = odd ? NIN_O : NIN_E;
              pg8::SchedStd S{(const char*)(ws + WS_H), (const char*)(wl + W_IN), DM * 2, DM * 2, DM / 64, MTOT / 256, nin / 256, (MTOT / 256) * (nin / 256), G, obid(), (char*)(ws + WS_MIXIN), nin, 256, gx, grk};
              pg8::EpiBf16 E{1.0f};
              pg8::gemm_phase<pg8::EpiBf16, pg8::SchedStd, G_ALIGN, G_SP2>(lds, S, E, wv); } TS1(3);
            BARRIER2(3, odd); }
        if (!odd) {
            for (int rep = 0; rep < DUPN(6); ++rep) {
                TS0(); if (PH(7)) { pg8::SchedF1 S{(const char*)(ws + WS_T256), (const char*)(ws + WS_MIXIN), (char*)(ws + WS_GT), (char*)(ws + WS_GTS), 512, NIN_E * 2, G, obid()};
                  pg8::EpiBf16 E{1.0f};
                  pg8::gemm_phase<pg8::EpiBf16, pg8::SchedF1, G_ALIGN, G_SP2>(lds, S, E, wv); }
                vstat_phase(args, G, wv); TS1(6);
                BARRIER(6); }
            for (int rep = 0; rep < DUPN(7); ++rep) {
                TS0(); if (PH(9)) { pg8::SchedF2 S{(const char*)(ws + WS_CS256), (const char*)(ws + WS_CS1024), (const char*)(ws + WS_GT), (const char*)(ws + WS_GTS), (char*)(ws + WS_MIXOUT), 4096, 4096, G, obid()};
                  pg8::EpiF2 E2;
                  pg8::gemm_phase<pg8::EpiF2, pg8::SchedF2, G_ALIGN, G_SP2>(lds, S, E2, wv); }
                if (PH(8)) sgu_phase(args, lds, G, eo, wv); TS1(7);
                }
        } else {
            for (int rep = 0; rep < DUPN(8); ++rep) { TS0(); if (PH(10)) prep_phase(args, G, eo, wv, gx, grk); TS1(8); BARRIER(8); }
            for (int rep = 0; rep < DUPN(9); ++rep) { TS0(); if (PH(11)) attn_phase(args, lds, G, eo, wv); TS1(9); }
        }
        if (layer == 0) { while (fill_round(args, lds, 0, wv)) {} if (ql <= 0) ql = 1; }
        if (layer < 3) { while (fill_round(args, lds, layer + 1, wv)) {} if (ql <= layer + 1) ql = layer + 2; }
        BARRIER(9);
        for (int rep = 0; rep < DUPN(4); ++rep) {
            TS0(); if (PH(12)) { pg8::SchedSplit S{(const char*)(ws + WS_MIXOUT), (const char*)(wl + W_OUT), DM * 2, DM * 2, DM / 64, 8, G, obid(), gx, grk};
              pg8::EpiResid E{args.out, mods + ((size_t)layer * 3) * NMODV + 5 * DM, rep == 0 ? 1.0f : 0.0f, (float*)(ws + WS_SLAB)};
              pg8::gemm_phase<pg8::EpiResid, pg8::SchedSplit, G_ALIGN, G_SP2>(lds, S, E, wv); } TS1(4);
            BARRIER2(4, true); }
        for (int rep = 0; rep < DUPN(5); ++rep) {
            TS0(); if (PH(13)) nm_phase(args, G, false, rep == 0, 1.0f, layer, 5, true, args.in[I_GF2] + (size_t)layer * DM, layer, 6, wv, true, gx, grk); TS1(5);
            BARRIER2(5, true); }
        for (int rep = 0; rep < DUPN(1); ++rep) {
            TS0(); TSC0(); if (PH(14)) { pg8::SchedStd S{(const char*)(ws + WS_H), (const char*)(wl + W_GU2), DM, DM, DM / 128, MTOT / 256, NGU / 256, (MTOT / 256) * (NGU / 256), G, obid(), (char*)(ws + WS_ACT), DFF, 128, gx, grk};
              pg8::EpiGU8 E{(const float*)(ws + WS_RSC), (const float*)(ws + WS_CMAX) + (size_t)(layer * 2 + 1) * NGU}; pg8::gemm_phase<pg8::EpiGU8, pg8::SchedStd, G_ALIGN, G_SP2, true>(lds, S, E, wv); } TS1(1); TSC1();
            BARRIER2(1, true); }
        for (int rep = 0; rep < DUPN(2); ++rep) {
            TS0(); if (PH(15)) { q8act_phase(args, wv, gx, grk); BARRIER2(2, true);
              pg8::SchedSplit S{(const char*)(ws + WS_ACT8), (const char*)(wl + W_DN2), KD8, KD8, KD8 / 128, 12, G, obid(), gx, grk};
              pg8::EpiResid8 E{args.out, mods + ((size_t)layer * 3) * NMODV + 8 * DM, rep == 0 ? 0.5f : 0.0f, (float*)(ws + WS_SLAB), (const float*)(ws + WS_RSC2), (const float*)(ws + WS_CMAX2) + (size_t)(layer * 2 + 1) * DM};
              pg8::gemm_phase<pg8::EpiResid8, pg8::SchedSplit, G_ALIGN, G_SP2, true>(lds, S, E, wv); } TS1(2);
            BARRIER2(2, true); }
    }
    TS0(); if (PH(16)) nm_phase(args, G, false, true, 0.5f, 3, 8, false, nullptr, 0, 0, wv, false, gx, grk); TS1(11);
    if (ts_on) { const unsigned long long te_ = __builtin_amdgcn_s_memrealtime() + (unsigned long long)TSMULT * TSACC[0]; while (__builtin_amdgcn_s_memrealtime() < te_) __builtin_amdgcn_s_sleep(8); }
#undef BARRIER
}

extern "C" void kernel_launch(void* const* d_in, const int* in_sizes, int n_in, void* d_out, int out_size, void* d_ws, size_t ws_size, hipStream_t stream) {
    static int grid = 0;
    if (grid == 0) {
        if (n_in != 29 || (size_t)out_size != O_END || ws_size < WS_END) {
            fprintf(stderr, "kernel_launch: unexpected shapes: n_in %d out %d ws %zu (need %zu)\n", n_in, out_size, ws_size, (size_t)WS_END); grid = -1; return; }
        int dev = 0, cus = 0, per_cu = 0;
        if (hipGetDevice(&dev) != hipSuccess || hipDeviceGetAttribute(&cus, hipDeviceAttributeMultiprocessorCount, dev) != hipSuccess) { grid = -1; return; }
        if (hipFuncSetAttribute((const void*)mega_fwd, hipFuncAttributeMaxDynamicSharedMemorySize, LDS_BYTES) != hipSuccess) { fprintf(stderr, "kernel_launch: hipFuncSetAttribute failed\n"); grid = -1; return; }
        if (hipOccupancyMaxActiveBlocksPerMultiprocessor(&per_cu, (const void*)mega_fwd, NTHR, LDS_BYTES) != hipSuccess || per_cu < 1)
            fprintf(stderr, "kernel_launch: occupancy query reports %d\n", per_cu);
        (void)hipGetLastError();
        if (cus != 256) { fprintf(stderr, "kernel_launch: built for a 256-CU device (8 groups of 32 workgroups), found %d CUs; nothing launched\n", cus); grid = -1; return; }
        grid = cus;
    }
    if (grid < 0) return;
    if (hipMemsetAsync((char*)d_ws + WS_CTL, 0, CTL_ZERO_BYTES, stream) != hipSuccess) { fprintf(stderr, "kernel_launch: memset failed\n"); return; }
    Args a{};
    for (int i = 0; i < 29; ++i) a.in[i] = (const float*)d_in[i];
    a.out = (float*)d_out; a.ws = (unsigned char*)d_ws;
    hipLaunchKernelGGL(mega_fwd, dim3(grid), dim3(NTHR), LDS_BYTES, stream, a);
    const hipError_t le = hipPeekAtLastError();
    if (le != hipSuccess) fprintf(stderr, "kernel_launch: launch failed: %s\n", hipGetErrorName(le));
}
```

```cpp
#include <hip/hip_runtime.h>
#include <cstdio>
#include <cstdint>

#define LAS __attribute__((address_space(3)))
#define GAS __attribute__((address_space(1)))
typedef unsigned short bf16_t;
typedef short bf16x8 __attribute__((ext_vector_type(8)));
typedef short s16x4 __attribute__((ext_vector_type(4)));
typedef float f32x2 __attribute__((ext_vector_type(2)));
typedef float f32x4 __attribute__((ext_vector_type(4)));
typedef float f32x8 __attribute__((ext_vector_type(8)));
typedef float f32x16 __attribute__((ext_vector_type(16)));
typedef unsigned u32x2 __attribute__((ext_vector_type(2)));
typedef unsigned u32x4 __attribute__((ext_vector_type(4)));
typedef int i32x4 __attribute__((ext_vector_type(4)));

#ifndef TSMASK
#define TSMASK 0
#endif
#ifndef TSBAR
#define TSBAR 0
#endif
constexpr int DM = 2048, MP = 8192, MS = 2048, MTOT = 10240, DFF = 5504, NGU = 11008, NIN_E = 3072, NIN_O = 4608, NMODV = 18432;
constexpr float EPS = 1e-6f;
constexpr int NWAVES = 8, NTHR = 512;
#ifndef G_ALIGN
#define G_ALIGN true
#endif
#ifndef G_SP2
#define G_SP2 true
#endif

constexpr size_t MiB = 1u << 20;
constexpr size_t WS_CTL = 0, CTL_ZERO_BYTES = 1024 * 1024;
constexpr size_t WS_CMAX = 512 * 1024;
constexpr size_t WS_MODS = 1 * MiB;
constexpr size_t WS_ADAP = 2 * MiB;
constexpr size_t WS_SSQ_OLD = 6 * MiB;
constexpr size_t WS_RSC = 6 * MiB + 704 * 1024;
constexpr size_t WS_RSC2 = 6 * MiB + 768 * 1024;
constexpr size_t WS_CMAX2 = 6 * MiB + 832 * 1024;
constexpr size_t WS_T256 = 7 * MiB;
constexpr size_t WS_ROPE = WS_T256 + 262144;
constexpr size_t WS_WSGU = 8 * MiB;
constexpr size_t WS_CS1024 = 9 * MiB;
constexpr size_t WS_CS256 = 23 * MiB;
constexpr size_t WS_CCK = 13 * MiB;
constexpr size_t WS_CCV = 14 * MiB, WS_CDK = 15 * MiB, WS_CDV = 19 * MiB;
constexpr size_t WS_H = 24 * MiB;
constexpr size_t WS_ACT = 64 * MiB;
constexpr size_t WS_MIXIN = 172 * MiB;
constexpr size_t WS_MIXOUT = 262 * MiB;
constexpr size_t WS_SLAB = 302 * MiB;
constexpr size_t WS_GT = 366 * MiB;
constexpr size_t WS_GTS = WS_GT + 128 * MiB;
constexpr size_t WS_QKV = 366 * MiB;
constexpr size_t WS_W = 502 * MiB;
constexpr size_t W_GU1 = 0, W_DN1 = (size_t)NGU * DM, W_GU2 = W_DN1 + (size_t)DM * DFF, W_DN2 = W_GU2 + (size_t)NGU * DM, W_OUT = W_DN2 + (size_t)DM * DFF,
                 W_IN = W_OUT + (size_t)DM * DM, W_LAYER = W_IN + (size_t)NIN_O * DM;
constexpr size_t WS_ACT8 = WS_W + 4 * W_LAYER * 2;
constexpr int KD8 = 5632;
constexpr size_t WS_SSQ = WS_ACT8 + (size_t)MTOT * KD8;
constexpr size_t WS_END = WS_SSQ + (size_t)MTOT * 4;
constexpr size_t Q_QCP = 0, Q_KCP = Q_QCP + (size_t)MP * 1024, Q_VCP = Q_KCP + (size_t)MP * 256, Q_QDP = Q_VCP + (size_t)MP * 256, Q_KDP = Q_QDP + (size_t)MP * 1024,
                 Q_VDP = Q_KDP + (size_t)MP * 1024, Q_QCS = Q_VDP + (size_t)MP * 1024, Q_KCS = Q_QCS + (size_t)MS * 1024, Q_VCS = Q_KCS + (size_t)MS * 256,
                 Q_QDS = Q_VCS + (size_t)MS * 256, Q_KDS = Q_QDS + (size_t)MS * 1024, Q_VDS = Q_KDS + (size_t)MS * 1024, Q_END = Q_VDS + (size_t)MS * 1024;
static_assert(WS_QKV + Q_END * 2 <= WS_W, "qkv region");
constexpr size_t O_YP = 0, O_YS = (size_t)MP * DM, O_SCK = O_YS + (size_t)MS * DM, O_SCV = O_SCK + (size_t)32 * 2 * 2 * 256 * 128, O_SDK = O_SCV + (size_t)32 * 2 * 2 * 256 * 128,
                 O_SDV = O_SDK + (size_t)32 * 2 * 8 * 256 * 128, O_END = O_SDV + (size_t)32 * 2 * 8 * 256 * 128;

constexpr int LDS_BYTES = 147456;
constexpr int LDS_MISC = 135168;

#define LDS_WAIT() asm volatile("s_waitcnt lgkmcnt(0)" ::: "memory")
#define VM_WAIT() asm volatile("s_waitcnt vmcnt(0)" ::: "memory")
__device__ __forceinline__ unsigned f2bf(float f) { unsigned u = __builtin_bit_cast(unsigned, f); return (u + 0x7fffu + ((u >> 16) & 1u)) >> 16; }
__device__ __forceinline__ unsigned pk2(float lo, float hi) { return f2bf(lo) | (f2bf(hi) << 16); }
__device__ __forceinline__ unsigned cvt_pk_bf16(float lo, float hi) { unsigned r; asm volatile("v_cvt_pk_bf16_f32 %0, %1, %2" : "=v"(r) : "v"(lo), "v"(hi)); return r; }
typedef __bf16 bf16x2_t __attribute__((ext_vector_type(2)));
__device__ __forceinline__ unsigned cvt_pk_bf16_b(float lo, float hi) { f32x2 v = {lo, hi}; bf16x2_t b = __builtin_convertvector(v, bf16x2_t); return __builtin_bit_cast(unsigned, b); }
__device__ __forceinline__ float bf_lo(unsigned w) { return __uint_as_float(w << 16); }
__device__ __forceinline__ float bf_hi(unsigned w) { return __uint_as_float(w & 0xffff0000u); }
__device__ __forceinline__ int ptid(int wv) { int t = wv * 64 + (int)__builtin_amdgcn_mbcnt_hi(~0u, __builtin_amdgcn_mbcnt_lo(~0u, 0u)); asm volatile("" : "+v"(t)); return t; }
__device__ __forceinline__ unsigned char* ws_opaque(unsigned char* p) { asm volatile("" : "+s"(p)); return p; }
__device__ __forceinline__ int obid() { int b = (int)blockIdx.x; asm volatile("" : "+s"(b)); return b; }
template <int M> __device__ __forceinline__ float sx(float v) { return __int_as_float(__builtin_amdgcn_ds_swizzle(__float_as_int(v), (M << 10) | 0x1f)); }
__device__ __forceinline__ float sum32(float v) { auto rr = __builtin_amdgcn_permlane32_swap(__float_as_uint(v), __float_as_uint(v), false, false); return __uint_as_float(rr[0]) + __uint_as_float(rr[1]); }
__device__ __forceinline__ float max32(float v) { auto rr = __builtin_amdgcn_permlane32_swap(__float_as_uint(v), __float_as_uint(v), false, false); return fmaxf(__uint_as_float(rr[0]), __uint_as_float(rr[1])); }
__device__ __forceinline__ float wave_sum(float v) { v += sx<1>(v); v += sx<2>(v); v += sx<4>(v); v += sx<8>(v); v += sx<16>(v); return sum32(v); }
__device__ __forceinline__ float wave_max(float v) { v = fmaxf(v, sx<1>(v)); v = fmaxf(v, sx<2>(v)); v = fmaxf(v, sx<4>(v)); v = fmaxf(v, sx<8>(v)); v = fmaxf(v, sx<16>(v)); return max32(v); }

#define XB_TMO      128
#define XB_XCNT(j)  (256  + 64 * (j))
#define XB_XSUB(j)  (1280 + 64 * (j))
#define XB_XGEN(j)  (2304 + 64 * (j))
#define XB_TOP      3328
#define XB_TOPGEN   3392
#define XCD_BAR_WORDS 3456
#define XB_SPIN_CAP (1u << 18)
__device__ __forceinline__ unsigned xb_ld(unsigned* p)              { return __hip_atomic_load(p, __ATOMIC_RELAXED, __HIP_MEMORY_SCOPE_AGENT); }
__device__ __forceinline__ unsigned xb_add(unsigned* p, unsigned v) { return __hip_atomic_fetch_add(p, v, __ATOMIC_RELAXED, __HIP_MEMORY_SCOPE_AGENT); }
__device__ __forceinline__ unsigned xb_xcc_id() { return (unsigned)__builtin_amdgcn_s_getreg((3 << 11) | 20) & 0xFu; }
#define XB_SPIN(cond, bar) do { unsigned _sp = 0; while (cond) { __builtin_amdgcn_s_sleep(1); \
    if ((++_sp & 255u) == 0u) { if (xb_ld(&(bar)[XB_TMO])) break; if (_sp > XB_SPIN_CAP) { atomicAdd(&(bar)[XB_TMO], 1u); break; } } } } while (0)
struct XcdBarrier { unsigned* bar; unsigned x; volatile LAS unsigned* st; };
__device__ __forceinline__ XcdBarrier xcd_barrier_post(unsigned* bar, volatile LAS unsigned* st, int tid) {
    XcdBarrier b; b.bar = bar; b.x = 0; b.st = st;
    if (tid == 0) { const unsigned xcc = xb_xcc_id(); st[2] = xb_add(&bar[XB_XCNT(xcc)], 1u); st[3] = xcc; }
    return b;
}
__device__ __forceinline__ void xcd_barrier_complete(unsigned* bar, unsigned x, unsigned& nloc, unsigned& nx) {
    const unsigned G = gridDim.x * gridDim.y * gridDim.z;
    unsigned sum, cnt, mine, sp = 0u;
    for (;;) {
        sum = 0u; cnt = 0u; mine = 0u;
#pragma unroll
        for (unsigned j = 0; j < 16; ++j) { const unsigned c = xb_ld(&bar[XB_XCNT(j)]); sum += c; cnt += (c > 0u) ? 1u : 0u; mine = (j == x) ? c : mine; }
        if (sum == G) break;
        __builtin_amdgcn_s_sleep(1);
        if ((++sp & 255u) == 0u) { if (xb_ld(&bar[XB_TMO])) break; if (sp > XB_SPIN_CAP) { atomicAdd(&bar[XB_TMO], 1u); break; } }
    }
    nloc = mine > 0u ? mine : 1u; nx = cnt > 0u ? cnt : 1u;
}
__device__ __forceinline__ void xcd_barrier(const XcdBarrier& b, int wv) {
    asm volatile("s_waitcnt vmcnt(0)" ::: "memory");
    __syncthreads();
    if (ptid(wv) == 0) {
        unsigned* bar = b.bar; const unsigned bx = xb_xcc_id();
        __builtin_amdgcn_s_waitcnt(0);
        unsigned nloc = b.st[0], nx = b.st[1];
        if (nloc == 0u) { xcd_barrier_complete(bar, bx, nloc, nx); b.st[0] = nloc; b.st[1] = nx; }
        const unsigned old = xb_add(&bar[XB_XSUB(bx)], 1u);
        const unsigned gen = old / nloc;
        if (old + 1u == (gen + 1u) * nloc) {
            __builtin_amdgcn_fence(__ATOMIC_RELEASE, "agent");
            asm volatile("s_waitcnt vmcnt(0)" ::: "memory");
            const unsigned og = xb_add(&bar[XB_TOP], 1u);
            const unsigned tg = og / nx;
            if (og + 1u == (tg + 1u) * nx) xb_add(&bar[XB_TOPGEN], 1u);
            else XB_SPIN(xb_ld(&bar[XB_TOPGEN]) == tg, bar);
            __builtin_amdgcn_fence(__ATOMIC_ACQUIRE, "agent");
            xb_add(&bar[XB_XGEN(bx)], 1u);
            asm volatile("s_waitcnt vmcnt(0)" ::: "memory");
        } else {
            XB_SPIN(xb_ld(&bar[XB_XGEN(bx)]) == gen, bar);
            __builtin_amdgcn_fence(__ATOMIC_ACQUIRE, "agent");
            asm volatile("s_waitcnt vmcnt(0)" ::: "memory");
        }
    }
    __syncthreads();
}

__device__ __forceinline__ void local_barrier(unsigned* bar, unsigned* lb, unsigned gsize, int wv) {
    asm volatile("s_waitcnt vmcnt(0)" ::: "memory");
    __syncthreads();
    if (ptid(wv) == 0) {
        __builtin_amdgcn_s_waitcnt(0);
        const unsigned old = xb_add(lb, 1u), target = (old / gsize + 1u) * gsize;
        XB_SPIN(xb_ld(lb) < target, bar);
        __builtin_amdgcn_fence(__ATOMIC_ACQUIRE, "agent");
        asm volatile("s_waitcnt vmcnt(0)" ::: "memory");
    }
    __syncthreads();
}

namespace pg8 {
constexpr int BM = 256, BK = 64, HALF = 128, HTB = HALF * BK * 2, STAGE_BYTES = 8 * HTB;
__device__ __forceinline__ int lds_byte(int r, int c) { const int st = (r >> 4) * 2 + (c >> 5), rr = r & 15, cc = c & 31, ob = rr * 64 + cc * 2; return st * 1024 + (ob ^ (((ob >> 9) & 1) << 5)); }
__device__ __forceinline__ void stage_rc(int b, int& R, int& C) { const int st = b / 1024, sb = b % 1024, swz = sb ^ (((sb >> 9) & 1) << 5); R = (st >> 1) * 16 + swz / 64; C = (st & 1) * 32 + (swz % 64) / 2; }
__device__ __forceinline__ int perm32(int rho) { const int n = rho >> 4, i = rho & 15; return 8 * (i >> 2) + 4 * n + (i & 3); }

struct GUnit { const char* a; const char* b; int nt; int pm, pn, ks; };

template <bool I8> struct AccT { typedef f32x4 T; };
template <> struct AccT<true> { typedef i32x4 T; };
template <class Epi, class Sched, bool ALIGN_EPI, bool SP2, bool I8 = false>
__device__ __forceinline__ void gemm_phase(LAS unsigned char* lds, const Sched& S, const Epi& E, int wv) {
    const int tid = ptid(wv);
    const int wid = wv, lane = tid & 63, wr = wid >> 2, wc = wid & 3, fr = lane & 15, fq = lane >> 4;
    unsigned cvA0, cvA1, cvB0, cvB1;
    { int R0, C0, R1, C1; stage_rc(tid * 16, R0, C0); stage_rc(tid * 16 + 8192, R1, C1);
      const int Rb0 = Epi::PERM ? ((R0 & ~31) + perm32(R0 & 31)) : R0, Rb1 = Epi::PERM ? ((R1 & ~31) + perm32(R1 & 31)) : R1;
      cvA0 = (unsigned)(R0 * S.lda2 + C0 * 2); cvA1 = (unsigned)(R1 * S.lda2 + C1 * 2); cvB0 = (unsigned)(Rb0 * S.ldb2 + C0 * 2); cvB1 = (unsigned)(Rb1 * S.ldb2 + C1 * 2); }
    const unsigned ldsw = (unsigned)wid * 1024u;
    const int aoff = lds_byte(wr * 64 + fr, fq * 8), boff = lds_byte(wc * 32 + fr, fq * 8);
#define PG8_SA(b, h) (((b) * 2 + (h)) * HTB)
#define PG8_SB(b, h) ((4 + (b) * 2 + (h)) * HTB)
#define PG8_STAGE(bufoff, gbase, v0, v1) do { \
        __builtin_amdgcn_global_load_lds((const unsigned*)((const char*)(gbase) + (v0)), (LAS unsigned*)(lds + (bufoff) + ldsw), 16, 0, 0); \
        __builtin_amdgcn_global_load_lds((const unsigned*)((const char*)(gbase) + (v1)), (LAS unsigned*)(lds + (bufoff) + ldsw + 8192), 16, 0, 0); } while (0)
#define PG8_LDA(dst, b, h) do { _Pragma("unroll") for (int m = 0; m < 4; ++m) _Pragma("unroll") for (int k = 0; k < 2; ++k) dst[m][k] = *(const LAS bf16x8*)(lds + PG8_SA(b, h) + aoff + m * 2048 + k * 1024); } while (0)
#define PG8_LDB(dst, b, h) do { _Pragma("unroll") for (int n = 0; n < 2; ++n) _Pragma("unroll") for (int k = 0; k < 2; ++k) dst[n][k] = *(const LAS bf16x8*)(lds + PG8_SB(b, h) + boff + n * 2048 + k * 1024); } while (0)
#define PG8_MMA(ai, bj, At, Bt) do { __builtin_amdgcn_s_setprio(1); _Pragma("unroll") for (int m = 0; m < 4; ++m) _Pragma("unroll") for (int n = 0; n < 2; ++n) _Pragma("unroll") for (int k = 0; k < 2; ++k) { \
        if constexpr (I8) acc[ai][bj][m][n] = __builtin_amdgcn_mfma_i32_16x16x64_i8(__builtin_bit_cast(i32x4, Bt[n][k]), __builtin_bit_cast(i32x4, At[m][k]), acc[ai][bj][m][n], 0, 0, 0); \
        else acc[ai][bj][m][n] = __builtin_amdgcn_mfma_f32_16x16x32_bf16(Bt[n][k], At[m][k], acc[ai][bj][m][n], 0, 0, 0); } __builtin_amdgcn_s_setprio(0); } while (0)
#define PG8_WAIT_V(n) asm volatile("s_waitcnt vmcnt(" #n ")" ::: "memory")
#define PG8_WAIT_L(n) asm volatile("s_waitcnt lgkmcnt(" #n ")" ::: "memory")
#define PG8_BAR __builtin_amdgcn_s_barrier()
#define PG8_SCHED __builtin_amdgcn_sched_barrier(0)
    GUnit cur, nxt; int ui = 0;
    if (!S.next(0, cur)) return;
    typedef typename AccT<I8>::T acc_t;
    acc_t acc[2][2][4][2];
    acc_t zz = (acc_t){0, 0, 0, 0}; asm volatile("" : "+v"(zz));
#pragma unroll
    for (int a = 0; a < 2; ++a)
#pragma unroll
        for (int b = 0; b < 2; ++b)
#pragma unroll
            for (int m = 0; m < 4; ++m)
#pragma unroll
                for (int n = 0; n < 2; ++n) acc[a][b][m][n] = zz;
    bf16x8 At[4][2], B0[2][2], B1[2][2];
    const size_t chA = (size_t)HALF * S.lda2, chB = (size_t)HALF * S.ldb2;
    const size_t kstep = (size_t)(BK * 2);
    const char* cA = cur.a; const char* cB = cur.b;
    if constexpr (SP2) {
        PG8_STAGE(PG8_SB(0, 0), cB, cvB0, cvB1); PG8_STAGE(PG8_SB(0, 1), cB + chB, cvB0, cvB1); PG8_STAGE(PG8_SA(0, 0), cA, cvA0, cvA1); PG8_STAGE(PG8_SA(0, 1), cA + chA, cvA0, cvA1);
        if (wr == 1) PG8_BAR;
        PG8_WAIT_V(2); PG8_BAR;
        PG8_STAGE(PG8_SB(1, 0), cB + kstep, cvB0, cvB1); PG8_STAGE(PG8_SA(1, 0), cA + kstep, cvA0, cvA1); PG8_STAGE(PG8_SB(1, 1), cB + chB + kstep, cvB0, cvB1);
        PG8_WAIT_V(6); PG8_BAR;
    } else {
        PG8_STAGE(PG8_SB(0, 0), cB, cvB0, cvB1); PG8_STAGE(PG8_SA(0, 0), cA, cvA0, cvA1); PG8_STAGE(PG8_SB(0, 1), cB + chB, cvB0, cvB1); PG8_STAGE(PG8_SA(0, 1), cA + chA, cvA0, cvA1);
        if (wr == 1) PG8_BAR;
        PG8_WAIT_V(4); PG8_BAR;
        PG8_STAGE(PG8_SB(1, 0), cB + kstep, cvB0, cvB1); PG8_STAGE(PG8_SA(1, 0), cA + kstep, cvA0, cvA1); PG8_STAGE(PG8_SB(1, 1), cB + chB + kstep, cvB0, cvB1);
        PG8_WAIT_V(6); PG8_BAR;
    }
    for (;;) {
        const bool has_next = S.next(ui + 1, nxt);
        const char* nA = has_next ? nxt.a : cA; const char* nB = has_next ? nxt.b : cB;
        int nt = cur.nt; asm volatile("" : "+s"(nt));
        for (int t = 0; t < nt; t += 2) {
            const bool last = (t == nt - 2);
            const char* a1 = cA + (size_t)(t + 1) * kstep;
            const char* a2 = last ? nA : cA + (size_t)(t + 2) * kstep; const char* b2 = last ? nB : cB + (size_t)(t + 2) * kstep;
            const char* a3 = a2 + kstep; const char* b3 = b2 + kstep;
            if constexpr (SP2) {
            PG8_LDB(B0, 0, 0); PG8_LDB(B1, 0, 1); PG8_SCHED; PG8_LDA(At, 0, 0); PG8_STAGE(PG8_SA(1, 1), a1 + chA, cvA0, cvA1);
            PG8_WAIT_V(8); PG8_WAIT_L(0); PG8_BAR; PG8_MMA(0, 0, At, B0); PG8_MMA(0, 1, At, B1); PG8_BAR; PG8_SCHED;
            PG8_LDA(At, 0, 1); PG8_STAGE(PG8_SB(0, 0), b2, cvB0, cvB1); PG8_STAGE(PG8_SB(0, 1), b2 + chB, cvB0, cvB1); PG8_STAGE(PG8_SA(0, 0), a2, cvA0, cvA1);
            PG8_WAIT_V(8); PG8_WAIT_L(0); PG8_BAR; PG8_MMA(1, 0, At, B0); PG8_MMA(1, 1, At, B1); PG8_BAR; PG8_SCHED;
            PG8_LDB(B0, 1, 0); PG8_LDB(B1, 1, 1); PG8_SCHED; PG8_LDA(At, 1, 0); PG8_STAGE(PG8_SA(0, 1), a2 + chA, cvA0, cvA1);
            PG8_WAIT_V(8); PG8_WAIT_L(0); PG8_BAR; PG8_MMA(0, 0, At, B0); PG8_MMA(0, 1, At, B1); PG8_BAR; PG8_SCHED;
            PG8_LDA(At, 1, 1); PG8_STAGE(PG8_SB(1, 0), b3, cvB0, cvB1); PG8_STAGE(PG8_SB(1, 1), b3 + chB, cvB0, cvB1); PG8_STAGE(PG8_SA(1, 0), a3, cvA0, cvA1);
            PG8_WAIT_V(8); PG8_WAIT_L(0); PG8_BAR; PG8_MMA(1, 0, At, B0); PG8_MMA(1, 1, At, B1); PG8_BAR; PG8_SCHED;
            } else {
            PG8_LDB(B0, 0, 0); PG8_SCHED; PG8_LDA(At, 0, 0); PG8_STAGE(PG8_SA(1, 1), a1 + chA, cvA0, cvA1);
            PG8_WAIT_L(8); PG8_BAR; PG8_WAIT_L(0); PG8_MMA(0, 0, At, B0); PG8_BAR; PG8_SCHED;
            PG8_LDB(B1, 0, 1); PG8_STAGE(PG8_SB(0, 0), b2, cvB0, cvB1);
            PG8_BAR; PG8_WAIT_L(0); PG8_MMA(0, 1, At, B1); PG8_BAR;
            PG8_LDA(At, 0, 1); PG8_STAGE(PG8_SA(0, 0), a2, cvA0, cvA1);
            PG8_BAR; PG8_WAIT_L(0); PG8_MMA(1, 0, At, B0); PG8_BAR; PG8_SCHED;
            PG8_STAGE(PG8_SB(0, 1), b2 + chB, cvB0, cvB1);
            PG8_WAIT_V(6); PG8_BAR; PG8_MMA(1, 1, At, B1); PG8_BAR;
            PG8_LDB(B0, 1, 0); PG8_SCHED; PG8_LDA(At, 1, 0); PG8_STAGE(PG8_SA(0, 1), a2 + chA, cvA0, cvA1);
            PG8_WAIT_L(8); PG8_BAR; PG8_WAIT_L(0); PG8_MMA(0, 0, At, B0); PG8_BAR; PG8_SCHED;
            PG8_LDB(B1, 1, 1); PG8_STAGE(PG8_SB(1, 0), b3, cvB0, cvB1);
            PG8_BAR; PG8_WAIT_L(0); PG8_MMA(0, 1, At, B1); PG8_BAR;
            PG8_LDA(At, 1, 1); PG8_STAGE(PG8_SA(1, 0), a3, cvA0, cvA1);
            PG8_BAR; PG8_WAIT_L(0); PG8_MMA(1, 0, At, B0); PG8_BAR; PG8_SCHED;
            PG8_STAGE(PG8_SB(1, 1), b3 + chB, cvB0, cvB1);
            PG8_WAIT_V(6); PG8_BAR; PG8_MMA(1, 1, At, B1); PG8_BAR;
            }
        }
        unsigned long long te0_ = 0; const bool tse_ = ((TSMASK >> 12) & 1) && blockIdx.x == 0 && wv == 0;
        if (tse_) te0_ = __builtin_amdgcn_s_memrealtime();
        if constexpr (ALIGN_EPI) { if (wr == 0) PG8_BAR; }
        E(acc, cur, S, wr, wc, fr, fq);
        if (tse_) { volatile LAS unsigned* ta_ = (volatile LAS unsigned*)(lds + 135168 + 8); ta_[0] += (unsigned)(__builtin_amdgcn_s_memrealtime() - te0_); }
        if (!has_next) break;
        acc_t z2 = (acc_t){0, 0, 0, 0}; asm volatile("" : "+v"(z2));
#pragma unroll
        for (int a = 0; a < 2; ++a)
#pragma unroll
            for (int b = 0; b < 2; ++b)
#pragma unroll
                for (int m = 0; m < 4; ++m)
#pragma unroll
                    for (int n = 0; n < 2; ++n) acc[a][b][m][n] = z2;
        cur = nxt; cA = nA; cB = nB; ++ui;
        if constexpr (ALIGN_EPI) { if (wr == 1) PG8_BAR; }
    }
    PG8_WAIT_V(0);
    if constexpr (!ALIGN_EPI) { if (wr == 0) PG8_BAR; }
    PG8_BAR;
#undef PG8_SA
#undef PG8_SB
#undef PG8_STAGE
#undef PG8_LDA
#undef PG8_LDB
#undef PG8_MMA
#undef PG8_WAIT_V
#undef PG8_WAIT_L
#undef PG8_BAR
#undef PG8_SCHED
}

struct SchedStd {
    const char* A; const char* Bt; int lda2, ldb2, nt; int nM, nN, nwg, G, c; char* O; int ldc, otile;
    int gx, grk;
    __device__ __forceinline__ bool next(int i, GUnit& u) const {
        if (G == 256) { const int uu = i * 32 + grk; if (uu >= 5 * nN) return false;
            const int pl = uu % 5; u.pm = pl < 4 ? 4 * gx + pl : 32 + gx; u.pn = uu / 5; u.ks = -1;
            u.a = A + (size_t)u.pm * 256 * lda2; u.b = Bt + (size_t)u.pn * 256 * ldb2; u.nt = nt; return true; }
        const long L = (long)i * G + c; if (L >= nwg) return false;
        int wgid = (int)L; { const int q = nwg / 8, r = nwg % 8, xcd = wgid % 8, off = wgid / 8; wgid = (xcd < r ? xcd * (q + 1) : r * (q + 1) + (xcd - r) * q) + off; }
        const int nig = 8 * nN, gid = wgid / nig, fm = gid * 8, gsz = (nM - fm) < 8 ? (nM - fm) : 8;
        u.pm = fm + ((wgid % nig) % gsz); u.pn = (wgid % nig) / gsz; u.ks = -1;
        u.a = A + (size_t)u.pm * 256 * lda2; u.b = Bt + (size_t)u.pn * 256 * ldb2; u.nt = nt;
        return true;
    }
    __device__ __forceinline__ void out(const GUnit& u, char*& o, int& ld) const { o = O + ((size_t)u.pm * 256 * ldc + (size_t)u.pn * otile) * 2; ld = ldc; }
};
struct SchedSplit {
    const char* A; const char* Bt; int lda2, ldb2, ntot, kq; int G, c; int gx, grk;
    __device__ __forceinline__ bool next(int i, GUnit& u) const {
        const int L = i * G + c; if (L >= 512) return false;
        const int Lr = L & 255; int x = Lr & 7, j = Lr >> 3, kt0 = 0;
        if (G == 256) { x = gx; j = grk; }
        if (L < 256) { u.pm = 4 * x + (j >> 3); u.pn = j & 7; u.ks = -1; u.nt = ntot; }
        else { u.pm = 32 + x; u.pn = j & 7; u.ks = j >> 3; kt0 = u.ks * kq; u.nt = (u.ks < 3) ? kq : ntot - 3 * kq; }
        u.a = A + (size_t)u.pm * 256 * lda2 + (size_t)kt0 * 128; u.b = Bt + (size_t)u.pn * 256 * ldb2 + (size_t)kt0 * 128;
        return true;
    }
};
struct SchedF1 {
    const char* T; const char* mixin; char* gtp; char* gts; int lda2, ldb2; int G, c;
    __device__ __forceinline__ bool next(int i, GUnit& u) const {
        const int L = i * G + c; if (L >= 320) return false;
        u.nt = 4; u.ks = L;
        if (L < 256) { const int bg = L >> 1, b = bg >> 2, g = bg & 3; u.pm = L & 1; u.pn = 0;
            u.b = mixin + ((size_t)(b * 256) * NIN_E + 2048 + g * 256) * 2; }
        else { const int l2 = L - 256, bg = l2 >> 3, b = bg >> 2, g = bg & 3; u.pm = (l2 >> 2) & 1; u.pn = l2 & 3;
            u.b = mixin + ((size_t)(MP + b * 1024 + u.pn * 256) * NIN_E + 2048 + g * 256) * 2; }
        u.a = T + (size_t)u.pm * 256 * 512;
        return true;
    }
    __device__ __forceinline__ void out(const GUnit& u, char*& o, int& ld) const { const int L = u.ks; ld = 2048;
        if (L < 256) o = gtp + ((size_t)(L >> 1) * 256 * 2048 + (size_t)u.pm * 256) * 2;
        else o = gts + ((size_t)((L - 256) >> 3) * 256 * 2048 + (size_t)u.pm * 1024 + u.pn * 256) * 2; }
};
struct SchedF2 {
    const char* cs256; const char* cs1024; const char* gtp; const char* gts; char* mixout; int lda2, ldb2; int G, c;
    __device__ __forceinline__ bool next(int i, GUnit& u) const {
        const int L = i * G + c; if (L >= 160) return false;
        u.ks = L; u.pn = 0;
        if (L < 32) { const int bg = L >> 2; u.pm = L & 3; u.nt = 32; u.a = cs1024 + (size_t)u.pm * 256 * 4096; u.b = gts + (size_t)bg * 256 * 2048 * 2; }
        else { const int bg = L - 32; u.pm = 0; u.nt = 8; u.a = cs256; u.b = gtp + (size_t)bg * 256 * 2048 * 2; }
        return true;
    }
    __device__ __forceinline__ void out(const GUnit& u, char*& o, int& ld) const { const int L = u.ks; ld = DM;
        if (L < 32) { const int bg = L >> 2, b = bg >> 2, g = bg & 3; o = mixout + ((size_t)(MP + b * 1024 + u.pm * 256) * DM + 1024 + g * 256) * 2; }
        else { const int bg = L - 32, b = bg >> 2, g = bg & 3; o = mixout + ((size_t)(b * 256) * DM + 1024 + g * 256) * 2; } }
};

struct EpiBf16 {
    static constexpr bool PERM = true;
    float scale;
    template <class Sched>
    __device__ __forceinline__ void operator()(const f32x4 (&acc)[2][2][4][2], const GUnit& u, const Sched& S, int wr, int wc, int fr, int fq) const {
        char* o; int ldc; S.out(u, o, ldc); bf16_t* T = (bf16_t*)o;
        const unsigned off0 = (unsigned)((wr * 64 + fr) * ldc + wc * 32 + 8 * fq);
#pragma unroll
        for (int ai = 0; ai < 2; ++ai)
#pragma unroll
            for (int m = 0; m < 4; ++m) { const unsigned off = off0 + (unsigned)((ai * HALF + m * 16) * ldc);
#pragma unroll
                for (int bj = 0; bj < 2; ++bj) { const f32x4 v0 = acc[ai][bj][m][0] * scale, v1 = acc[ai][bj][m][1] * scale;
                    u32x4 w; w.x = cvt_pk_bf16(v0[0], v0[1]); w.y = cvt_pk_bf16(v0[2], v0[3]); w.z = cvt_pk_bf16(v1[0], v1[1]); w.w = cvt_pk_bf16(v1[2], v1[3]);
                    *(u32x4*)(T + off + bj * HALF) = w; } }
    }
};
struct EpiF2 { static constexpr bool PERM = true;
    template <class Sched>
    __device__ __forceinline__ void operator()(const f32x4 (&acc)[2][2][4][2], const GUnit& u, const Sched& S, int wr, int wc, int fr, int fq) const {
        EpiBf16 e{u.nt == 32 ? 1.0f / 512.0f : 1.0f / 256.0f}; e(acc, u, S, wr, wc, fr, fq); } };
struct EpiGU {
    static constexpr bool PERM = true;
    template <class Sched>
    __device__ __forceinline__ void operator()(const f32x4 (&acc)[2][2][4][2], const GUnit& u, const Sched& S, int wr, int wc, int fr, int fq) const {
        char* o; int ldc; S.out(u, o, ldc); bf16_t* T = (bf16_t*)o;
        const unsigned off0 = (unsigned)((wr * 64 + fr) * ldc + wc * 32 + 8 * fq);
#pragma unroll
        for (int ai = 0; ai < 2; ++ai)
#pragma unroll
            for (int m = 0; m < 4; ++m) { const unsigned off = off0 + (unsigned)((ai * HALF + m * 16) * ldc); float t[8], r[8];
#pragma unroll
                for (int i = 0; i < 8; ++i) t[i] = acc[ai][0][m][i >> 2][i & 3] * -1.4426950408889634f;
#pragma unroll
                for (int i = 0; i < 8; ++i) t[i] = __builtin_amdgcn_exp2f(t[i]);
#pragma unroll
                for (int i = 0; i < 8; ++i) t[i] = t[i] + 1.0f;
#pragma unroll
                for (int i = 0; i < 8; ++i) t[i] = __builtin_amdgcn_rcpf(t[i]);
#pragma unroll
                for (int i = 0; i < 8; ++i) r[i] = (acc[ai][0][m][i >> 2][i & 3] * acc[ai][1][m][i >> 2][i & 3]) * t[i];
                asm volatile("" : "+v"(r[0]), "+v"(r[1]), "+v"(r[2]), "+v"(r[3]), "+v"(r[4]), "+v"(r[5]), "+v"(r[6]), "+v"(r[7]));
                u32x4 w; w.x = cvt_pk_bf16(r[0], r[1]); w.y = cvt_pk_bf16(r[2], r[3]); w.z = cvt_pk_bf16(r[4], r[5]); w.w = cvt_pk_bf16(r[6], r[7]);
                *(u32x4*)(T + off) = w; }
    }
};
struct EpiGU8 {
    static constexpr bool PERM = true;
    const float* rsc; const float* cmax;
    template <class Sched>
    __device__ __forceinline__ void operator()(const i32x4 (&acc)[2][2][4][2], const GUnit& u, const Sched& S, int wr, int wc, int fr, int fq) const {
        char* o; int ldc; S.out(u, o, ldc); bf16_t* T = (bf16_t*)o;
        const unsigned off0 = (unsigned)((wr * 64 + fr) * ldc + wc * 32 + 4 * fq);
        bf16x8 hf[2];
#pragma unroll
        for (int nt = 0; nt < 2; ++nt) { u32x4 hw;
#pragma unroll
            for (int p = 0; p < 4; ++p) { const unsigned s0 = __builtin_popcount((unsigned)((8 * fq + 2 * p) & (16 * nt + fr))) & 1u, s1 = __builtin_popcount((unsigned)((8 * fq + 2 * p + 1) & (16 * nt + fr))) & 1u;
                hw[p] = (s0 ? 0xbf80u : 0x3f80u) | ((s1 ? 0xbf80u : 0x3f80u) << 16); }
            hf[nt] = __builtin_bit_cast(bf16x8, hw); }
        const float* cp = cmax + u.pn * BM + wc * 32 + 8 * fq;
        f32x4 cs[2][2];
#pragma unroll
        for (int bj = 0; bj < 2; ++bj)
#pragma unroll
            for (int n = 0; n < 2; ++n) cs[bj][n] = *(const f32x4*)(cp + bj * HALF + 4 * n) * (1.0f / 127.0f);
        const float* rp = rsc + u.pm * BM + wr * 64 + fr;
#pragma unroll
        for (int ai = 0; ai < 2; ++ai)
#pragma unroll
            for (int m = 0; m < 4; ++m) { const unsigned off = off0 + (unsigned)((ai * HALF + m * 16) * ldc); float t[8], gg[8], r[8];
                const float rs = rp[ai * HALF + m * 16];
#pragma unroll
                for (int i = 0; i < 8; ++i) gg[i] = (float)acc[ai][0][m][i >> 2][i & 3] * (rs * cs[0][i >> 2][i & 3]);
#pragma unroll
                for (int i = 0; i < 8; ++i) t[i] = gg[i] * -1.4426950408889634f;
#pragma unroll
                for (int i = 0; i < 8; ++i) t[i] = __builtin_amdgcn_exp2f(t[i]);
#pragma unroll
                for (int i = 0; i < 8; ++i) t[i] = t[i] + 1.0f;
#pragma unroll
                for (int i = 0; i < 8; ++i) t[i] = __builtin_amdgcn_rcpf(t[i]);
#pragma unroll
                for (int i = 0; i < 8; ++i) r[i] = (gg[i] * ((float)acc[ai][1][m][i >> 2][i & 3] * (rs * cs[1][i >> 2][i & 3]))) * t[i];
                asm volatile("" : "+v"(r[0]), "+v"(r[1]), "+v"(r[2]), "+v"(r[3]), "+v"(r[4]), "+v"(r[5]), "+v"(r[6]), "+v"(r[7]));
                u32x4 w; w.x = cvt_pk_bf16_b(r[0], r[1]); w.y = cvt_pk_bf16_b(r[2], r[3]); w.z = cvt_pk_bf16_b(r[4], r[5]); w.w = cvt_pk_bf16_b(r[6], r[7]);
                const bf16x8 af = __builtin_bit_cast(bf16x8, w);
                float zf = 0.f; asm volatile("" : "+v"(zf));
                const f32x4 z4 = {zf, zf, zf, zf};
                const f32x4 h0 = __builtin_amdgcn_mfma_f32_16x16x32_bf16(hf[0], af, z4, 0, 0, 0), h1 = __builtin_amdgcn_mfma_f32_16x16x32_bf16(hf[1], af, z4, 0, 0, 0);
                u32x2 o0, o1; o0.x = cvt_pk_bf16_b(h0[0], h0[1]); o0.y = cvt_pk_bf16_b(h0[2], h0[3]); o1.x = cvt_pk_bf16_b(h1[0], h1[1]); o1.y = cvt_pk_bf16_b(h1[2], h1[3]);
                *(u32x2*)(T + off) = o0; *(u32x2*)(T + off + 16) = o1;
                __builtin_amdgcn_sched_barrier(0); }
    }
};
struct EpiResid8 {
    static constexpr bool PERM = false;
    float* x; const float* gate; float coef; float* slab; const float* rsc; const float* cmax;
    template <class Sched>
    __device__ __forceinline__ void operator()(const i32x4 (&acc)[2][2][4][2], const GUnit& u, const Sched& S, int wr, int wc, int fr, int fq) const {
        const unsigned off0 = (unsigned)((wr * 64 + fr) * DM + wc * 32 + 4 * fq);
        const float* cp = cmax + u.pn * BM + wc * 32 + 4 * fq;
        const float* rp = rsc + u.pm * BM + wr * 64 + fr;
        float rsv[8];
#pragma unroll
        for (int i = 0; i < 8; ++i) rsv[i] = rp[(i >> 2) * HALF + (i & 3) * 16];
        f32x4 gv[2][2];
        if (u.ks < 0) { const float* gt = gate + u.pn * BM + wc * 32 + 4 * fq;
#pragma unroll
            for (int bj = 0; bj < 2; ++bj)
#pragma unroll
                for (int n = 0; n < 2; ++n) gv[bj][n] = (*(const f32x4*)(gt + bj * HALF + n * 16) * coef) * (*(const f32x4*)(cp + bj * HALF + n * 16) * (1.0f / 127.0f));
        } else {
#pragma unroll
            for (int bj = 0; bj < 2; ++bj)
#pragma unroll
                for (int n = 0; n < 2; ++n) gv[bj][n] = *(const f32x4*)(cp + bj * HALF + n * 16) * (1.0f / 127.0f);
        }
        asm volatile("" : "+v"(rsv[0]), "+v"(rsv[1]), "+v"(rsv[2]), "+v"(rsv[3]), "+v"(rsv[4]), "+v"(rsv[5]), "+v"(rsv[6]), "+v"(rsv[7]));
        if (u.ks < 0) {
            float* T = x + (size_t)u.pm * BM * DM + u.pn * BM;
#pragma unroll
            for (int ai = 0; ai < 2; ++ai)
#pragma unroll
                for (int m = 0; m < 4; ++m) { const unsigned off = off0 + (unsigned)((ai * HALF + m * 16) * DM); const float rs = rsv[ai * 4 + m];
#pragma unroll
                    for (int bj = 0; bj < 2; ++bj)
#pragma unroll
                        for (int n = 0; n < 2; ++n) { f32x4* p = (f32x4*)(T + off + bj * HALF + n * 16); const i32x4 a = acc[ai][bj][m][n];
                            const f32x4 af = {(float)a[0], (float)a[1], (float)a[2], (float)a[3]}; *p = *p + (gv[bj][n] * rs) * af; }
                    if (m == 3) asm volatile("" ::: "memory"); }
        } else {
            bf16_t* T = (bf16_t*)slab + (size_t)u.ks * MS * DM + (size_t)(u.pm - 32) * BM * DM + u.pn * BM;
#pragma unroll
            for (int ai = 0; ai < 2; ++ai)
#pragma unroll
                for (int m = 0; m < 4; ++m) { const unsigned off = off0 + (unsigned)((ai * HALF + m * 16) * DM); const float rs = rsv[ai * 4 + m];
#pragma unroll
                    for (int bj = 0; bj < 2; ++bj)
#pragma unroll
                        for (int n = 0; n < 2; ++n) { const i32x4 a = acc[ai][bj][m][n]; const f32x4 v = (f32x4){(float)a[0], (float)a[1], (float)a[2], (float)a[3]} * (gv[bj][n] * rs);
                            u32x2 w; w.x = cvt_pk_bf16(v[0], v[1]); w.y = cvt_pk_bf16(v[2], v[3]); *(u32x2*)(T + off + bj * HALF + n * 16) = w; } }
        }
    }
};
struct EpiResid {
    static constexpr bool PERM = false;
    float* x; const float* gate; float coef; float* slab;
    template <class Sched>
    __device__ __forceinline__ void operator()(const f32x4 (&acc)[2][2][4][2], const GUnit& u, const Sched& S, int wr, int wc, int fr, int fq) const {
        const unsigned off0 = (unsigned)((wr * 64 + fr) * DM + wc * 32 + 4 * fq);
        if (u.ks < 0) {
            float* T = x + (size_t)u.pm * BM * DM + u.pn * BM; const float* gt = gate + u.pn * BM + wc * 32 + 4 * fq;
            f32x4 gv[2][2];
#pragma unroll
            for (int bj = 0; bj < 2; ++bj)
#pragma unroll
                for (int n = 0; n < 2; ++n) gv[bj][n] = *(const f32x4*)(gt + bj * HALF + n * 16) * coef;
#pragma unroll
            for (int ai = 0; ai < 2; ++ai)
#pragma unroll
                for (int m = 0; m < 4; ++m) { const unsigned off = off0 + (unsigned)((ai * HALF + m * 16) * DM);
#pragma unroll
                    for (int bj = 0; bj < 2; ++bj)
#pragma unroll
                        for (int n = 0; n < 2; ++n) { f32x4* p = (f32x4*)(T + off + bj * HALF + n * 16); *p = *p + gv[bj][n] * acc[ai][bj][m][n]; }
                    if (m == 3) asm volatile("" ::: "memory"); }
        } else {
            bf16_t* T = (bf16_t*)slab + (size_t)u.ks * MS * DM + (size_t)(u.pm - 32) * BM * DM + u.pn * BM;
#pragma unroll
            for (int ai = 0; ai < 2; ++ai)
#pragma unroll
                for (int m = 0; m < 4; ++m) { const unsigned off = off0 + (unsigned)((ai * HALF + m * 16) * DM);
#pragma unroll
                    for (int bj = 0; bj < 2; ++bj)
#pragma unroll
                        for (int n = 0; n < 2; ++n) { const f32x4 v = acc[ai][bj][m][n]; u32x2 w; w.x = cvt_pk_bf16(v[0], v[1]); w.y = cvt_pk_bf16(v[2], v[3]); *(u32x2*)(T + off + bj * HALF + n * 16) = w; } }
        }
    }
};
}

namespace att {
constexpr int D = 128, QBLK = 32, KVBLK = 64;
constexpr float SCALE = 0.088388347648318440f;
constexpr float THR = 8.f;
constexpr float NEG = -1e30f;
constexpr size_t SHM_V = KVBLK * D * 2, SHM_K = KVBLK * D * 2, SHM_ATTN = 2 * SHM_V + 2 * SHM_K + 8 * 64 * 4;
constexpr int RPB_OFF = (int)SHM_ATTN;
#define KSWZ(row, colB) ((row) * 256 + ((colB) ^ (((row) & 7) << 4)))
#define SBAR() __builtin_amdgcn_sched_barrier(0)
__device__ __forceinline__ int crow(int r, int hi) { return (r & 3) + 8 * (r >> 2) + 4 * hi; }

struct AUnit { const bf16_t* Q; bf16_t* O; const bf16_t* Kc; const bf16_t* Vc; const bf16_t* Kl; const bf16_t* Vl; int nctx, nloc, nt, mode, q0, kt0; float m0, l0; const float* rpb; };

__device__ __forceinline__ void partialSM(f32x16& p0, f32x16& p1, float& m_reg, float& mn, float& alpha) {
  constexpr float C = SCALE * 1.4426950408889634f;
  float pmax = p0[0];
#pragma unroll
  for (int r = 1; r < 16; ++r) pmax = fmaxf(pmax, p0[r]);
#pragma unroll
  for (int r = 0; r < 16; ++r) pmax = fmaxf(pmax, p1[r]);
  { auto rr = __builtin_amdgcn_permlane32_swap(__float_as_uint(pmax), __float_as_uint(pmax), false, false);
    pmax = fmaxf(__uint_as_float(rr[0]), __uint_as_float(rr[1])); }
  if (__builtin_expect(__all(pmax - m_reg <= THR / SCALE), 1)) { mn = m_reg; alpha = 1.f; }
  else { mn = fmaxf(m_reg, pmax); alpha = __builtin_amdgcn_exp2f((m_reg - mn) * C); m_reg = mn; }
  float mnC = -mn * C;
#pragma unroll
  for (int r = 0; r < 16; ++r) p0[r] = fmaf(p0[r], C, mnC);
#pragma unroll
  for (int r = 0; r < 16; ++r) p1[r] = fmaf(p1[r], C, mnC);
#pragma unroll
  for (int r = 0; r < 16; ++r) p0[r] = __builtin_amdgcn_exp2f(p0[r]);
}
__device__ __forceinline__ void finishSM(f32x16& p0, f32x16& p1, float alpha, float& l_reg, bf16x8& pa0, bf16x8& pa1, bf16x8& pa2, bf16x8& pa3) {
#pragma unroll
  for (int r = 0; r < 16; ++r) p1[r] = __builtin_amdgcn_exp2f(p1[r]);
  float ps = 0;
#pragma unroll
  for (int r = 0; r < 16; ++r) ps += p0[r];
#pragma unroll
  for (int r = 0; r < 16; ++r) ps += p1[r];
  { auto rr = __builtin_amdgcn_permlane32_swap(__float_as_uint(ps), __float_as_uint(ps), false, false);
    ps = __uint_as_float(rr[0]) + __uint_as_float(rr[1]); }
  l_reg = l_reg * alpha + ps;
#define PK4(P, BASE, OUT) do { unsigned a0 = cvt_pk_bf16(P[BASE + 0], P[BASE + 1]), a1 = cvt_pk_bf16(P[BASE + 2], P[BASE + 3]);   \
    unsigned b0 = cvt_pk_bf16(P[BASE + 4], P[BASE + 5]), b1 = cvt_pk_bf16(P[BASE + 6], P[BASE + 7]);                              \
    auto r0 = __builtin_amdgcn_permlane32_swap(a0, b0, false, false); auto r1 = __builtin_amdgcn_permlane32_swap(a1, b1, false, false); \
    u32x4 w = {r0[0], r1[0], r0[1], r1[1]}; OUT = *reinterpret_cast<bf16x8*>(&w); } while (0)
  PK4(p0, 0, pa0); PK4(p0, 8, pa1); PK4(p1, 0, pa2); PK4(p1, 8, pa3);
#undef PK4
}
__device__ __forceinline__ void qkt(f32x16& p0, f32x16& p1, const bf16_t* Ks, const bf16x8* qr, int r32, int hi) {
  p0 = f32x16{}; p1 = f32x16{};
#pragma unroll
  for (int d0 = 0; d0 < 8; ++d0) { int cb = (d0 * 16 + hi * 8) * 2;
    bf16x8 b0 = *reinterpret_cast<const bf16x8*>((const char*)Ks + KSWZ(r32, cb));
    bf16x8 b1 = *reinterpret_cast<const bf16x8*>((const char*)Ks + KSWZ(32 + r32, cb));
    p0 = __builtin_amdgcn_mfma_f32_32x32x16_bf16(b0, qr[d0], p0, 0, 0, 0);
    p1 = __builtin_amdgcn_mfma_f32_32x32x16_bf16(b1, qr[d0], p1, 0, 0, 0); }
}
__device__ __forceinline__ int v_st(int k, int c) { const int kk = (k & ~0xC) | ((k & 4) << 1) | ((k & 8) >> 1); return ((kk >> 3) * 4 + (c >> 5)) * 512 + ((kk & 7) * 32 + (c & 31)) * 2; }
__device__ __forceinline__ int v_rd_base(int lane) { return ((lane & 3) << 3) | (((lane >> 2) & 3) << 6) | (((lane >> 4) & 1) << 5) | (((lane >> 5) & 1) << 8); }
constexpr int v_rd_off(int d0, int ks, int half) { return d0 * 512 + ks * 4096 + half * 2048; }
template <int OFF> __device__ __forceinline__ s16x4 tr_read(int vb) {
  s16x4 r; asm volatile("ds_read_b64_tr_b16 %0, %1 offset:%2" : "=&v"(r) : "v"(vb), "i"(OFF) : "memory"); return r;
}
template <int D0> __device__ __forceinline__ void pv_one(f32x16& od, int vb, bf16x8 pa0, bf16x8 pa1, bf16x8 pa2, bf16x8 pa3) {
  const s16x4 l0 = tr_read<v_rd_off(D0, 0, 0)>(vb), h0 = tr_read<v_rd_off(D0, 0, 1)>(vb), l1 = tr_read<v_rd_off(D0, 1, 0)>(vb), h1 = tr_read<v_rd_off(D0, 1, 1)>(vb);
  const s16x4 l2 = tr_read<v_rd_off(D0, 2, 0)>(vb), h2 = tr_read<v_rd_off(D0, 2, 1)>(vb), l3 = tr_read<v_rd_off(D0, 3, 0)>(vb), h3 = tr_read<v_rd_off(D0, 3, 1)>(vb);
  asm volatile("s_waitcnt lgkmcnt(0)" ::: "memory"); SBAR();
#define PK(L, H) (bf16x8){L[0], L[1], L[2], L[3], H[0], H[1], H[2], H[3]}
  od = __builtin_amdgcn_mfma_f32_32x32x16_bf16(pa0, PK(l0, h0), od, 0, 0, 0);
  od = __builtin_amdgcn_mfma_f32_32x32x16_bf16(pa1, PK(l1, h1), od, 0, 0, 0);
  od = __builtin_amdgcn_mfma_f32_32x32x16_bf16(pa2, PK(l2, h2), od, 0, 0, 0);
  od = __builtin_amdgcn_mfma_f32_32x32x16_bf16(pa3, PK(l3, h3), od, 0, 0, 0);
#undef PK
}
__device__ __forceinline__ void pv_d0(f32x16* o, int vb, bf16x8 pa0, bf16x8 pa1, bf16x8 pa2, bf16x8 pa3) {
  pv_one<0>(o[0], vb, pa0, pa1, pa2, pa3); pv_one<1>(o[1], vb, pa0, pa1, pa2, pa3); pv_one<2>(o[2], vb, pa0, pa1, pa2, pa3); pv_one<3>(o[3], vb, pa0, pa1, pa2, pa3);
}
__device__ __forceinline__ void mask_tile(f32x16& p0, f32x16& p1, const AUnit& U, int j, int qrel, int hi, const float* rpbT) {
  if (j < U.nctx) return;
  const int jl = j - U.nctx;
  if (jl >= U.nloc) {
#pragma unroll
    for (int r = 0; r < 16; ++r) { p0[r] = NEG; p1[r] = NEG; }
    return; }
  if (U.mode == 1) {
    const int dq = (U.kt0 + jl) * 64 - (U.q0 + qrel) + 128;
#pragma unroll
    for (int r = 0; r < 16; ++r) { const int d0 = dq + crow(r, hi); if ((unsigned)d0 > 256u) p0[r] = NEG; if ((unsigned)(d0 + 32) > 256u) p1[r] = NEG; }
  } else if (U.mode == 2) {
    const int qpos = U.q0 + qrel, qrow = qpos >> 6, qcol = qpos & 63, krow = U.kt0 + jl;
    int rs = qrow - 4; rs = rs < 0 ? 0 : (rs > 8 ? 8 : rs);
    int cs = qcol - 8; cs = cs < 0 ? 0 : (cs > 48 ? 48 : cs);
    const bool rowok = (krow >= rs) && (krow < rs + 8);
    const int ib = (krow - qrow + 7) * 31 - qcol + 15;
#pragma unroll
    for (int r = 0; r < 16; ++r) { const int kc0 = crow(r, hi), kc1 = kc0 + 32;
      const bool ok0 = rowok && ((unsigned)(kc0 - cs) < 16u), ok1 = rowok && ((unsigned)(kc1 - cs) < 16u);
      const float b0 = rpbT[ok0 ? ib + kc0 : 0], b1 = rpbT[ok1 ? ib + kc1 : 0];
      p0[r] = ok0 ? p0[r] + b0 : NEG; p1[r] = ok1 ? p1[r] + b1 : NEG; }
  }
}
__device__ __forceinline__ void attn_unit(const AUnit& U, char* lds, int wv) {
  const int tid = ptid(wv);
  const int wid = wv, lane = tid & 63, r32 = lane & 31, hi = lane >> 5;
  bf16_t* V_lds = (bf16_t*)lds; bf16_t* K_lds = (bf16_t*)(lds + 2 * SHM_V);
  float* ws = (float*)(lds + 2 * SHM_V + 2 * SHM_K) + wid * 64; float* li_l = ws; float* al_l = ws + 32;
  float* rpbT = (float*)(lds + RPB_OFF);
  if (U.mode == 2) { for (int i = tid; i < 15 * 31; i += NTHR) rpbT[i] = U.rpb[i] * (1.0f / SCALE); }
  float m_reg = U.m0, l_reg = U.l0; f32x16 o[4] = {}; bf16x8 qr[8];
  const bf16_t* Qw = U.Q + (long)(wid * QBLK + r32) * D + hi * 8;
#pragma unroll
  for (int d0 = 0; d0 < 8; ++d0) qr[d0] = *reinterpret_cast<const bf16x8*>(Qw + d0 * 16);
  const int sr = tid >> 4, sc = (tid & 15) * 8, vst0 = v_st(sr, sc), vst1 = v_st(32 + sr, sc);
  const int vb0 = (int)(uintptr_t)V_lds + v_rd_base(lane);
  const int qrel = wid * QBLK + r32;
  struct { bf16x8 vs0, vs1, ks0, ks1; } sr_[1];
#define KTP(j) ((j) < U.nctx ? U.Kc + (long)(j) * 8192 : U.Kl + (long)(((j) - U.nctx) < U.nloc ? ((j) - U.nctx) : (U.nloc - 1)) * 8192)
#define VTP(j) ((j) < U.nctx ? U.Vc + (long)(j) * 8192 : U.Vl + (long)(((j) - U.nctx) < U.nloc ? ((j) - U.nctx) : (U.nloc - 1)) * 8192)
#define SLOAD(i, j) do { const bf16_t* kp_ = KTP(j); const bf16_t* vp_ = VTP(j); \
    sr_[i].vs0 = *reinterpret_cast<const bf16x8*>(&vp_[(long)(sr) * D + sc]); sr_[i].vs1 = *reinterpret_cast<const bf16x8*>(&vp_[(long)(32 + sr) * D + sc]); \
    sr_[i].ks0 = *reinterpret_cast<const bf16x8*>(&kp_[(long)(sr) * D + sc]); sr_[i].ks1 = *reinterpret_cast<const bf16x8*>(&kp_[(long)(32 + sr) * D + sc]); } while (0)
#define SWRITE(b, i) do { *(bf16x8*)((char*)V_lds + (b) * SHM_V + vst0) = sr_[i].vs0;          \
    *(bf16x8*)((char*)V_lds + (b) * SHM_V + vst1) = sr_[i].vs1; int kc = sc * 2;               \
    *(bf16x8*)((char*)K_lds + (b) * SHM_K + KSWZ(sr, kc)) = sr_[i].ks0;                       \
    *(bf16x8*)((char*)K_lds + (b) * SHM_K + KSWZ(32 + sr, kc)) = sr_[i].ks1; } while (0)
#define SWAIT() asm volatile("s_waitcnt vmcnt(0)" ::: "memory")
#define RESC(a) do { if (__any((a) < 1.f)) { if (hi == 0) al_l[r32] = (a); asm volatile("s_waitcnt lgkmcnt(0)" ::: "memory"); \
    _Pragma("unroll") for (int d = 0; d < 4; ++d) _Pragma("unroll") for (int r = 0; r < 16; ++r) o[d][r] *= al_l[crow(r, hi)]; } } while (0)
  f32x16 pA0, pA1, pB0, pB1; float mnA, mnB, alA, alB; bf16x8 pa0, pa1, pa2, pa3; const int NT = U.nt;
  SLOAD(0, 0); asm volatile("s_waitcnt vmcnt(0)" ::: "memory"); SWRITE(0, 0); __syncthreads();
  qkt(pA0, pA1, K_lds, qr, r32, hi); partialSM(pA0, pA1, m_reg, mnA, alA);
  SLOAD(0, 1);
  SWAIT(); SWRITE(1, 0); __syncthreads();
  for (int j = 1; j + 1 < NT; j += 2) {
    SBAR(); qkt(pB0, pB1, (bf16_t*)((char*)K_lds + SHM_K), qr, r32, hi);
    finishSM(pA0, pA1, alA, l_reg, pa0, pa1, pa2, pa3); SBAR();
    SLOAD(0, j + 1); SBAR();
    pv_d0(o, vb0, pa0, pa1, pa2, pa3); mask_tile(pB0, pB1, U, j, qrel, hi, rpbT); partialSM(pB0, pB1, m_reg, mnB, alB);
    __syncthreads(); SWAIT(); SWRITE(0, 0);
    RESC(alB); __syncthreads();
    SBAR(); qkt(pA0, pA1, K_lds, qr, r32, hi);
    finishSM(pB0, pB1, alB, l_reg, pa0, pa1, pa2, pa3); SBAR();
    SLOAD(0, j + 2); SBAR();
    pv_d0(o, vb0 + (int)SHM_V, pa0, pa1, pa2, pa3); mask_tile(pA0, pA1, U, j + 1, qrel, hi, rpbT); partialSM(pA0, pA1, m_reg, mnA, alA);
    __syncthreads(); SWAIT(); SWRITE(1, 0);
    RESC(alA); __syncthreads();
  }
  SBAR(); qkt(pB0, pB1, (bf16_t*)((char*)K_lds + SHM_K), qr, r32, hi);
  finishSM(pA0, pA1, alA, l_reg, pa0, pa1, pa2, pa3); SBAR();
  pv_d0(o, vb0, pa0, pa1, pa2, pa3); mask_tile(pB0, pB1, U, NT - 1, qrel, hi, rpbT); partialSM(pB0, pB1, m_reg, mnB, alB);
  __syncthreads(); RESC(alB);
  finishSM(pB0, pB1, alB, l_reg, pa0, pa1, pa2, pa3); SBAR();
  pv_d0(o, vb0 + (int)SHM_V, pa0, pa1, pa2, pa3);
  if (hi == 0) li_l[r32] = l_reg; asm volatile("s_waitcnt lgkmcnt(0)" ::: "memory");
  float rli[16];
#pragma unroll
  for (int r = 0; r < 16; ++r) rli[r] = __builtin_amdgcn_rcpf(li_l[crow(r, hi)]);
  bf16_t* Ow = U.O + (long)(wid * QBLK) * DM;
#pragma unroll
  for (int r = 0; r < 16; ++r) { int orow = crow(r, hi);
#pragma unroll
    for (int d0 = 0; d0 < 4; ++d0) Ow[(long)orow * DM + d0 * 32 + r32] = (bf16_t)f2bf(o[d0][r] * rli[r]); }
  __syncthreads();
#undef KTP
#undef VTP
#undef SLOAD
#undef SWRITE
#undef SWAIT
#undef RESC
}
#undef KSWZ
#undef SBAR
}

struct Args { const float* in[29]; float* out; unsigned char* ws; };
enum { I_XP = 0, I_XS, I_C, I_CCK, I_CCV, I_CDK, I_CDV, I_CCTX, I_WADA, I_BADA, I_GF1, I_WGU1, I_WDN1, I_GMIX, I_WOUT, I_GF2, I_WGU2, I_WDN2, I_WINE, I_GSGU, I_WSGU, I_BSGU, I_WINO,
       I_GQC, I_GKC, I_GQD, I_GKD, I_SINK, I_RPB };

__device__ __forceinline__ void transpose_item(const float* W, int K, int N, bf16_t* WT, int k0, int n0, int drow0, LAS float* scr, int lane) {
    (void)scr;
    const int r8 = lane >> 3, c4 = (lane & 7) * 4;
    f32x4 dd[8]; const float* wp = W + (size_t)(k0 + 8 * r8) * N + n0 + c4;
#pragma unroll
    for (int ii = 0; ii < 8; ++ii) dd[ii] = __builtin_nontemporal_load((const f32x4*)(wp + (size_t)ii * N));
#pragma unroll
    for (int e = 0; e < 4; ++e) { u32x4 o; o.x = pk2(dd[0][e], dd[1][e]); o.y = pk2(dd[2][e], dd[3][e]); o.z = pk2(dd[4][e], dd[5][e]); o.w = pk2(dd[6][e], dd[7][e]);
        __builtin_nontemporal_store(o, (u32x4*)(WT + (size_t)(drow0 + c4 + e) * K + k0 + 8 * r8)); }
}
__device__ __forceinline__ void transpose_item_q8(const float* W, int K, int N, signed char* WT, int k0, int n0, int drow0, const float* cmax, LAS float* scr, int lane) {
#pragma unroll 8
    for (int i = 0; i < 32; ++i) { const int kk = 2 * i + (lane >> 5); scr[kk * 33 + (lane & 31)] = W[(size_t)(k0 + kk) * N + n0 + (lane & 31)]; }
    LDS_WAIT(); asm volatile("" ::: "memory");
    const int c = lane & 7;
#pragma unroll
    for (int j = 0; j < 4; ++j) { const int n = (lane >> 3) + 8 * j; const LAS float* s = scr + (8 * c) * 33 + n;
        const float inv = 127.0f / fmaxf(cmax[drow0 + n], 1e-30f); int q[8];
#pragma unroll
        for (int i = 0; i < 8; ++i) { int v = (int)__builtin_rintf(s[i * 33] * inv); v = v > 127 ? 127 : (v < -127 ? -127 : v); q[i] = v & 255; }
        u32x2 o; o.x = (unsigned)q[0] | ((unsigned)q[1] << 8) | ((unsigned)q[2] << 16) | ((unsigned)q[3] << 24); o.y = (unsigned)q[4] | ((unsigned)q[5] << 8) | ((unsigned)q[6] << 16) | ((unsigned)q[7] << 24);
        *(u32x2*)(WT + (size_t)(drow0 + n) * K + k0 + 8 * c) = o; }
    LDS_WAIT(); asm volatile("" ::: "memory");
}
__device__ __forceinline__ int gu_row(int n) { return n < DFF ? ((n >> 7) * 256 + (n & 127)) : (((n - DFF) >> 7) * 256 + 128 + ((n - DFF) & 127)); }

constexpr int CONV_PER_LAYER = 11008 * 2 + 5504 * 2 + 2048 + 4608;
__device__ __forceinline__ void convert_item(const Args& A, int l, int r, LAS float* scr, int lane) {
    bf16_t* wl = (bf16_t*)(ws_opaque(A.ws) + WS_W) + (size_t)l * W_LAYER;
    if (r < 22016) { const int f = r / 11008; r %= 11008; const int kb = r / 344, nb = r % 344;
        transpose_item_q8(A.in[f ? I_WGU2 : I_WGU1] + (size_t)l * DM * NGU, DM, NGU, (signed char*)(wl + (f ? W_GU2 : W_GU1)), kb * 64, nb * 32, gu_row(nb * 32),
                          (const float*)(ws_opaque(A.ws) + WS_CMAX) + (size_t)(l * 2 + f) * NGU, scr, lane); return; }
    r -= 22016;
    if (r < 11008) { const int f = r / 5504; r %= 5504; const int kb = r / 64, nb = r % 64;
        transpose_item(A.in[f ? I_WDN2 : I_WDN1] + (size_t)l * DFF * DM, DFF, DM, wl + (f ? W_DN2 : W_DN1), kb * 64, nb * 32, nb * 32, scr, lane); return; }
    r -= 11008;
    if (r < 2048) { const int kb = r / 64, nb = r % 64;
        transpose_item(A.in[I_WOUT] + (size_t)l * DM * DM, DM, DM, wl + W_OUT, kb * 64, nb * 32, nb * 32, scr, lane); return; }
    r -= 2048;
    if (l & 1) { const int kb = r / 144, nb = r % 144;
        transpose_item(A.in[I_WINO] + (size_t)(l >> 1) * DM * NIN_O, DM, NIN_O, wl + W_IN, kb * 64, nb * 32, nb * 32, scr, lane); }
    else if (r < 3072) { const int kb = r / 96, nb = r % 96;
        transpose_item(A.in[I_WINE] + (size_t)(l >> 1) * DM * NIN_E, DM, NIN_E, wl + W_IN, kb * 64, nb * 32, nb * 32, scr, lane); }
}
__device__ __forceinline__ void gu_q8_wg_item(const Args& A, LAS unsigned char* lds, int l, int f, int nb, int wv) {
    const int tid = ptid(wv), lane = tid & 63, r8 = lane >> 3, c4 = (lane & 7) * 4;
    const float* W = A.in[f ? I_WGU2 : I_WGU1] + (size_t)l * DM * NGU;
    LAS float* wmax = (LAS float*)(lds + 69632);
    LAS float* cm = wmax + 256;
    f32x4 d[32];
    { const float* w = W + (size_t)(wv * 256 + 8 * r8) * NGU + nb * 32 + c4;
#pragma unroll
      for (int i = 0; i < 32; ++i) d[i] = __builtin_nontemporal_load((const f32x4*)(w + (size_t)((i >> 3) * 64 + (i & 7)) * NGU)); }
    { f32x4 mx = {0.f, 0.f, 0.f, 0.f};
#pragma unroll
      for (int i = 0; i < 32; ++i) { mx[0] = fmaxf(mx[0], fabsf(d[i][0])); mx[1] = fmaxf(mx[1], fabsf(d[i][1])); mx[2] = fmaxf(mx[2], fabsf(d[i][2])); mx[3] = fmaxf(mx[3], fabsf(d[i][3])); }
#pragma unroll
      for (int q = 0; q < 4; ++q) { mx[q] = fmaxf(mx[q], sx<8>(mx[q])); mx[q] = fmaxf(mx[q], sx<16>(mx[q])); mx[q] = max32(mx[q]); }
      if (lane < 8) { wmax[wv * 32 + lane * 4 + 0] = mx[0]; wmax[wv * 32 + lane * 4 + 1] = mx[1]; wmax[wv * 32 + lane * 4 + 2] = mx[2]; wmax[wv * 32 + lane * 4 + 3] = mx[3]; } }
    __syncthreads();
    const int drow0 = gu_row(nb * 32);
    if (tid < 32) { float m = wmax[tid];
#pragma unroll
        for (int w8 = 1; w8 < 8; ++w8) m = fmaxf(m, wmax[w8 * 32 + tid]);
        cm[tid] = m; ((float*)(ws_opaque(A.ws) + WS_CMAX))[(size_t)(l * 2 + f) * NGU + drow0 + tid] = m; }
    __syncthreads();
    signed char* WT = (signed char*)((bf16_t*)(ws_opaque(A.ws) + WS_W) + (size_t)l * W_LAYER + (f ? W_GU2 : W_GU1));
    float inv[4];
#pragma unroll
    for (int e = 0; e < 4; ++e) inv[e] = 127.0f / fmaxf(cm[c4 + e], 1e-30f);
#pragma unroll
    for (int kb = 0; kb < 4; ++kb)
#pragma unroll
        for (int e = 0; e < 4; ++e) { int q[8];
#pragma unroll
            for (int i = 0; i < 8; ++i) { int v = (int)__builtin_rintf(d[kb * 8 + i][e] * inv[e]); v = v > 127 ? 127 : (v < -127 ? -127 : v); q[i] = v & 255; }
            u32x2 o; o.x = (unsigned)q[0] | ((unsigned)q[1] << 8) | ((unsigned)q[2] << 16) | ((unsigned)q[3] << 24); o.y = (unsigned)q[4] | ((unsigned)q[5] << 8) | ((unsigned)q[6] << 16) | ((unsigned)q[7] << 24);
            __builtin_nontemporal_store(o, (u32x2*)(WT + (size_t)(drow0 + c4 + e) * DM + wv * 256 + kb * 64 + 8 * r8)); }
    __syncthreads();
}
__device__ __forceinline__ void wht32_rows(float (&v)[8], int r8) {
#pragma unroll
    for (int st = 1; st < 8; st <<= 1)
#pragma unroll
        for (int i = 0; i < 8; ++i) if (!(i & st)) { const float a = v[i], b = v[i + st]; v[i] = a + b; v[i + st] = a - b; }
#pragma unroll
    for (int i = 0; i < 8; ++i) { const float p = sx<8>(v[i]); v[i] = (r8 & 1) ? (p - v[i]) : (v[i] + p); }
#pragma unroll
    for (int i = 0; i < 8; ++i) { const float p = sx<16>(v[i]); v[i] = (r8 & 2) ? (p - v[i]) : (v[i] + p); }
}
__device__ __forceinline__ void dn_q8_wg_item(const Args& A, LAS unsigned char* lds, int l, int f, int nb, int wv) {
    const int tid = ptid(wv), lane = tid & 63, r8 = lane >> 3, c4 = (lane & 7) * 4;
    const float* W = A.in[f ? I_WDN2 : I_WDN1] + (size_t)l * DFF * DM;
    LAS float* wmax = (LAS float*)(lds + 69632);
    LAS float* cm = wmax + 256;
    signed char* WT = (signed char*)((bf16_t*)(ws_opaque(A.ws) + WS_W) + (size_t)l * W_LAYER + (f ? W_DN2 : W_DN1));
    float mx[4] = {0.f, 0.f, 0.f, 0.f}, inv[4] = {0.f, 0.f, 0.f, 0.f};
    for (int pass = 0; pass < 2; ++pass) {
        for (int kb = wv; kb < 86; kb += 8) {
            const int k0 = kb * 64;
            f32x4 dd[8]; const float* wp = W + (size_t)(k0 + 8 * r8) * DM + nb * 32 + c4;
#pragma unroll
            for (int ii = 0; ii < 8; ++ii) dd[ii] = *(const f32x4*)(wp + (size_t)ii * DM);
#pragma unroll
            for (int e = 0; e < 4; ++e) { float v[8];
#pragma unroll
                for (int i = 0; i < 8; ++i) v[i] = dd[i][e];
                wht32_rows(v, r8);
                if (pass == 0) {
#pragma unroll
                    for (int i = 0; i < 8; ++i) mx[e] = fmaxf(mx[e], fabsf(v[i]));
                } else { int q[8];
#pragma unroll
                    for (int i = 0; i < 8; ++i) { int t = (int)__builtin_rintf(v[i] * inv[e]); t = t > 127 ? 127 : (t < -127 ? -127 : t); q[i] = t & 255; }
                    u32x2 o; o.x = (unsigned)q[0] | ((unsigned)q[1] << 8) | ((unsigned)q[2] << 16) | ((unsigned)q[3] << 24); o.y = (unsigned)q[4] | ((unsigned)q[5] << 8) | ((unsigned)q[6] << 16) | ((unsigned)q[7] << 24);
                    __builtin_nontemporal_store(o, (u32x2*)(WT + (size_t)(nb * 32 + c4 + e) * KD8 + k0 + 8 * r8)); } }
        }
        if (pass == 0) {
#pragma unroll
            for (int e = 0; e < 4; ++e) { mx[e] = fmaxf(mx[e], sx<8>(mx[e])); mx[e] = fmaxf(mx[e], sx<16>(mx[e])); mx[e] = max32(mx[e]); }
            if (lane < 8) {
#pragma unroll
                for (int e = 0; e < 4; ++e) wmax[wv * 32 + c4 + e] = mx[e]; }
            __syncthreads();
            if (tid < 32) { float m = wmax[tid];
#pragma unroll
                for (int w8 = 1; w8 < 8; ++w8) m = fmaxf(m, wmax[w8 * 32 + tid]);
                cm[tid] = m; ((float*)(ws_opaque(A.ws) + WS_CMAX2))[(size_t)(l * 2 + f) * DM + nb * 32 + tid] = m * (1.0f / 32.0f); }
            __syncthreads();
#pragma unroll
            for (int e = 0; e < 4; ++e) inv[e] = 127.0f / fmaxf(cm[c4 + e], 1e-30f);
        }
    }
    if (tid < 256) { u32x4 zv = {0u, 0u, 0u, 0u}; asm volatile("" : "+v"(zv)); *(u32x4*)(WT + (size_t)(nb * 32 + (tid >> 3)) * KD8 + DFF + (tid & 7) * 16) = zv; }
    __syncthreads();
}
constexpr int CONV_GU_ROUNDS = 688, CONV_DN_ROUNDS = 128, CONV_ROUNDS = CONV_GU_ROUNDS + CONV_DN_ROUNDS + (CONV_PER_LAYER - 33024) / 8;
__device__ __forceinline__ void conv_round(const Args& A, LAS unsigned char* lds, int l, int r, int wv) {
    if (r < CONV_GU_ROUNDS) { gu_q8_wg_item(A, lds, l, r / 344, r % 344, wv); return; }
    if (r < CONV_GU_ROUNDS + CONV_DN_ROUNDS) { const int rr = r - CONV_GU_ROUNDS; dn_q8_wg_item(A, lds, l, rr >> 6, rr & 63, wv); return; }
    const int lane = ptid(wv) & 63;
    convert_item(A, l, 33024 + 8 * (r - CONV_GU_ROUNDS - CONV_DN_ROUNDS) + wv, (LAS float*)(lds + wv * 8704), lane);
}
#define QH(l) (8192 + 64 * (l))
__device__ __forceinline__ bool fill_round(const Args& A, LAS unsigned char* lds, int l, int wv) {
    volatile LAS unsigned* MISC = (volatile LAS unsigned*)(lds + LDS_MISC);
    const int tid = ptid(wv);
    if (tid == 0) MISC[4] = __hip_atomic_fetch_add((unsigned*)(ws_opaque(A.ws) + WS_CTL) + QH(l), 1u, __ATOMIC_RELAXED, __HIP_MEMORY_SCOPE_AGENT);
    __syncthreads();
    const int base = (int)MISC[4];
    __syncthreads();
    if (base >= CONV_ROUNDS) return false;
    conv_round(A, lds, l, base, wv);
    return true;
}
__device__ __forceinline__ void fill_wait(const Args& A, LAS unsigned char* lds, int G, int wv, int nbar, int& ql) {
    volatile LAS unsigned* MISC = (volatile LAS unsigned*)(lds + LDS_MISC);
    while (ql < 4) {
        const int tid = ptid(wv);
        if (tid == 0) { unsigned* bar = (unsigned*)(ws_opaque(A.ws) + WS_CTL); unsigned sum = 0u;
#pragma unroll
            for (unsigned j = 0; j < 16; ++j) sum += xb_ld(&bar[XB_XSUB(j)]);
            MISC[5] = ((sum - (unsigned)nbar * (unsigned)G) * 2u >= (unsigned)G) ? 1u : 0u; }
        __syncthreads();
        const unsigned stop = MISC[5];
        __syncthreads();
        if (stop) break;
        if (!fill_round(A, lds, ql, wv)) ++ql;
    }
}

__device__ __forceinline__ void prologue_a(const Args& A, LAS unsigned char* lds, int G, int wv) {
    const int tid = ptid(wv), lane = tid & 63, wave = wv;
    unsigned char* ws = ws_opaque(A.ws);
    LAS float* sil = (LAS float*)(lds + 69632);
    for (int i = tid; i < 3 * DM; i += NTHR) { const int cv = i / DM, k = i % DM; const float v = cv == 0 ? A.in[I_CCTX][k] : A.in[I_C][(cv - 1) * DM + k]; sil[i] = v / (1.0f + __expf(-v)); }
    __syncthreads();
    const int gw = obid() * NWAVES + wave, NGW = G * NWAVES;
    for (int it = gw; it < 4 * 144 * 4; it += NGW) {
        const int l = it / 576, r = it % 576, cg = r >> 2, ks = r & 3;
        const float* w = A.in[I_WADA] + ((size_t)l * DM + ks * 512) * NMODV + cg * 128 + 2 * lane;
        f32x2 a0 = {0.f, 0.f}, a1 = {0.f, 0.f}, a2 = {0.f, 0.f};
        const LAS float* s0 = sil + ks * 512;
#pragma unroll 8
        for (int k = 0; k < 512; ++k) { const f32x2 wv = __builtin_nontemporal_load((const f32x2*)(w + (size_t)k * NMODV)); a0 += wv * s0[k]; a1 += wv * s0[DM + k]; a2 += wv * s0[2 * DM + k]; }
        float* P = (float*)(ws + WS_ADAP) + ((size_t)(l * 4 + ks) * 3) * NMODV + cg * 128 + 2 * lane;
        *(f32x2*)P = a0; *(f32x2*)(P + NMODV) = a1; *(f32x2*)(P + 2 * NMODV) = a2;
    }
    __syncthreads();
    for (int r = obid(); r < CONV_ROUNDS; r += G) conv_round(A, lds, 0, r, wv);
    const size_t gt = (size_t)obid() * NTHR + tid, GT = (size_t)G * NTHR;
    constexpr size_t N_CK = 524288 / 8, N_DK = 2097152 / 8, N_WS = 262144 / 8, N_T = 131072 / 8, N_CS = 2097152 / 8;
    constexpr size_t E0 = N_CK, E1 = E0 + N_CK, E2 = E1 + N_DK, E3 = E2 + N_DK, E4 = E3 + N_WS, E5 = E4 + N_T, E6 = E5 + N_T, E7 = E6 + N_CS;
    for (size_t i = gt; i < E7; i += GT) {
        if (i < E4) {
            const float* src; bf16_t* dst; size_t j;
            if (i < E0) { src = A.in[I_CCK]; dst = (bf16_t*)(ws + WS_CCK); j = i; }
            else if (i < E1) { src = A.in[I_CCV]; dst = (bf16_t*)(ws + WS_CCV); j = i - E0; }
            else if (i < E2) { src = A.in[I_CDK]; dst = (bf16_t*)(ws + WS_CDK); j = i - E1; }
            else if (i < E3) { src = A.in[I_CDV]; dst = (bf16_t*)(ws + WS_CDV); j = i - E2; }
            else { src = A.in[I_WSGU]; dst = (bf16_t*)(ws + WS_WSGU); j = i - E3; }
            const f32x4 x0 = *(const f32x4*)(src + j * 8), x1 = *(const f32x4*)(src + j * 8 + 4);
            u32x4 o; o.x = pk2(x0[0], x0[1]); o.y = pk2(x0[2], x0[3]); o.z = pk2(x1[0], x1[1]); o.w = pk2(x1[2], x1[3]);
            *(u32x4*)(dst + j * 8) = o;
        } else {
            float v[8]; bf16_t* dst; size_t j; size_t doff;
            if (i < E5) { j = i - E4; doff = j * 8; dst = (bf16_t*)(ws + WS_T256); const int m = (int)(j * 8) / 256, k0 = (int)(j * 8) % 256, cp = m & 255, h = m >> 8;
#pragma unroll
                for (int e = 0; e < 8; ++e) { const float ang = (float)(((cp * (k0 + e)) & 255) * 2) * (1.0f / 256.0f); v[e] = h ? sinpif(ang) : cospif(ang); } }
            else if (i < E6) { j = i - E5; dst = (bf16_t*)(ws + WS_CS256); const int sp = (int)(j * 8) / 512, kk0 = (int)(j * 8) % 512, h = kk0 / 256, s0 = kk0 % 256; doff = (size_t)sp * 2048 + kk0;
#pragma unroll
                for (int e = 0; e < 8; ++e) { const float ang = (float)(((sp * (s0 + e)) & 255) * 2) * (1.0f / 256.0f); v[e] = h ? -sinpif(ang) : cospif(ang); } }
            else { j = i - E6; doff = j * 8; dst = (bf16_t*)(ws + WS_CS1024); const int sp = (int)(j * 8) / 2048, kk0 = (int)(j * 8) % 2048, h = kk0 / 1024, s0 = kk0 % 1024;
#pragma unroll
                for (int e = 0; e < 8; ++e) { const float ang = (float)(((sp * (s0 + e)) & 1023) * 2) * (1.0f / 1024.0f); v[e] = h ? -sinpif(ang) : cospif(ang); } }
            u32x4 o; o.x = pk2(v[0], v[1]); o.y = pk2(v[2], v[3]); o.z = pk2(v[4], v[5]); o.w = pk2(v[6], v[7]);
            *(u32x4*)(dst + doff) = o;
        }
    }
    if (gt < 2048) { const int pos = (int)gt >> 5, f = (int)gt & 31; const float inv = powf(10000.0f, -(float)f / 32.0f), ang = (float)pos * inv;
        float* rt = (float*)(ws + WS_ROPE); rt[gt] = cosf(ang); rt[2048 + gt] = sinf(ang); }
}
__device__ __forceinline__ void prologue_b(const Args& A, LAS unsigned char* lds, int G, int wv) {
    const size_t gt = (size_t)obid() * NTHR + ptid(wv), GT = (size_t)G * NTHR;
    const float* P = (const float*)(ws_opaque(A.ws) + WS_ADAP); float* Mo = (float*)(ws_opaque(A.ws) + WS_MODS);
    for (size_t i = gt; i < (size_t)4 * 3 * NMODV; i += GT) { const int l = (int)(i / (3 * NMODV)), r = (int)(i % (3 * NMODV)), j = r % NMODV;
        float s = A.in[I_BADA][(size_t)l * NMODV + j];
#pragma unroll
        for (int ks = 0; ks < 4; ++ks) s += P[((size_t)(l * 4 + ks) * 3) * NMODV + r];
        Mo[i] = s; }
}

__device__ __forceinline__ void nm_phase(const Args& A, int G, bool first, bool do_slab, float coef, int layer_gate, int kgate, bool do_norm, const float* g, int layer, int kshift, int wv, bool q8, int gx, int grk) {
    const int tid = ptid(wv);
    const int lane = tid & 63, wave = wv;
    const int gw = obid() * NWAVES + wave, NGW = G * NWAVES;
    float* xd = A.out; bf16_t* H = (bf16_t*)(ws_opaque(A.ws) + WS_H);
    const float* mods = (const float*)(ws_opaque(A.ws) + WS_MODS); const float* slab = (const float*)(ws_opaque(A.ws) + WS_SLAB);
    const int r_lo = do_norm ? 0 : MP;
    for (int it = do_norm ? 0 : 4; it < 5; ++it) {
        const int r = (it < 4 ? 4 * gx + it : 32 + gx) * 256 + grk * 8 + wave;
        const int cv = r < MP ? 0 : 1 + ((r - MP) >> 10);
        const float* xr = first ? (r < MP ? A.in[I_XP] + (size_t)r * DM : A.in[I_XS] + (size_t)(r - MP) * DM) : xd + (size_t)r * DM;
        f32x4 v[8];
#pragma unroll
        for (int j = 0; j < 8; ++j) v[j] = *(const f32x4*)(xr + 4 * lane + 256 * j);
        const bool wr_x = first || (do_slab && r >= MP);
        if (do_slab && r >= MP) {
            const float* gt_ = mods + ((size_t)(layer_gate * 3 + cv)) * NMODV + kgate * DM;
            const bf16_t* sb = (const bf16_t*)slab + (size_t)(r - MP) * DM;
#pragma unroll
            for (int j = 0; j < 8; ++j) { const int c = 4 * lane + 256 * j;
                const u32x2 w0 = *(const u32x2*)(sb + c), w1 = *(const u32x2*)(sb + (size_t)MS * DM + c), w2 = *(const u32x2*)(sb + (size_t)2 * MS * DM + c), w3 = *(const u32x2*)(sb + (size_t)3 * MS * DM + c);
                const f32x4 s = {(bf_lo(w0.x) + bf_lo(w1.x)) + (bf_lo(w2.x) + bf_lo(w3.x)), (bf_hi(w0.x) + bf_hi(w1.x)) + (bf_hi(w2.x) + bf_hi(w3.x)),
                                 (bf_lo(w0.y) + bf_lo(w1.y)) + (bf_lo(w2.y) + bf_lo(w3.y)), (bf_hi(w0.y) + bf_hi(w1.y)) + (bf_hi(w2.y) + bf_hi(w3.y))};
                v[j] = v[j] + (*(const f32x4*)(gt_ + c) * coef) * s; }
        }
        if (wr_x) {
#pragma unroll
            for (int j = 0; j < 8; ++j) *(f32x4*)(xd + (size_t)r * DM + 4 * lane + 256 * j) = v[j];
        }
        if (do_norm) {
            float ss = 0.f;
#pragma unroll
            for (int j = 0; j < 8; ++j) ss += (v[j][0] * v[j][0] + v[j][1] * v[j][1]) + (v[j][2] * v[j][2] + v[j][3] * v[j][3]);
            ss = wave_sum(ss);
            const float rstd = 1.0f / sqrtf(ss * (1.0f / DM) + EPS);
            const float* sh = mods + ((size_t)(layer * 3 + cv)) * NMODV + kshift * DM; const float* scp = sh + DM;
            if (!q8) {
#pragma unroll
                for (int j = 0; j < 8; ++j) { const int c = 4 * lane + 256 * j;
                    const f32x4 gg = *(const f32x4*)(g + c), s1 = *(const f32x4*)(scp + c), s0 = *(const f32x4*)(sh + c);
                    const f32x4 y = ((v[j] * rstd) * gg) * (s1 + 1.0f) + s0;
                    u32x2 w; w.x = cvt_pk_bf16(y[0], y[1]); w.y = cvt_pk_bf16(y[2], y[3]);
                    *(u32x2*)(H + (size_t)r * DM + c) = w; }
            } else {
                float amax = 0.f;
#pragma unroll
                for (int j = 0; j < 8; ++j) { const int c = 4 * lane + 256 * j;
                    const f32x4 gg = *(const f32x4*)(g + c), s1 = *(const f32x4*)(scp + c), s0 = *(const f32x4*)(sh + c);
                    v[j] = ((v[j] * rstd) * gg) * (s1 + 1.0f) + s0;
                    amax = fmaxf(fmaxf(amax, fmaxf(fabsf(v[j][0]), fabsf(v[j][1]))), fmaxf(fabsf(v[j][2]), fabsf(v[j][3]))); }
                amax = wave_max(amax);
                amax = fmaxf(amax, 1e-30f);
                const float inv = 127.0f / amax;
                signed char* H8 = (signed char*)H;
#pragma unroll
                for (int j = 0; j < 8; ++j) { const int c = 4 * lane + 256 * j; unsigned w = 0u;
#pragma unroll
                    for (int e = 0; e < 4; ++e) { int q = (int)__builtin_rintf(v[j][e] * inv); q = q > 127 ? 127 : (q < -127 ? -127 : q); w |= (unsigned)(q & 255) << (8 * e); }
                    *(unsigned*)(H8 + (size_t)r * DM + c) = w; }
                if (lane == 0) ((float*)(ws_opaque(A.ws) + WS_RSC))[r] = amax * (1.0f / 127.0f);
            }
        }
    }
}

__device__ __forceinline__ void q8act_phase(const Args& A, int wv, int gx, int grk) {
    const int tid = ptid(wv), lane = tid & 63;
    const bf16_t* act = (const bf16_t*)(ws_opaque(A.ws) + WS_ACT); signed char* a8 = (signed char*)(ws_opaque(A.ws) + WS_ACT8); float* rs2 = (float*)(ws_opaque(A.ws) + WS_RSC2);
    for (int it = 0; it < 5; ++it) {
        const int r = (it < 4 ? 4 * gx + it : 32 + gx) * 256 + grk * 8 + wv;
        const bf16_t* row = act + (size_t)r * DFF;
        u32x4 v[11]; float amax = 0.f;
#pragma unroll
        for (int j = 0; j < 11; ++j) { const int idx = lane + 64 * j;
            v[j] = (idx < 688) ? __builtin_nontemporal_load((const u32x4*)(row + idx * 8)) : (u32x4){0u, 0u, 0u, 0u};
#pragma unroll
            for (int e = 0; e < 4; ++e) amax = fmaxf(amax, fmaxf(fabsf(bf_lo(v[j][e])), fabsf(bf_hi(v[j][e])))); }
        amax = wave_max(amax);
        amax = fmaxf(amax, 1e-30f);
        const float inv = 127.0f / amax;
        signed char* orow = a8 + (size_t)r * KD8;
#pragma unroll
        for (int j = 0; j < 11; ++j) { const int idx = lane + 64 * j; u32x2 o;
#pragma unroll
            for (int h = 0; h < 2; ++h) { unsigned w = 0u;
#pragma unroll
                for (int e = 0; e < 2; ++e) { const unsigned src = v[j][2 * h + e];
                    int q0 = (int)__builtin_rintf(bf_lo(src) * inv), q1 = (int)__builtin_rintf(bf_hi(src) * inv);
                    q0 = q0 > 127 ? 127 : (q0 < -127 ? -127 : q0); q1 = q1 > 127 ? 127 : (q1 < -127 ? -127 : q1);
                    w |= ((unsigned)(q0 & 255) | ((unsigned)(q1 & 255) << 8)) << (16 * e); }
                o[h] = w; }
            if (idx < 688) *(u32x2*)(orow + idx * 8) = o; }
        if (lane < 16) { u32x2 zv = {0u, 0u}; asm volatile("" : "+v"(zv)); *(u32x2*)(orow + DFF + lane * 8) = zv; }
        if (lane == 0) rs2[r] = amax * (1.0f / 127.0f);
    }
}

__device__ __forceinline__ void vstat_phase(const Args& A, int G, int wv) {
    const int tid = ptid(wv), lane = tid & 63;
    const bf16_t* mixin = (const bf16_t*)(ws_opaque(A.ws) + WS_MIXIN); float* rst = (float*)(ws_opaque(A.ws) + WS_SSQ);
    for (int r = obid() * NWAVES + wv; r < MTOT; r += G * NWAVES) {
        const bf16_t* p = mixin + (size_t)r * NIN_E + 1024 + lane * 8;
        const u32x4 a = *(const u32x4*)p, b = *(const u32x4*)(p + 512);
        float ss = 0.f;
#pragma unroll
        for (int e = 0; e < 4; ++e) { const float x0 = bf_lo(a[e]), x1 = bf_hi(a[e]), y0 = bf_lo(b[e]), y1 = bf_hi(b[e]); ss += (x0 * x0 + x1 * x1) + (y0 * y0 + y1 * y1); }
        ss = wave_sum(ss);
        if (lane == 0) rst[r] = 1.0f / sqrtf(ss * (1.0f / 1024.0f) + EPS);
    }
}

__device__ __forceinline__ void sgu_phase(const Args& A, LAS unsigned char* lds, int G, int e, int wv) {
    const int tid = ptid(wv);
    const int lane = tid & 63, wave = wv;
    const bf16_t* mixin = (const bf16_t*)(ws_opaque(A.ws) + WS_MIXIN); bf16_t* mixout = (bf16_t*)(ws_opaque(A.ws) + WS_MIXOUT);
    const float* ssq = (const float*)(ws_opaque(A.ws) + WS_SSQ);
    const bf16_t* wsg = (const bf16_t*)(ws_opaque(A.ws) + WS_WSGU) + (size_t)e * 8 * 128 * 128;
    LAS bf16_t* LT = (LAS bf16_t*)lds;
    LAS float* rs = (LAS float*)(lds + 128 * 136 * 2);
    volatile LAS unsigned* MISCq = (volatile LAS unsigned*)(lds + LDS_MISC);
    for (;;) {
        if (tid == 0) MISCq[6] = __hip_atomic_fetch_add((unsigned*)(ws_opaque(A.ws) + WS_CTL) + (8192 + 64 * (12 + e)), 1u, __ATOMIC_RELAXED, __HIP_MEMORY_SCOPE_AGENT);
        __syncthreads();
        const int u = (int)MISCq[6];
        if (u >= 80 * 8) break;
        const int ch = u >> 3, g = u & 7, t0 = ch * 128;
        __syncthreads();
        if (tid < 128) rs[tid] = ssq[t0 + tid];
        __syncthreads();
#pragma unroll
        for (int i = 0; i < 4; ++i) { const int idx = tid + NTHR * i, q = idx >> 4, cc = idx & 15;
            const u32x4 w = *(const u32x4*)(mixin + (size_t)(t0 + q) * NIN_E + 1024 + g * 128 + cc * 8);
            const float* gs = A.in[I_GSGU] + (size_t)e * 1024 + g * 128 + cc * 8; const float r = rs[q];
            const f32x4 g0 = *(const f32x4*)gs, g1 = *(const f32x4*)(gs + 4);
            float y[8] = {bf_lo(w.x) * r * g0[0], bf_hi(w.x) * r * g0[1], bf_lo(w.y) * r * g0[2], bf_hi(w.y) * r * g0[3], bf_lo(w.z) * r * g1[0], bf_hi(w.z) * r * g1[1], bf_lo(w.w) * r * g1[2], bf_hi(w.w) * r * g1[3]};
#pragma unroll
            for (int k = 0; k < 8; ++k) LT[(cc * 8 + k) * 136 + q] = (bf16_t)f2bf(y[k]); }
        __syncthreads();
        const int p = 16 * wave + (lane & 15), kq = lane >> 4;
        bf16x8 wf[4];
#pragma unroll
        for (int ks = 0; ks < 4; ++ks) wf[ks] = *(const bf16x8*)(wsg + ((size_t)g * 128 + p) * 128 + 32 * ks + 8 * kq);
        const float bias = A.in[I_BSGU][(size_t)e * 1024 + g * 128 + p];
#pragma unroll
        for (int nt = 0; nt < 8; ++nt) { f32x4 acc = {0.f, 0.f, 0.f, 0.f};
#pragma unroll
            for (int ks = 0; ks < 4; ++ks) { const bf16x8 vf = *(const LAS bf16x8*)(LT + (16 * nt + (lane & 15)) * 136 + 32 * ks + 8 * kq);
                acc = __builtin_amdgcn_mfma_f32_16x16x32_bf16(vf, wf[ks], acc, 0, 0, 0); }
            const int c = 16 * nt + 4 * kq;
            const u32x2 uu = *(const u32x2*)(mixin + (size_t)(t0 + p) * NIN_E + g * 128 + c);
            u32x2 o; o.x = cvt_pk_bf16(bf_lo(uu.x) * (acc[0] + bias), bf_hi(uu.x) * (acc[1] + bias)); o.y = cvt_pk_bf16(bf_lo(uu.y) * (acc[2] + bias), bf_hi(uu.y) * (acc[3] + bias));
            *(u32x2*)(mixout + (size_t)(t0 + p) * DM + g * 128 + c) = o; }
    }
    __syncthreads();
}

__device__ __forceinline__ void prep_phase(const Args& A, int G, int o, int wv, int gx, int grk) {
    const int tid = ptid(wv);
    const int lane = tid & 63, wave = wv, li = lane & 15, grp = lane >> 4;
    const int gw = obid() * NWAVES + wave, NGW = G * NWAVES;
    const bf16_t* mixin = (const bf16_t*)(ws_opaque(A.ws) + WS_MIXIN); bf16_t* qkv = (bf16_t*)(ws_opaque(A.ws) + WS_QKV);
    const float* rt = (const float*)(ws_opaque(A.ws) + WS_ROPE);
    for (int it = 0; it < 5; ++it) {
        const int r = (it < 4 ? 4 * gx + it : 32 + gx) * 256 + grk * 8 + wave;
        const bool smp = r >= MP; const int b = smp ? (r - MP) >> 10 : r >> 8, s = smp ? (r - MP) & 1023 : r & 255, S = smp ? 1024 : 256;
        const int prow = s >> 6, pcol = s & 63;
#pragma unroll
        for (int j = 0; j < 9; ++j) {
            const int slot = 4 * j + grp;
            const u32x4 w = __builtin_nontemporal_load((const u32x4*)(mixin + (size_t)r * NIN_O + slot * 128 + li * 8));
            float x[8] = {bf_lo(w.x), bf_hi(w.x), bf_lo(w.y), bf_hi(w.y), bf_lo(w.z), bf_hi(w.z), bf_lo(w.w), bf_hi(w.w)};
            int ty, hd, H;
            if (slot < 8) { ty = 0; hd = slot; H = 8; } else if (slot < 10) { ty = 1; hd = slot - 8; H = 2; } else if (slot < 12) { ty = 2; hd = slot - 10; H = 2; }
            else if (slot < 20) { ty = 3; hd = slot - 12; H = 8; } else if (slot < 28) { ty = 4; hd = slot - 20; H = 8; } else { ty = 5; hd = slot - 28; H = 8; }
            const bool isn = (ty != 2) && (ty != 5);
            float ss = 0.f;
#pragma unroll
            for (int k = 0; k < 8; ++k) ss += x[k] * x[k];
            ss += sx<1>(ss); ss += sx<2>(ss); ss += sx<4>(ss); ss += sx<8>(ss);
            const float rstd = 1.0f / sqrtf(ss * (1.0f / 128.0f) + EPS);
            const float* gp = A.in[ty == 0 ? I_GQC : ty == 1 ? I_GKC : ty == 3 ? I_GQD : I_GKD] + (size_t)o * 128 + li * 8;
            if (isn) {
                const f32x4 g0 = *(const f32x4*)gp, g1 = *(const f32x4*)(gp + 4);
#pragma unroll
                for (int k = 0; k < 4; ++k) { x[k] = x[k] * rstd * g0[k]; x[4 + k] = x[4 + k] * rstd * g1[k]; }
            }
            if (smp && j <= 2) {
                const int pos = (li < 8) ? prow : pcol; const float* ct = rt + pos * 32 + 8 * (li & 3); const float* st = ct + 2048;
                const bool lo = !(li & 4), dor = ty < 2;
#pragma unroll
                for (int k = 0; k < 8; ++k) { const float xp = sx<4>(x[k]); const float c = ct[k], sn = st[k];
                    const float rr = lo ? (x[k] * c - xp * sn) : (xp * sn + x[k] * c); x[k] = dor ? rr : x[k]; }
            }
            const size_t base = smp ? (ty == 0 ? Q_QCS : ty == 1 ? Q_KCS : ty == 2 ? Q_VCS : ty == 3 ? Q_QDS : ty == 4 ? Q_KDS : Q_VDS)
                                    : (ty == 0 ? Q_QCP : ty == 1 ? Q_KCP : ty == 2 ? Q_VCP : ty == 3 ? Q_QDP : ty == 4 ? Q_KDP : Q_VDP);
            u32x4 ov; ov.x = cvt_pk_bf16(x[0], x[1]); ov.y = cvt_pk_bf16(x[2], x[3]); ov.z = cvt_pk_bf16(x[4], x[5]); ov.w = cvt_pk_bf16(x[6], x[7]);
            *(u32x4*)(qkv + base + ((size_t)(b * H + hd) * S + s) * 128 + li * 8) = ov;
            if (!smp && (ty == 1 || ty == 2 || ty == 4 || ty == 5)) {
                float* sp = A.out + (ty == 1 ? O_SCK : ty == 2 ? O_SCV : ty == 4 ? O_SDK : O_SDV) + (((size_t)(b * 2 + o) * H + hd) * 256 + s) * 128 + li * 8;
                __builtin_nontemporal_store((f32x4){x[0], x[1], x[2], x[3]}, (f32x4*)sp); __builtin_nontemporal_store((f32x4){x[4], x[5], x[6], x[7]}, (f32x4*)(sp + 4));
            }
        }
    }
}

__device__ __forceinline__ void attn_phase(const Args& A, LAS unsigned char* lds, int G, int o, int wv) {
    const bf16_t* qkv = (const bf16_t*)(ws_opaque(A.ws) + WS_QKV); bf16_t* mixout = (bf16_t*)(ws_opaque(A.ws) + WS_MIXOUT);
    const int c = obid();
    for (int i = 0;; ++i) {
        int u;
        if (G == 256) { if (c < 128) { if (i > 0) break; u = c; } else { if (i >= 4) break; u = 128 + 4 * (c - 128) + i; } }
        else { u = c + i * G; if (u >= 640) break; }
        att::AUnit U;
        if (u < 64) {
            const int b = u >> 5, h = (u >> 2) & 7, qb = u & 3;
            U.q0 = qb * 256; U.kt0 = qb == 0 ? 0 : (qb == 1 ? 0 : (qb == 2 ? 4 : 8)); U.nloc = (qb == 0 || qb == 3) ? 8 : 11; U.nctx = 8; U.nt = 8 + ((U.nloc + 1) & ~1); U.mode = 2;
            U.Q = qkv + Q_QDS + ((size_t)(b * 8 + h) * 1024 + U.q0) * 128; U.O = mixout + (size_t)(MP + b * 1024 + U.q0) * DM + (8 + h) * 128;
            U.Kc = (const bf16_t*)(ws_opaque(A.ws) + WS_CDK) + ((size_t)((b * 2 + o) * 8 + h)) * 512 * 128; U.Vc = (const bf16_t*)(ws_opaque(A.ws) + WS_CDV) + ((size_t)((b * 2 + o) * 8 + h)) * 512 * 128;
            U.Kl = qkv + Q_KDS + ((size_t)(b * 8 + h) * 1024 + U.kt0 * 64) * 128; U.Vl = qkv + Q_VDS + ((size_t)(b * 8 + h) * 1024 + U.kt0 * 64) * 128;
            U.m0 = -1e30f; U.l0 = 0.f; U.rpb = A.in[I_RPB] + ((size_t)o * 8 + h) * 15 * 31;
        } else if (u < 128) {
            const int v = u - 64, b = v >> 5, h = (v >> 2) & 7, qb = v & 3, kvh = h >> 2;
            U.q0 = qb * 256; const int k_lo = qb == 0 ? 0 : 4 * qb - 2, k_hi = qb == 3 ? 15 : 4 * qb + 5;
            U.kt0 = k_lo; U.nloc = k_hi - k_lo + 1; U.nctx = 8; U.nt = 8 + U.nloc; U.mode = 1;
            U.Q = qkv + Q_QCS + ((size_t)(b * 8 + h) * 1024 + U.q0) * 128; U.O = mixout + (size_t)(MP + b * 1024 + U.q0) * DM + h * 128;
            U.Kc = (const bf16_t*)(ws_opaque(A.ws) + WS_CCK) + ((size_t)((b * 2 + o) * 2 + kvh)) * 512 * 128; U.Vc = (const bf16_t*)(ws_opaque(A.ws) + WS_CCV) + ((size_t)((b * 2 + o) * 2 + kvh)) * 512 * 128;
            U.Kl = qkv + Q_KCS + ((size_t)(b * 2 + kvh) * 1024 + U.kt0 * 64) * 128; U.Vl = qkv + Q_VCS + ((size_t)(b * 2 + kvh) * 1024 + U.kt0 * 64) * 128;
            U.m0 = A.in[I_SINK][o * 8 + h] * (1.0f / att::SCALE); U.l0 = 1.f; U.rpb = nullptr;
        } else {
            const int v = u - 128, b = v >> 4, hh = v & 15;
            U.q0 = 0; U.kt0 = 0; U.nloc = 0; U.nctx = 4; U.nt = 4; U.mode = 0; U.rpb = nullptr; U.Kl = nullptr; U.Vl = nullptr;
            U.O = mixout + (size_t)(b * 256) * DM + hh * 128;
            if (hh < 8) { const int kvh = hh >> 2;
                U.Q = qkv + Q_QCP + ((size_t)(b * 8 + hh) * 256) * 128; U.Kc = qkv + Q_KCP + ((size_t)(b * 2 + kvh) * 256) * 128; U.Vc = qkv + Q_VCP + ((size_t)(b * 2 + kvh) * 256) * 128;
                U.m0 = A.in[I_SINK][o * 8 + hh] * (1.0f / att::SCALE); U.l0 = 1.f; }
            else { const int h = hh - 8;
                U.Q = qkv + Q_QDP + ((size_t)(b * 8 + h) * 256) * 128; U.Kc = qkv + Q_KDP + ((size_t)(b * 8 + h) * 256) * 128; U.Vc = qkv + Q_VDP + ((size_t)(b * 8 + h) * 256) * 128;
                U.m0 = -1e30f; U.l0 = 0.f; }
        }
        att::attn_unit(U, (char*)lds, wv);
    }
}

#ifndef ONLY_PH
#define ONLY_PH (-1)
#endif
#define PH(n) (ONLY_PH < 0 || ONLY_PH == (n))
#ifndef DUPMASK
#define DUPMASK 0
#endif
#define DUPN(g) (((DUPMASK >> (g)) & 1) ? 2 : 1)
#define TSMULT 8
#define TS0() do { if (ts_on) ts_t0 = __builtin_amdgcn_s_memrealtime(); } while (0)
#define TSC0() do { if (((TSMASK >> 13) & 1) && ts_on) ts_c0 = (unsigned long long)__builtin_readcyclecounter(); } while (0)
#define TSC1() do { if (((TSMASK >> 13) & 1) && ts_on) { const unsigned long long d_ = (unsigned long long)__builtin_readcyclecounter() - ts_c0; TSACC[0] += (unsigned)(d_ / 20ull); } } while (0)
#define TS1(g) do { if (((TSMASK >> (g)) & 1) && ts_on) { const unsigned long long d_ = __builtin_amdgcn_s_memrealtime() - ts_t0; TSACC[0] += (unsigned)d_; } } while (0)
__global__ void __launch_bounds__(NTHR, 2) mega_fwd(Args args) {
    extern __shared__ __attribute__((aligned(16))) unsigned char lds_raw[];
    LAS unsigned char* lds = (LAS unsigned char*)lds_raw;
    const int G = gridDim.x, wv = __builtin_amdgcn_readfirstlane((int)(threadIdx.x >> 6));
    volatile LAS unsigned* MISC = (volatile LAS unsigned*)(lds + LDS_MISC);
    { const int t0 = ptid(wv); if (t0 < 16) MISC[t0] = 0u; }
    __syncthreads();
    unsigned char* ws = args.ws;
    const bool ts_on = (TSMASK != 0 || TSBAR != 0) && (blockIdx.x == 0) && (wv == 0); unsigned long long ts_t0 = 0, ts_c0 = 0; (void)ts_c0; volatile LAS unsigned* TSACC = MISC + 2; (void)ts_on; (void)ts_t0; (void)TSACC;
    XcdBarrier bar = xcd_barrier_post((unsigned*)(ws + WS_CTL), MISC + 8, ptid(wv));
    const float* mods = (const float*)(ws + WS_MODS);

    int ql = 1, nbar = 0; int lok = 0; int gx = 0, grk = 0;
#ifndef LOCAL_BAR
#define LOCAL_BAR 1
#endif
#define BARRIER2(g, loc) do { TS0(); \
    if (LOCAL_BAR && (loc) && lok) { local_barrier((unsigned*)(ws + WS_CTL), (unsigned*)(ws + WS_CTL) + 8192 + 64 * (20 + gx), 32u, wv); } \
    else { fill_wait(args, lds, G, wv, nbar, ql); for (int br_ = 0; br_ < DUPN(10); ++br_) { xcd_barrier(bar, wv); ++nbar; } } \
    TS1(10); if (((TSBAR >> (g)) & 1) && ts_on) { TSACC[0] += (unsigned)(__builtin_amdgcn_s_memrealtime() - ts_t0); } } while (0)
#define BARRIER(g) BARRIER2(g, false)
    for (int rep = 0; rep < DUPN(0); ++rep) { TS0(); if (PH(0)) prologue_a(args, lds, G, wv); TS1(0); BARRIER(0); }
    if (ptid(wv) == 0) { unsigned* barw = (unsigned*)(ws + WS_CTL); const unsigned myx = MISC[11]; unsigned npop = 0u, below = 0u; bool uni = (G == 256);
        for (unsigned j = 0; j < 16; ++j) { const unsigned cnt = xb_ld(&barw[XB_XCNT(j)]); if (cnt) { ++npop; if (j < myx) ++below; if (cnt != 32u) uni = false; } }
        uni = uni && (npop == 8u); MISC[12] = below; MISC[13] = uni ? 1u : 0u; }
    __syncthreads();
    lok = __builtin_amdgcn_readfirstlane((int)MISC[13]); asm volatile("" : "+s"(lok));
    gx = lok ? __builtin_amdgcn_readfirstlane((int)MISC[12]) : (int)(blockIdx.x & 7);
    grk = lok ? __builtin_amdgcn_readfirstlane((int)MISC[10]) : (int)(blockIdx.x >> 3);
    TS0(); if (PH(1)) prologue_b(args, lds, G, wv); TS1(11);
    BARRIER(11);

    for (int layer = 0; layer < 4; ++layer) {
        const bf16_t* wl = (const bf16_t*)(ws + WS_W) + (size_t)layer * W_LAYER;
        const bool odd = layer & 1; const int eo = layer >> 1;
        for (int rep = 0; rep < DUPN(5); ++rep) {
            TS0(); if (PH(2)) nm_phase(args, G, layer == 0 && rep == 0, layer > 0 && rep == 0, 0.5f, layer - 1, 8, true, args.in[I_GF1] + (size_t)layer * DM, layer, 0, wv, true, gx, grk); TS1(5);
            BARRIER2(5, true); }
        for (int rep = 0; rep < DUPN(1); ++rep) {
            TS0(); TSC0(); if (PH(3)) { pg8::SchedStd S{(const char*)(ws + WS_H), (const char*)(wl + W_GU1), DM, DM, DM / 128, MTOT / 256, NGU / 256, (MTOT / 256) * (NGU / 256), G, obid(), (char*)(ws + WS_ACT), DFF, 128, gx, grk};
              pg8::EpiGU8 E{(const float*)(ws + WS_RSC), (const float*)(ws + WS_CMAX) + (size_t)(layer * 2 + 0) * NGU}; pg8::gemm_phase<pg8::EpiGU8, pg8::SchedStd, G_ALIGN, G_SP2, true>(lds, S, E, wv); } TS1(1); TSC1();
            BARRIER2(1, true); }
        for (int rep = 0; rep < DUPN(2); ++rep) {
            TS0(); if (PH(4)) { q8act_phase(args, wv, gx, grk); BARRIER2(2, true);
              pg8::SchedSplit S{(const char*)(ws + WS_ACT8), (const char*)(wl + W_DN1), KD8, KD8, KD8 / 128, 12, G, obid(), gx, grk};
              pg8::EpiResid8 E{args.out, mods + ((size_t)layer * 3) * NMODV + 2 * DM, rep == 0 ? 0.5f : 0.0f, (float*)(ws + WS_SLAB), (const float*)(ws + WS_RSC2), (const float*)(ws + WS_CMAX2) + (size_t)(layer * 2 + 0) * DM};
              pg8::gemm_phase<pg8::EpiResid8, pg8::SchedSplit, G_ALIGN, G_SP2, true>(lds, S, E, wv); } TS1(2);
            BARRIER2(2, true); }
        for (int rep = 0; rep < DUPN(5); ++rep) {
            TS0(); if (PH(5)) nm_phase(args, G, false, rep == 0, 0.5f, layer, 2, true, args.in[I_GMIX] + (size_t)layer * DM, layer, 3, wv, false, gx, grk); TS1(5);
            BARRIER2(5, true); }
        for (int rep = 0; rep < DUPN(3); ++rep) {
            TS0(); if (PH(6)) { const int nin = odd ? NIN_O : NIN_E;
              pg8::SchedStd S{(const char*)(ws + WS_H), (const char*)(wl + W_IN), DM * 2, DM * 2, DM / 64, MTOT / 256, nin / 256, (MTOT / 256) * (nin / 256), G, obid(), (char*)(ws + WS_MIXIN), nin, 256, gx, grk};
              pg8::EpiBf16 E{1.0f};
              pg8::gemm_phase<pg8::EpiBf16, pg8::SchedStd, G_ALIGN, G_SP2>(lds, S, E, wv); } TS1(3);
            BARRIER2(3, odd); }
        if (!odd) {
            for (int rep = 0; rep < DUPN(6); ++rep) {
                TS0(); if (PH(7)) { pg8::SchedF1 S{(const char*)(ws + WS_T256), (const char*)(ws + WS_MIXIN), (char*)(ws + WS_GT), (char*)(ws + WS_GTS), 512, NIN_E * 2, G, obid()};
                  pg8::EpiBf16 E{1.0f};
                  pg8::gemm_phase<pg8::EpiBf16, pg8::SchedF1, G_ALIGN, G_SP2>(lds, S, E, wv); }
                vstat_phase(args, G, wv); TS1(6);
                BARRIER(6); }
            for (int rep = 0; rep < DUPN(7); ++rep) {
                TS0(); if (PH(9)) { pg8::SchedF2 S{(const char*)(ws + WS_CS256), (const char*)(ws + WS_CS1024), (const char*)(ws + WS_GT), (const char*)(ws + WS_GTS), (char*)(ws + WS_MIXOUT), 4096, 4096, G, obid()};
                  pg8::EpiF2 E2;
                  pg8::gemm_phase<pg8::EpiF2, pg8::SchedF2, G_ALIGN, G_SP2>(lds, S, E2, wv); }
                if (PH(8)) sgu_phase(args, lds, G, eo, wv); TS1(7);
                }
        } else {
            for (int rep = 0; rep < DUPN(8); ++rep) { TS0(); if (PH(10)) prep_phase(args, G, eo, wv, gx, grk); TS1(8); BARRIER(8); }
            for (int rep = 0; rep < DUPN(9); ++rep) { TS0(); if (PH(11)) attn_phase(args, lds, G, eo, wv); TS1(9); }
        }
        if (layer < 3) { while (fill_round(args, lds, layer + 1, wv)) {} if (ql <= layer + 1) ql = layer + 2; }
        BARRIER(9);
        for (int rep = 0; rep < DUPN(4); ++rep) {
            TS0(); if (PH(12)) { pg8::SchedSplit S{(const char*)(ws + WS_MIXOUT), (const char*)(wl + W_OUT), DM * 2, DM * 2, DM / 64, 8, G, obid(), gx, grk};
              pg8::EpiResid E{args.out, mods + ((size_t)layer * 3) * NMODV + 5 * DM, rep == 0 ? 1.0f : 0.0f, (float*)(ws + WS_SLAB)};
              pg8::gemm_phase<pg8::EpiResid, pg8::SchedSplit, G_ALIGN, G_SP2>(lds, S, E, wv); } TS1(4);
            BARRIER2(4, true); }
        for (int rep = 0; rep < DUPN(5); ++rep) {
            TS0(); if (PH(13)) nm_phase(args, G, false, rep == 0, 1.0f, layer, 5, true, args.in[I_GF2] + (size_t)layer * DM, layer, 6, wv, true, gx, grk); TS1(5);
            BARRIER2(5, true); }
        for (int rep = 0; rep < DUPN(1); ++rep) {
            TS0(); TSC0(); if (PH(14)) { pg8::SchedStd S{(const char*)(ws + WS_H), (const char*)(wl + W_GU2), DM, DM, DM / 128, MTOT / 256, NGU / 256, (MTOT / 256) * (NGU / 256), G, obid(), (char*)(ws + WS_ACT), DFF, 128, gx, grk};
              pg8::EpiGU8 E{(const float*)(ws + WS_RSC), (const float*)(ws + WS_CMAX) + (size_t)(layer * 2 + 1) * NGU}; pg8::gemm_phase<pg8::EpiGU8, pg8::SchedStd, G_ALIGN, G_SP2, true>(lds, S, E, wv); } TS1(1); TSC1();
            BARRIER2(1, true); }
        for (int rep = 0; rep < DUPN(2); ++rep) {
            TS0(); if (PH(15)) { q8act_phase(args, wv, gx, grk); BARRIER2(2, true);
              pg8::SchedSplit S{(const char*)(ws + WS_ACT8), (const char*)(wl + W_DN2), KD8, KD8, KD8 / 128, 12, G, obid(), gx, grk};
              pg8::EpiResid8 E{args.out, mods + ((size_t)layer * 3) * NMODV + 8 * DM, rep == 0 ? 0.5f : 0.0f, (float*)(ws + WS_SLAB), (const float*)(ws + WS_RSC2), (const float*)(ws + WS_CMAX2) + (size_t)(layer * 2 + 1) * DM};
              pg8::gemm_phase<pg8::EpiResid8, pg8::SchedSplit, G_ALIGN, G_SP2, true>(lds, S, E, wv); } TS1(2);
            BARRIER2(2, true); }
    }
    TS0(); if (PH(16)) nm_phase(args, G, false, true, 0.5f, 3, 8, false, nullptr, 0, 0, wv, false, gx, grk); TS1(11);
    if (ts_on) { const unsigned long long te_ = __builtin_amdgcn_s_memrealtime() + (unsigned long long)TSMULT * TSACC[0]; while (__builtin_amdgcn_s_memrealtime() < te_) __builtin_amdgcn_s_sleep(8); }
#undef BARRIER
}

extern "C" void kernel_launch(void* const* d_in, const int* in_sizes, int n_in, void* d_out, int out_size, void* d_ws, size_t ws_size, hipStream_t stream) {
    static int grid = 0;
    if (grid == 0) {
        if (n_in != 29 || (size_t)out_size != O_END || ws_size < WS_END) {
            fprintf(stderr, "kernel_launch: unexpected shapes: n_in %d out %d ws %zu (need %zu)\n", n_in, out_size, ws_size, (size_t)WS_END); grid = -1; return; }
        int dev = 0, cus = 0, per_cu = 0;
        if (hipGetDevice(&dev) != hipSuccess || hipDeviceGetAttribute(&cus, hipDeviceAttributeMultiprocessorCount, dev) != hipSuccess) { grid = -1; return; }
        if (hipFuncSetAttribute((const void*)mega_fwd, hipFuncAttributeMaxDynamicSharedMemorySize, LDS_BYTES) != hipSuccess) { fprintf(stderr, "kernel_launch: hipFuncSetAttribute failed\n"); grid = -1; return; }
        if (hipOccupancyMaxActiveBlocksPerMultiprocessor(&per_cu, (const void*)mega_fwd, NTHR, LDS_BYTES) != hipSuccess || per_cu < 1)
            fprintf(stderr, "kernel_launch: occupancy query reports %d\n", per_cu);
        (void)hipGetLastError();
        if (cus != 256) { fprintf(stderr, "kernel_launch: built for a 256-CU device (8 groups of 32 workgroups), found %d CUs; nothing launched\n", cus); grid = -1; return; }
        grid = cus;
    }
    if (grid < 0) return;
    if (hipMemsetAsync((char*)d_ws + WS_CTL, 0, CTL_ZERO_BYTES, stream) != hipSuccess) { fprintf(stderr, "kernel_launch: memset failed\n"); return; }
    Args a{};
    for (int i = 0; i < 29; ++i) a.in[i] = (const float*)d_in[i];
    a.out = (float*)d_out; a.ws = (unsigned char*)d_ws;
    hipLaunchKernelGGL(mega_fwd, dim3(grid), dim3(NTHR), LDS_BYTES, stream, a);
    const hipError_t le = hipPeekAtLastError();
    if (le != hipSuccess) fprintf(stderr, "kernel_launch: launch failed: %s\n", hipGetErrorName(le));
}
```

```cpp
#include <hip/hip_runtime.h>
#include <cstdio>
#include <cstdint>

#define LAS __attribute__((address_space(3)))
#define GAS __attribute__((address_space(1)))
typedef unsigned short bf16_t;
typedef short bf16x8 __attribute__((ext_vector_type(8)));
typedef short s16x4 __attribute__((ext_vector_type(4)));
typedef float f32x2 __attribute__((ext_vector_type(2)));
typedef float f32x4 __attribute__((ext_vector_type(4)));
typedef float f32x8 __attribute__((ext_vector_type(8)));
typedef float f32x16 __attribute__((ext_vector_type(16)));
typedef unsigned u32x2 __attribute__((ext_vector_type(2)));
typedef unsigned u32x4 __attribute__((ext_vector_type(4)));
typedef int i32x4 __attribute__((ext_vector_type(4)));

#ifndef TSMASK
#define TSMASK 0
#endif
#ifndef TSBAR
#define TSBAR 0
#endif
constexpr int DM = 2048, MP = 8192, MS = 2048, MTOT = 10240, DFF = 5504, NGU = 11008, NIN_E = 3072, NIN_O = 4608, NMODV = 18432;
constexpr float EPS = 1e-6f;
constexpr int NWAVES = 8, NTHR = 512;
#ifndef G_ALIGN
#define G_ALIGN true
#endif
#ifndef G_SP2
#define G_SP2 true
#endif

constexpr size_t MiB = 1u << 20;
constexpr size_t WS_CTL = 0, CTL_ZERO_BYTES = 1024 * 1024;
constexpr size_t WS_CMAX = 512 * 1024;
constexpr size_t WS_MODS = 1 * MiB;
constexpr size_t WS_ADAP = 2 * MiB;
constexpr size_t WS_SSQ_OLD = 6 * MiB;
constexpr size_t WS_RSC = 6 * MiB + 704 * 1024;
constexpr size_t WS_RSC2 = 6 * MiB + 768 * 1024;
constexpr size_t WS_CMAX2 = 6 * MiB + 832 * 1024;
constexpr size_t WS_T256 = 7 * MiB;
constexpr size_t WS_ROPE = WS_T256 + 262144;
constexpr size_t WS_WSGU = 8 * MiB;
constexpr size_t WS_CS1024 = 9 * MiB;
constexpr size_t WS_CS256 = 23 * MiB;
constexpr size_t WS_CCK = 13 * MiB;
constexpr size_t WS_CCV = 14 * MiB, WS_CDK = 15 * MiB, WS_CDV = 19 * MiB;
constexpr size_t WS_H = 24 * MiB;
constexpr size_t WS_ACT = 64 * MiB;
constexpr size_t WS_MIXIN = 172 * MiB;
constexpr size_t WS_MIXOUT = 262 * MiB;
constexpr size_t WS_SLAB = 302 * MiB;
constexpr size_t WS_GT = 366 * MiB;
constexpr size_t WS_GTS = WS_GT + 128 * MiB;
constexpr size_t WS_QKV = 366 * MiB;
constexpr size_t WS_W = 502 * MiB;
constexpr size_t W_GU1 = 0, W_DN1 = (size_t)NGU * DM, W_GU2 = W_DN1 + (size_t)DM * DFF, W_DN2 = W_GU2 + (size_t)NGU * DM, W_OUT = W_DN2 + (size_t)DM * DFF,
                 W_IN = W_OUT + (size_t)DM * DM, W_LAYER = W_IN + (size_t)NIN_O * DM;
constexpr size_t WS_ACT8 = WS_W + 4 * W_LAYER * 2;
constexpr int KD8 = 5632;
constexpr size_t WS_SSQ = WS_ACT8 + (size_t)MTOT * KD8;
constexpr size_t WS_END = WS_SSQ + (size_t)MTOT * 4;
constexpr size_t Q_QCP = 0, Q_KCP = Q_QCP + (size_t)MP * 1024, Q_VCP = Q_KCP + (size_t)MP * 256, Q_QDP = Q_VCP + (size_t)MP * 256, Q_KDP = Q_QDP + (size_t)MP * 1024,
                 Q_VDP = Q_KDP + (size_t)MP * 1024, Q_QCS = Q_VDP + (size_t)MP * 1024, Q_KCS = Q_QCS + (size_t)MS * 1024, Q_VCS = Q_KCS + (size_t)MS * 256,
                 Q_QDS = Q_VCS + (size_t)MS * 256, Q_KDS = Q_QDS + (size_t)MS * 1024, Q_VDS = Q_KDS + (size_t)MS * 1024, Q_END = Q_VDS + (size_t)MS * 1024;
static_assert(WS_QKV + Q_END * 2 <= WS_W, "qkv region");
constexpr size_t O_YP = 0, O_YS = (size_t)MP * DM, O_SCK = O_YS + (size_t)MS * DM, O_SCV = O_SCK + (size_t)32 * 2 * 2 * 256 * 128, O_SDK = O_SCV + (size_t)32 * 2 * 2 * 256 * 128,
                 O_SDV = O_SDK + (size_t)32 * 2 * 8 * 256 * 128, O_END = O_SDV + (size_t)32 * 2 * 8 * 256 * 128;

constexpr int LDS_BYTES = 147456;
constexpr int LDS_MISC = 135168;

#define LDS_WAIT() asm volatile("s_waitcnt lgkmcnt(0)" ::: "memory")
#define VM_WAIT() asm volatile("s_waitcnt vmcnt(0)" ::: "memory")
__device__ __forceinline__ unsigned f2bf(float f) { unsigned u = __builtin_bit_cast(unsigned, f); return (u + 0x7fffu + ((u >> 16) & 1u)) >> 16; }
__device__ __forceinline__ unsigned pk2(float lo, float hi) { return f2bf(lo) | (f2bf(hi) << 16); }
__device__ __forceinline__ unsigned cvt_pk_bf16(float lo, float hi) { unsigned r; asm volatile("v_cvt_pk_bf16_f32 %0, %1, %2" : "=v"(r) : "v"(lo), "v"(hi)); return r; }
typedef __bf16 bf16x2_t __attribute__((ext_vector_type(2)));
__device__ __forceinline__ unsigned cvt_pk_bf16_b(float lo, float hi) { f32x2 v = {lo, hi}; bf16x2_t b = __builtin_convertvector(v, bf16x2_t); return __builtin_bit_cast(unsigned, b); }
__device__ __forceinline__ float bf_lo(unsigned w) { return __uint_as_float(w << 16); }
__device__ __forceinline__ float bf_hi(unsigned w) { return __uint_as_float(w & 0xffff0000u); }
__device__ __forceinline__ int ptid(int wv) { unsigned z = 0u; asm volatile("" : "+v"(z)); int t = wv * 64 + (int)__builtin_amdgcn_mbcnt_hi(~0u, __builtin_amdgcn_mbcnt_lo(~0u, z)); asm volatile("" : "+v"(t)); return t; }
template <class T> __device__ __forceinline__ T* asg(T* p) { const unsigned long long v = (unsigned long long)p; return (T*)(__attribute__((address_space(1))) T*)v; }
__device__ __forceinline__ unsigned char* ws_opaque(unsigned char* p) { unsigned long long v = (unsigned long long)p; asm volatile("" : "+s"(v)); return (unsigned char*)(__attribute__((address_space(1))) unsigned char*)v; }
__device__ __forceinline__ int obid() { int b = (int)blockIdx.x; asm volatile("" : "+s"(b)); return b; }
template <int M> __device__ __forceinline__ float sx(float v) { return __int_as_float(__builtin_amdgcn_ds_swizzle(__float_as_int(v), (M << 10) | 0x1f)); }
__device__ __forceinline__ float sum32(float v) { auto rr = __builtin_amdgcn_permlane32_swap(__float_as_uint(v), __float_as_uint(v), false, false); return __uint_as_float(rr[0]) + __uint_as_float(rr[1]); }
__device__ __forceinline__ float max32(float v) { auto rr = __builtin_amdgcn_permlane32_swap(__float_as_uint(v), __float_as_uint(v), false, false); return fmaxf(__uint_as_float(rr[0]), __uint_as_float(rr[1])); }
__device__ __forceinline__ float wave_sum(float v) { v += sx<1>(v); v += sx<2>(v); v += sx<4>(v); v += sx<8>(v); v += sx<16>(v); return sum32(v); }
__device__ __forceinline__ float wave_max(float v) { v = fmaxf(v, sx<1>(v)); v = fmaxf(v, sx<2>(v)); v = fmaxf(v, sx<4>(v)); v = fmaxf(v, sx<8>(v)); v = fmaxf(v, sx<16>(v)); return max32(v); }

#define XB_TMO      128
#define XB_XCNT(j)  (256  + 64 * (j))
#define XB_XSUB(j)  (1280 + 64 * (j))
#define XB_XGEN(j)  (2304 + 64 * (j))
#define XB_TOP      3328
#define XB_TOPGEN   3392
#define XCD_BAR_WORDS 3456
#define XB_SPIN_CAP (1u << 18)
__device__ __forceinline__ unsigned xb_ld(unsigned* p)              { return __hip_atomic_load(p, __ATOMIC_RELAXED, __HIP_MEMORY_SCOPE_AGENT); }
__device__ __forceinline__ unsigned xb_add(unsigned* p, unsigned v) { return __hip_atomic_fetch_add(p, v, __ATOMIC_RELAXED, __HIP_MEMORY_SCOPE_AGENT); }
__device__ __forceinline__ unsigned xb_xcc_id() { return (unsigned)__builtin_amdgcn_s_getreg((3 << 11) | 20) & 0xFu; }
#define XB_SPIN(cond, bar) do { unsigned _sp = 0; while (cond) { __builtin_amdgcn_s_sleep(1); \
    if ((++_sp & 255u) == 0u) { if (xb_ld(&(bar)[XB_TMO])) break; if (_sp > XB_SPIN_CAP) { atomicAdd(&(bar)[XB_TMO], 1u); break; } } } } while (0)
struct XcdBarrier { unsigned* bar; unsigned x; volatile LAS unsigned* st; };
__device__ __forceinline__ XcdBarrier xcd_barrier_post(unsigned* bar, volatile LAS unsigned* st, int tid) {
    XcdBarrier b; b.bar = bar; b.x = 0; b.st = st;
    if (tid == 0) { const unsigned xcc = xb_xcc_id(); st[2] = xb_add(&bar[XB_XCNT(xcc)], 1u); st[3] = xcc; }
    return b;
}
__device__ __forceinline__ void xcd_barrier_complete(unsigned* bar, unsigned x, unsigned& nloc, unsigned& nx) {
    const unsigned G = gridDim.x * gridDim.y * gridDim.z;
    unsigned sum, cnt, mine, sp = 0u;
    for (;;) {
        sum = 0u; cnt = 0u; mine = 0u;
#pragma unroll
        for (unsigned j = 0; j < 16; ++j) { const unsigned c = xb_ld(&bar[XB_XCNT(j)]); sum += c; cnt += (c > 0u) ? 1u : 0u; mine = (j == x) ? c : mine; }
        if (sum == G) break;
        __builtin_amdgcn_s_sleep(1);
        if ((++sp & 255u) == 0u) { if (xb_ld(&bar[XB_TMO])) break; if (sp > XB_SPIN_CAP) { atomicAdd(&bar[XB_TMO], 1u); break; } }
    }
    nloc = mine > 0u ? mine : 1u; nx = cnt > 0u ? cnt : 1u;
}
__device__ __forceinline__ void xcd_barrier(const XcdBarrier& b, int wv) {
    asm volatile("s_waitcnt vmcnt(0)" ::: "memory");
    __syncthreads();
    if (ptid(wv) == 0) {
        unsigned* bar = b.bar; const unsigned bx = xb_xcc_id();
        __builtin_amdgcn_s_waitcnt(0);
        unsigned nloc = b.st[0], nx = b.st[1];
        if (nloc == 0u) { xcd_barrier_complete(bar, bx, nloc, nx); b.st[0] = nloc; b.st[1] = nx; }
        const unsigned old = xb_add(&bar[XB_XSUB(bx)], 1u);
        const unsigned gen = old / nloc;
        if (old + 1u == (gen + 1u) * nloc) {
            __builtin_amdgcn_fence(__ATOMIC_RELEASE, "agent");
            asm volatile("s_waitcnt vmcnt(0)" ::: "memory");
            const unsigned og = xb_add(&bar[XB_TOP], 1u);
            const unsigned tg = og / nx;
            if (og + 1u == (tg + 1u) * nx) xb_add(&bar[XB_TOPGEN], 1u);
            else XB_SPIN(xb_ld(&bar[XB_TOPGEN]) == tg, bar);
            __builtin_amdgcn_fence(__ATOMIC_ACQUIRE, "agent");
            xb_add(&bar[XB_XGEN(bx)], 1u);
            asm volatile("s_waitcnt vmcnt(0)" ::: "memory");
        } else {
            XB_SPIN(xb_ld(&bar[XB_XGEN(bx)]) == gen, bar);
            __builtin_amdgcn_fence(__ATOMIC_ACQUIRE, "agent");
            asm volatile("s_waitcnt vmcnt(0)" ::: "memory");
        }
    }
    __syncthreads();
}

__device__ __forceinline__ void local_barrier(unsigned* bar, unsigned* lb, unsigned gsize, int wv) {
    asm volatile("s_waitcnt vmcnt(0)" ::: "memory");
    __syncthreads();
    if (ptid(wv) == 0) {
        __builtin_amdgcn_s_waitcnt(0);
        const unsigned old = xb_add(lb, 1u), target = (old / gsize + 1u) * gsize;
        XB_SPIN(xb_ld(lb) < target, bar);
        __builtin_amdgcn_fence(__ATOMIC_ACQUIRE, "agent");
        asm volatile("s_waitcnt vmcnt(0)" ::: "memory");
    }
    __syncthreads();
}

namespace pg8 {
constexpr int BM = 256, BK = 64, HALF = 128, HTB = HALF * BK * 2, STAGE_BYTES = 8 * HTB;
__device__ __forceinline__ int lds_byte(int r, int c) { const int st = (r >> 4) * 2 + (c >> 5), rr = r & 15, cc = c & 31, ob = rr * 64 + cc * 2; return st * 1024 + (ob ^ (((ob >> 9) & 1) << 5)); }
__device__ __forceinline__ void stage_rc(int b, int& R, int& C) { const int st = b / 1024, sb = b % 1024, swz = sb ^ (((sb >> 9) & 1) << 5); R = (st >> 1) * 16 + swz / 64; C = (st & 1) * 32 + (swz % 64) / 2; }
__device__ __forceinline__ int perm32(int rho) { const int n = rho >> 4, i = rho & 15; return 8 * (i >> 2) + 4 * n + (i & 3); }

struct GUnit { const char* a; const char* b; int nt; int pm, pn, ks; };

template <bool I8> struct AccT { typedef f32x4 T; };
template <> struct AccT<true> { typedef i32x4 T; };
template <class Epi, class Sched, bool ALIGN_EPI, bool SP2, bool I8 = false>
__device__ __forceinline__ void gemm_phase(LAS unsigned char* lds, const Sched& S, const Epi& E, int wv) {
    const int tid = ptid(wv);
    const int wid = wv, lane = tid & 63, wr = wid >> 2, wc = wid & 3, fr = lane & 15, fq = lane >> 4;
    unsigned cvA0, cvA1, cvB0, cvB1;
    { int R0, C0, R1, C1; stage_rc(tid * 16, R0, C0); stage_rc(tid * 16 + 8192, R1, C1);
      const int Rb0 = Epi::PERM ? ((R0 & ~31) + perm32(R0 & 31)) : R0, Rb1 = Epi::PERM ? ((R1 & ~31) + perm32(R1 & 31)) : R1;
      cvA0 = (unsigned)(R0 * S.lda2 + C0 * 2); cvA1 = (unsigned)(R1 * S.lda2 + C1 * 2); cvB0 = (unsigned)(Rb0 * S.ldb2 + C0 * 2); cvB1 = (unsigned)(Rb1 * S.ldb2 + C1 * 2); }
    const unsigned ldsw = (unsigned)wid * 1024u;
    const int aoff = lds_byte(wr * 64 + fr, fq * 8), boff = lds_byte(wc * 32 + fr, fq * 8);
#define PG8_SA(b, h) (((b) * 2 + (h)) * HTB)
#define PG8_SB(b, h) ((4 + (b) * 2 + (h)) * HTB)
#define PG8_STAGE(bufoff, gbase, v0, v1) do { \
        __builtin_amdgcn_global_load_lds((const unsigned*)((const char*)(gbase) + (v0)), (LAS unsigned*)(lds + (bufoff) + ldsw), 16, 0, 0); \
        __builtin_amdgcn_global_load_lds((const unsigned*)((const char*)(gbase) + (v1)), (LAS unsigned*)(lds + (bufoff) + ldsw + 8192), 16, 0, 0); } while (0)
#define PG8_LDA(dst, b, h) do { _Pragma("unroll") for (int m = 0; m < 4; ++m) _Pragma("unroll") for (int k = 0; k < 2; ++k) dst[m][k] = *(const LAS bf16x8*)(lds + PG8_SA(b, h) + aoff + m * 2048 + k * 1024); } while (0)
#define PG8_LDB(dst, b, h) do { _Pragma("unroll") for (int n = 0; n < 2; ++n) _Pragma("unroll") for (int k = 0; k < 2; ++k) dst[n][k] = *(const LAS bf16x8*)(lds + PG8_SB(b, h) + boff + n * 2048 + k * 1024); } while (0)
#define PG8_MMA(ai, bj, At, Bt) do { __builtin_amdgcn_s_setprio(1); _Pragma("unroll") for (int m = 0; m < 4; ++m) _Pragma("unroll") for (int n = 0; n < 2; ++n) _Pragma("unroll") for (int k = 0; k < 2; ++k) { \
        if constexpr (I8) acc[ai][bj][m][n] = __builtin_amdgcn_mfma_i32_16x16x64_i8(__builtin_bit_cast(i32x4, Bt[n][k]), __builtin_bit_cast(i32x4, At[m][k]), acc[ai][bj][m][n], 0, 0, 0); \
        else acc[ai][bj][m][n] = __builtin_amdgcn_mfma_f32_16x16x32_bf16(Bt[n][k], At[m][k], acc[ai][bj][m][n], 0, 0, 0); } __builtin_amdgcn_s_setprio(0); } while (0)
#define PG8_WAIT_V(n) asm volatile("s_waitcnt vmcnt(" #n ")" ::: "memory")
#define PG8_WAIT_L(n) asm volatile("s_waitcnt lgkmcnt(" #n ")" ::: "memory")
#define PG8_BAR __builtin_amdgcn_s_barrier()
#define PG8_SCHED __builtin_amdgcn_sched_barrier(0)
    GUnit cur, nxt; int ui = 0;
    if (!S.next(0, cur)) return;
    typedef typename AccT<I8>::T acc_t;
    acc_t acc[2][2][4][2];
    acc_t zz = (acc_t){0, 0, 0, 0}; asm volatile("" : "+v"(zz));
#pragma unroll
    for (int a = 0; a < 2; ++a)
#pragma unroll
        for (int b = 0; b < 2; ++b)
#pragma unroll
            for (int m = 0; m < 4; ++m)
#pragma unroll
                for (int n = 0; n < 2; ++n) acc[a][b][m][n] = zz;
    bf16x8 At[4][2], B0[2][2], B1[2][2];
    const size_t chA = (size_t)HALF * S.lda2, chB = (size_t)HALF * S.ldb2;
    const size_t kstep = (size_t)(BK * 2);
    const char* cA = cur.a; const char* cB = cur.b;
    if constexpr (SP2) {
        PG8_STAGE(PG8_SB(0, 0), cB, cvB0, cvB1); PG8_STAGE(PG8_SB(0, 1), cB + chB, cvB0, cvB1); PG8_STAGE(PG8_SA(0, 0), cA, cvA0, cvA1); PG8_STAGE(PG8_SA(0, 1), cA + chA, cvA0, cvA1);
        if (wr == 1) PG8_BAR;
        PG8_WAIT_V(2); PG8_BAR;
        PG8_STAGE(PG8_SB(1, 0), cB + kstep, cvB0, cvB1); PG8_STAGE(PG8_SA(1, 0), cA + kstep, cvA0, cvA1); PG8_STAGE(PG8_SB(1, 1), cB + chB + kstep, cvB0, cvB1);
        PG8_WAIT_V(6); PG8_BAR;
    } else {
        PG8_STAGE(PG8_SB(0, 0), cB, cvB0, cvB1); PG8_STAGE(PG8_SA(0, 0), cA, cvA0, cvA1); PG8_STAGE(PG8_SB(0, 1), cB + chB, cvB0, cvB1); PG8_STAGE(PG8_SA(0, 1), cA + chA, cvA0, cvA1);
        if (wr == 1) PG8_BAR;
        PG8_WAIT_V(4); PG8_BAR;
        PG8_STAGE(PG8_SB(1, 0), cB + kstep, cvB0, cvB1); PG8_STAGE(PG8_SA(1, 0), cA + kstep, cvA0, cvA1); PG8_STAGE(PG8_SB(1, 1), cB + chB + kstep, cvB0, cvB1);
        PG8_WAIT_V(6); PG8_BAR;
    }
    for (;;) {
        const bool has_next = S.next(ui + 1, nxt);
        const char* nA = has_next ? nxt.a : cA; const char* nB = has_next ? nxt.b : cB;
        int nt = cur.nt; asm volatile("" : "+s"(nt));
        for (int t = 0; t < nt; t += 2) {
            const bool last = (t == nt - 2);
            const char* a1 = cA + (size_t)(t + 1) * kstep;
            const char* a2 = last ? nA : cA + (size_t)(t + 2) * kstep; const char* b2 = last ? nB : cB + (size_t)(t + 2) * kstep;
            const char* a3 = a2 + kstep; const char* b3 = b2 + kstep;
            if constexpr (SP2) {
            PG8_LDB(B0, 0, 0); PG8_LDB(B1, 0, 1); PG8_SCHED; PG8_LDA(At, 0, 0); PG8_STAGE(PG8_SA(1, 1), a1 + chA, cvA0, cvA1);
            PG8_WAIT_V(8); PG8_WAIT_L(0); PG8_BAR; PG8_MMA(0, 0, At, B0); PG8_MMA(0, 1, At, B1); PG8_BAR; PG8_SCHED;
            PG8_LDA(At, 0, 1); PG8_STAGE(PG8_SB(0, 0), b2, cvB0, cvB1); PG8_STAGE(PG8_SB(0, 1), b2 + chB, cvB0, cvB1); PG8_STAGE(PG8_SA(0, 0), a2, cvA0, cvA1);
            PG8_WAIT_V(8); PG8_WAIT_L(0); PG8_BAR; PG8_MMA(1, 0, At, B0); PG8_MMA(1, 1, At, B1); PG8_BAR; PG8_SCHED;
            PG8_LDB(B0, 1, 0); PG8_LDB(B1, 1, 1); PG8_SCHED; PG8_LDA(At, 1, 0); PG8_STAGE(PG8_SA(0, 1), a2 + chA, cvA0, cvA1);
            PG8_WAIT_V(8); PG8_WAIT_L(0); PG8_BAR; PG8_MMA(0, 0, At, B0); PG8_MMA(0, 1, At, B1); PG8_BAR; PG8_SCHED;
            PG8_LDA(At, 1, 1); PG8_STAGE(PG8_SB(1, 0), b3, cvB0, cvB1); PG8_STAGE(PG8_SB(1, 1), b3 + chB, cvB0, cvB1); PG8_STAGE(PG8_SA(1, 0), a3, cvA0, cvA1);
            PG8_WAIT_V(8); PG8_WAIT_L(0); PG8_BAR; PG8_MMA(1, 0, At, B0); PG8_MMA(1, 1, At, B1); PG8_BAR; PG8_SCHED;
            } else {
            PG8_LDB(B0, 0, 0); PG8_SCHED; PG8_LDA(At, 0, 0); PG8_STAGE(PG8_SA(1, 1), a1 + chA, cvA0, cvA1);
            PG8_WAIT_L(8); PG8_BAR; PG8_WAIT_L(0); PG8_MMA(0, 0, At, B0); PG8_BAR; PG8_SCHED;
            PG8_LDB(B1, 0, 1); PG8_STAGE(PG8_SB(0, 0), b2, cvB0, cvB1);
            PG8_BAR; PG8_WAIT_L(0); PG8_MMA(0, 1, At, B1); PG8_BAR;
            PG8_LDA(At, 0, 1); PG8_STAGE(PG8_SA(0, 0), a2, cvA0, cvA1);
            PG8_BAR; PG8_WAIT_L(0); PG8_MMA(1, 0, At, B0); PG8_BAR; PG8_SCHED;
            PG8_STAGE(PG8_SB(0, 1), b2 + chB, cvB0, cvB1);
            PG8_WAIT_V(6); PG8_BAR; PG8_MMA(1, 1, At, B1); PG8_BAR;
            PG8_LDB(B0, 1, 0); PG8_SCHED; PG8_LDA(At, 1, 0); PG8_STAGE(PG8_SA(0, 1), a2 + chA, cvA0, cvA1);
            PG8_WAIT_L(8); PG8_BAR; PG8_WAIT_L(0); PG8_MMA(0, 0, At, B0); PG8_BAR; PG8_SCHED;
            PG8_LDB(B1, 1, 1); PG8_STAGE(PG8_SB(1, 0), b3, cvB0, cvB1);
            PG8_BAR; PG8_WAIT_L(0); PG8_MMA(0, 1, At, B1); PG8_BAR;
            PG8_LDA(At, 1, 1); PG8_STAGE(PG8_SA(1, 0), a3, cvA0, cvA1);
            PG8_BAR; PG8_WAIT_L(0); PG8_MMA(1, 0, At, B0); PG8_BAR; PG8_SCHED;
            PG8_STAGE(PG8_SB(1, 1), b3 + chB, cvB0, cvB1);
            PG8_WAIT_V(6); PG8_BAR; PG8_MMA(1, 1, At, B1); PG8_BAR;
            }
        }
        unsigned long long te0_ = 0; const bool tse_ = ((TSMASK >> 12) & 1) && blockIdx.x == 0 && wv == 0;
        if (tse_) te0_ = __builtin_amdgcn_s_memrealtime();
        if constexpr (ALIGN_EPI) { if (wr == 0) PG8_BAR; }
        E(acc, cur, S, wr, wc, fr, fq);
        if (tse_) { volatile LAS unsigned* ta_ = (volatile LAS unsigned*)(lds + 135168 + 8); ta_[0] += (unsigned)(__builtin_amdgcn_s_memrealtime() - te0_); }
        if (!has_next) break;
        acc_t z2 = (acc_t){0, 0, 0, 0}; asm volatile("" : "+v"(z2));
#pragma unroll
        for (int a = 0; a < 2; ++a)
#pragma unroll
            for (int b = 0; b < 2; ++b)
#pragma unroll
                for (int m = 0; m < 4; ++m)
#pragma unroll
                    for (int n = 0; n < 2; ++n) acc[a][b][m][n] = z2;
        cur = nxt; cA = nA; cB = nB; ++ui;
        if constexpr (ALIGN_EPI) { if (wr == 1) PG8_BAR; }
    }
    PG8_WAIT_V(0);
    if constexpr (!ALIGN_EPI) { if (wr == 0) PG8_BAR; }
    PG8_BAR;
#undef PG8_SA
#undef PG8_SB
#undef PG8_STAGE
#undef PG8_LDA
#undef PG8_LDB
#undef PG8_MMA
#undef PG8_WAIT_V
#undef PG8_WAIT_L
#undef PG8_BAR
#undef PG8_SCHED
}

struct SchedStd {
    const char* A; const char* Bt; int lda2, ldb2, nt; int nM, nN, nwg, G, c; char* O; int ldc, otile;
    int gx, grk;
    __device__ __forceinline__ bool next(int i, GUnit& u) const {
        if (G == 256) { const int uu = i * 32 + grk; if (uu >= 5 * nN) return false;
            const int pl = uu % 5; u.pm = pl < 4 ? 4 * gx + pl : 32 + gx; u.pn = uu / 5; u.ks = -1;
            u.a = A + (size_t)u.pm * 256 * lda2; u.b = Bt + (size_t)u.pn * 256 * ldb2; u.nt = nt; return true; }
        const long L = (long)i * G + c; if (L >= nwg) return false;
        int wgid = (int)L; { const int q = nwg / 8, r = nwg % 8, xcd = wgid % 8, off = wgid / 8; wgid = (xcd < r ? xcd * (q + 1) : r * (q + 1) + (xcd - r) * q) + off; }
        const int nig = 8 * nN, gid = wgid / nig, fm = gid * 8, gsz = (nM - fm) < 8 ? (nM - fm) : 8;
        u.pm = fm + ((wgid % nig) % gsz); u.pn = (wgid % nig) / gsz; u.ks = -1;
        u.a = A + (size_t)u.pm * 256 * lda2; u.b = Bt + (size_t)u.pn * 256 * ldb2; u.nt = nt;
        return true;
    }
    __device__ __forceinline__ void out(const GUnit& u, char*& o, int& ld) const { o = O + ((size_t)u.pm * 256 * ldc + (size_t)u.pn * otile) * 2; ld = ldc; }
};
struct SchedSplit {
    const char* A; const char* Bt; int lda2, ldb2, ntot, kq; int G, c; int gx, grk;
    __device__ __forceinline__ bool next(int i, GUnit& u) const {
        const int L = i * G + c; if (L >= 512) return false;
        const int Lr = L & 255; int x = Lr & 7, j = Lr >> 3, kt0 = 0;
        if (G == 256) { x = gx; j = grk; }
        if (L < 256) { u.pm = 4 * x + (j >> 3); u.pn = j & 7; u.ks = -1; u.nt = ntot; }
        else { u.pm = 32 + x; u.pn = j & 7; u.ks = j >> 3; kt0 = u.ks * kq; u.nt = (u.ks < 3) ? kq : ntot - 3 * kq; }
        u.a = A + (size_t)u.pm * 256 * lda2 + (size_t)kt0 * 128; u.b = Bt + (size_t)u.pn * 256 * ldb2 + (size_t)kt0 * 128;
        return true;
    }
};
struct SchedF1 {
    const char* T; const char* mixin; char* gtp; char* gts; int lda2, ldb2; int G, c;
    __device__ __forceinline__ bool next(int i, GUnit& u) const {
        const int L = i * G + c; if (L >= 320) return false;
        u.nt = 4; u.ks = L;
        if (L < 256) { const int bg = L >> 1, b = bg >> 2, g = bg & 3; u.pm = L & 1; u.pn = 0;
            u.b = mixin + ((size_t)(b * 256) * NIN_E + 2048 + g * 256) * 2; }
        else { const int l2 = L - 256, bg = l2 >> 3, b = bg >> 2, g = bg & 3; u.pm = (l2 >> 2) & 1; u.pn = l2 & 3;
            u.b = mixin + ((size_t)(MP + b * 1024 + u.pn * 256) * NIN_E + 2048 + g * 256) * 2; }
        u.a = T + (size_t)u.pm * 256 * 512;
        return true;
    }
    __device__ __forceinline__ void out(const GUnit& u, char*& o, int& ld) const { const int L = u.ks; ld = 2048;
        if (L < 256) o = gtp + ((size_t)(L >> 1) * 256 * 2048 + (size_t)u.pm * 256) * 2;
        else o = gts + ((size_t)((L - 256) >> 3) * 256 * 2048 + (size_t)u.pm * 1024 + u.pn * 256) * 2; }
};
struct SchedF2 {
    const char* cs256; const char* cs1024; const char* gtp; const char* gts; char* mixout; int lda2, ldb2; int G, c;
    __device__ __forceinline__ bool next(int i, GUnit& u) const {
        const int L = i * G + c; if (L >= 160) return false;
        u.ks = L; u.pn = 0;
        if (L < 32) { const int bg = L >> 2; u.pm = L & 3; u.nt = 32; u.a = cs1024 + (size_t)u.pm * 256 * 4096; u.b = gts + (size_t)bg * 256 * 2048 * 2; }
        else { const int bg = L - 32; u.pm = 0; u.nt = 8; u.a = cs256; u.b = gtp + (size_t)bg * 256 * 2048 * 2; }
        return true;
    }
    __device__ __forceinline__ void out(const GUnit& u, char*& o, int& ld) const { const int L = u.ks; ld = DM;
        if (L < 32) { const int bg = L >> 2, b = bg >> 2, g = bg & 3; o = mixout + ((size_t)(MP + b * 1024 + u.pm * 256) * DM + 1024 + g * 256) * 2; }
        else { const int bg = L - 32, b = bg >> 2, g = bg & 3; o = mixout + ((size_t)(b * 256) * DM + 1024 + g * 256) * 2; } }
};

struct EpiBf16 {
    static constexpr bool PERM = true;
    float scale;
    template <class Sched>
    __device__ __forceinline__ void operator()(const f32x4 (&acc)[2][2][4][2], const GUnit& u, const Sched& S, int wr, int wc, int fr, int fq) const {
        char* o; int ldc; S.out(u, o, ldc); bf16_t* T = (bf16_t*)o;
        const unsigned off0 = (unsigned)((wr * 64 + fr) * ldc + wc * 32 + 8 * fq);
#pragma unroll
        for (int ai = 0; ai < 2; ++ai)
#pragma unroll
            for (int m = 0; m < 4; ++m) { const unsigned off = off0 + (unsigned)((ai * HALF + m * 16) * ldc);
#pragma unroll
                for (int bj = 0; bj < 2; ++bj) { const f32x4 v0 = acc[ai][bj][m][0] * scale, v1 = acc[ai][bj][m][1] * scale;
                    u32x4 w; w.x = cvt_pk_bf16(v0[0], v0[1]); w.y = cvt_pk_bf16(v0[2], v0[3]); w.z = cvt_pk_bf16(v1[0], v1[1]); w.w = cvt_pk_bf16(v1[2], v1[3]);
                    *(u32x4*)(T + off + bj * HALF) = w; } }
    }
};
struct EpiF2 { static constexpr bool PERM = true;
    template <class Sched>
    __device__ __forceinline__ void operator()(const f32x4 (&acc)[2][2][4][2], const GUnit& u, const Sched& S, int wr, int wc, int fr, int fq) const {
        EpiBf16 e{u.nt == 32 ? 1.0f / 512.0f : 1.0f / 256.0f}; e(acc, u, S, wr, wc, fr, fq); } };
struct EpiGU {
    static constexpr bool PERM = true;
    template <class Sched>
    __device__ __forceinline__ void operator()(const f32x4 (&acc)[2][2][4][2], const GUnit& u, const Sched& S, int wr, int wc, int fr, int fq) const {
        char* o; int ldc; S.out(u, o, ldc); bf16_t* T = (bf16_t*)o;
        const unsigned off0 = (unsigned)((wr * 64 + fr) * ldc + wc * 32 + 8 * fq);
#pragma unroll
        for (int ai = 0; ai < 2; ++ai)
#pragma unroll
            for (int m = 0; m < 4; ++m) { const unsigned off = off0 + (unsigned)((ai * HALF + m * 16) * ldc); float t[8], r[8];
#pragma unroll
                for (int i = 0; i < 8; ++i) t[i] = acc[ai][0][m][i >> 2][i & 3] * -1.4426950408889634f;
#pragma unroll
                for (int i = 0; i < 8; ++i) t[i] = __builtin_amdgcn_exp2f(t[i]);
#pragma unroll
                for (int i = 0; i < 8; ++i) t[i] = t[i] + 1.0f;
#pragma unroll
                for (int i = 0; i < 8; ++i) t[i] = __builtin_amdgcn_rcpf(t[i]);
#pragma unroll
                for (int i = 0; i < 8; ++i) r[i] = (acc[ai][0][m][i >> 2][i & 3] * acc[ai][1][m][i >> 2][i & 3]) * t[i];
                asm volatile("" : "+v"(r[0]), "+v"(r[1]), "+v"(r[2]), "+v"(r[3]), "+v"(r[4]), "+v"(r[5]), "+v"(r[6]), "+v"(r[7]));
                u32x4 w; w.x = cvt_pk_bf16(r[0], r[1]); w.y = cvt_pk_bf16(r[2], r[3]); w.z = cvt_pk_bf16(r[4], r[5]); w.w = cvt_pk_bf16(r[6], r[7]);
                *(u32x4*)(T + off) = w; }
    }
};
struct EpiGU8 {
    static constexpr bool PERM = true;
    const float* rsc; const float* cmax;
    template <class Sched>
    __device__ __forceinline__ void operator()(const i32x4 (&acc)[2][2][4][2], const GUnit& u, const Sched& S, int wr, int wc, int fr, int fq) const {
        char* o; int ldc; S.out(u, o, ldc); bf16_t* T = (bf16_t*)o;
        const unsigned off0 = (unsigned)((wr * 64 + fr) * ldc + wc * 32 + 4 * fq);
        bf16x8 hf[2];
#pragma unroll
        for (int nt = 0; nt < 2; ++nt) { u32x4 hw;
#pragma unroll
            for (int p = 0; p < 4; ++p) { const unsigned s0 = __builtin_popcount((unsigned)((8 * fq + 2 * p) & (16 * nt + fr))) & 1u, s1 = __builtin_popcount((unsigned)((8 * fq + 2 * p + 1) & (16 * nt + fr))) & 1u;
                hw[p] = (s0 ? 0xbf80u : 0x3f80u) | ((s1 ? 0xbf80u : 0x3f80u) << 16); }
            hf[nt] = __builtin_bit_cast(bf16x8, hw); }
        const float* cp = cmax + u.pn * BM + wc * 32 + 8 * fq;
        f32x4 cs[2][2];
#pragma unroll
        for (int bj = 0; bj < 2; ++bj)
#pragma unroll
            for (int n = 0; n < 2; ++n) cs[bj][n] = *(const f32x4*)(cp + bj * HALF + 4 * n) * (1.0f / 127.0f);
        const float* rp = rsc + u.pm * BM + wr * 64 + fr;
#pragma unroll
        for (int ai = 0; ai < 2; ++ai)
#pragma unroll
            for (int m = 0; m < 4; ++m) { const unsigned off = off0 + (unsigned)((ai * HALF + m * 16) * ldc); float t[8], gg[8], r[8];
                const float rs = rp[ai * HALF + m * 16];
#pragma unroll
                for (int i = 0; i < 8; ++i) gg[i] = (float)acc[ai][0][m][i >> 2][i & 3] * (rs * cs[0][i >> 2][i & 3]);
#pragma unroll
                for (int i = 0; i < 8; ++i) t[i] = gg[i] * -1.4426950408889634f;
#pragma unroll
                for (int i = 0; i < 8; ++i) t[i] = __builtin_amdgcn_exp2f(t[i]);
#pragma unroll
                for (int i = 0; i < 8; ++i) t[i] = t[i] + 1.0f;
#pragma unroll
                for (int i = 0; i < 8; ++i) t[i] = __builtin_amdgcn_rcpf(t[i]);
#pragma unroll
                for (int i = 0; i < 8; ++i) r[i] = (gg[i] * ((float)acc[ai][1][m][i >> 2][i & 3] * (rs * cs[1][i >> 2][i & 3]))) * t[i];
                asm volatile("" : "+v"(r[0]), "+v"(r[1]), "+v"(r[2]), "+v"(r[3]), "+v"(r[4]), "+v"(r[5]), "+v"(r[6]), "+v"(r[7]));
                u32x4 w; w.x = cvt_pk_bf16_b(r[0], r[1]); w.y = cvt_pk_bf16_b(r[2], r[3]); w.z = cvt_pk_bf16_b(r[4], r[5]); w.w = cvt_pk_bf16_b(r[6], r[7]);
                const bf16x8 af = __builtin_bit_cast(bf16x8, w);
                float zf = 0.f; asm volatile("" : "+v"(zf));
                const f32x4 z4 = {zf, zf, zf, zf};
                const f32x4 h0 = __builtin_amdgcn_mfma_f32_16x16x32_bf16(hf[0], af, z4, 0, 0, 0), h1 = __builtin_amdgcn_mfma_f32_16x16x32_bf16(hf[1], af, z4, 0, 0, 0);
                u32x2 o0, o1; o0.x = cvt_pk_bf16_b(h0[0], h0[1]); o0.y = cvt_pk_bf16_b(h0[2], h0[3]); o1.x = cvt_pk_bf16_b(h1[0], h1[1]); o1.y = cvt_pk_bf16_b(h1[2], h1[3]);
                *(u32x2*)(T + off) = o0; *(u32x2*)(T + off + 16) = o1;
                __builtin_amdgcn_sched_barrier(0); }
    }
};
struct EpiResid8 {
    static constexpr bool PERM = false;
    float* x; const float* gate; float coef; float* slab; const float* rsc; const float* cmax;
    template <class Sched>
    __device__ __forceinline__ void operator()(const i32x4 (&acc)[2][2][4][2], const GUnit& u, const Sched& S, int wr, int wc, int fr, int fq) const {
        const unsigned off0 = (unsigned)((wr * 64 + fr) * DM + wc * 32 + 4 * fq);
        const float* cp = cmax + u.pn * BM + wc * 32 + 4 * fq;
        const float* rp = rsc + u.pm * BM + wr * 64 + fr;
        float rsv[8];
#pragma unroll
        for (int i = 0; i < 8; ++i) rsv[i] = rp[(i >> 2) * HALF + (i & 3) * 16];
        f32x4 gv[2][2];
        if (u.ks < 0) { const float* gt = gate + u.pn * BM + wc * 32 + 4 * fq;
#pragma unroll
            for (int bj = 0; bj < 2; ++bj)
#pragma unroll
                for (int n = 0; n < 2; ++n) gv[bj][n] = (*(const f32x4*)(gt + bj * HALF + n * 16) * coef) * (*(const f32x4*)(cp + bj * HALF + n * 16) * (1.0f / 127.0f));
        } else {
#pragma unroll
            for (int bj = 0; bj < 2; ++bj)
#pragma unroll
                for (int n = 0; n < 2; ++n) gv[bj][n] = *(const f32x4*)(cp + bj * HALF + n * 16) * (1.0f / 127.0f);
        }
        asm volatile("" : "+v"(rsv[0]), "+v"(rsv[1]), "+v"(rsv[2]), "+v"(rsv[3]), "+v"(rsv[4]), "+v"(rsv[5]), "+v"(rsv[6]), "+v"(rsv[7]));
        if (u.ks < 0) {
            float* T = x + (size_t)u.pm * BM * DM + u.pn * BM;
#pragma unroll
            for (int ai = 0; ai < 2; ++ai)
#pragma unroll
                for (int m = 0; m < 4; ++m) { const unsigned off = off0 + (unsigned)((ai * HALF + m * 16) * DM); const float rs = rsv[ai * 4 + m];
#pragma unroll
                    for (int bj = 0; bj < 2; ++bj)
#pragma unroll
                        for (int n = 0; n < 2; ++n) { f32x4* p = (f32x4*)(T + off + bj * HALF + n * 16); const i32x4 a = acc[ai][bj][m][n];
                            const f32x4 af = {(float)a[0], (float)a[1], (float)a[2], (float)a[3]}; *p = *p + (gv[bj][n] * rs) * af; }
                    if (m == 3) asm volatile("" ::: "memory"); }
        } else {
            bf16_t* T = (bf16_t*)slab + (size_t)u.ks * MS * DM + (size_t)(u.pm - 32) * BM * DM + u.pn * BM;
#pragma unroll
            for (int ai = 0; ai < 2; ++ai)
#pragma unroll
                for (int m = 0; m < 4; ++m) { const unsigned off = off0 + (unsigned)((ai * HALF + m * 16) * DM); const float rs = rsv[ai * 4 + m];
#pragma unroll
                    for (int bj = 0; bj < 2; ++bj)
#pragma unroll
                        for (int n = 0; n < 2; ++n) { const i32x4 a = acc[ai][bj][m][n]; const f32x4 v = (f32x4){(float)a[0], (float)a[1], (float)a[2], (float)a[3]} * (gv[bj][n] * rs);
                            u32x2 w; w.x = cvt_pk_bf16(v[0], v[1]); w.y = cvt_pk_bf16(v[2], v[3]); *(u32x2*)(T + off + bj * HALF + n * 16) = w; } }
        }
    }
};
struct EpiResid {
    static constexpr bool PERM = false;
    float* x; const float* gate; float coef; float* slab;
    template <class Sched>
    __device__ __forceinline__ void operator()(const f32x4 (&acc)[2][2][4][2], const GUnit& u, const Sched& S, int wr, int wc, int fr, int fq) const {
        const unsigned off0 = (unsigned)((wr * 64 + fr) * DM + wc * 32 + 4 * fq);
        if (u.ks < 0) {
            float* T = x + (size_t)u.pm * BM * DM + u.pn * BM; const float* gt = gate + u.pn * BM + wc * 32 + 4 * fq;
            f32x4 gv[2][2];
#pragma unroll
            for (int bj = 0; bj < 2; ++bj)
#pragma unroll
                for (int n = 0; n < 2; ++n) gv[bj][n] = *(const f32x4*)(gt + bj * HALF + n * 16) * coef;
#pragma unroll
            for (int ai = 0; ai < 2; ++ai)
#pragma unroll
                for (int m = 0; m < 4; ++m) { const unsigned off = off0 + (unsigned)((ai * HALF + m * 16) * DM);
#pragma unroll
                    for (int bj = 0; bj < 2; ++bj)
#pragma unroll
                        for (int n = 0; n < 2; ++n) { f32x4* p = (f32x4*)(T + off + bj * HALF + n * 16); *p = *p + gv[bj][n] * acc[ai][bj][m][n]; }
                    if (m == 3) asm volatile("" ::: "memory"); }
        } else {
            bf16_t* T = (bf16_t*)slab + (size_t)u.ks * MS * DM + (size_t)(u.pm - 32) * BM * DM + u.pn * BM;
#pragma unroll
            for (int ai = 0; ai < 2; ++ai)
#pragma unroll
                for (int m = 0; m < 4; ++m) { const unsigned off = off0 + (unsigned)((ai * HALF + m * 16) * DM);
#pragma unroll
                    for (int bj = 0; bj < 2; ++bj)
#pragma unroll
                        for (int n = 0; n < 2; ++n) { const f32x4 v = acc[ai][bj][m][n]; u32x2 w; w.x = cvt_pk_bf16(v[0], v[1]); w.y = cvt_pk_bf16(v[2], v[3]); *(u32x2*)(T + off + bj * HALF + n * 16) = w; } }
        }
    }
};
}

namespace att {
constexpr int D = 128, QBLK = 32, KVBLK = 64;
constexpr float SCALE = 0.088388347648318440f;
constexpr float THR = 8.f;
constexpr float NEG = -1e30f;
constexpr size_t SHM_V = KVBLK * D * 2, SHM_K = KVBLK * D * 2, SHM_ATTN = 2 * SHM_V + 2 * SHM_K + 8 * 64 * 4;
constexpr int RPB_OFF = (int)SHM_ATTN;
#define KSWZ(row, colB) ((row) * 256 + ((colB) ^ (((row) & 7) << 4)))
#define SBAR() __builtin_amdgcn_sched_barrier(0)
__device__ __forceinline__ int crow(int r, int hi) { return (r & 3) + 8 * (r >> 2) + 4 * hi; }

struct AUnit { const bf16_t* Q; bf16_t* O; const bf16_t* Kc; const bf16_t* Vc; const bf16_t* Kl; const bf16_t* Vl; int nctx, nloc, nt, mode, q0, kt0; float m0, l0; const float* rpb; };

__device__ __forceinline__ void partialSM(f32x16& p0, f32x16& p1, float& m_reg, float& mn, float& alpha) {
  constexpr float C = SCALE * 1.4426950408889634f;
  float pmax = p0[0];
#pragma unroll
  for (int r = 1; r < 16; ++r) pmax = fmaxf(pmax, p0[r]);
#pragma unroll
  for (int r = 0; r < 16; ++r) pmax = fmaxf(pmax, p1[r]);
  { auto rr = __builtin_amdgcn_permlane32_swap(__float_as_uint(pmax), __float_as_uint(pmax), false, false);
    pmax = fmaxf(__uint_as_float(rr[0]), __uint_as_float(rr[1])); }
  if (__builtin_expect(__all(pmax - m_reg <= THR / SCALE), 1)) { mn = m_reg; alpha = 1.f; }
  else { mn = fmaxf(m_reg, pmax); alpha = __builtin_amdgcn_exp2f((m_reg - mn) * C); m_reg = mn; }
  float mnC = -mn * C;
#pragma unroll
  for (int r = 0; r < 16; ++r) p0[r] = fmaf(p0[r], C, mnC);
#pragma unroll
  for (int r = 0; r < 16; ++r) p1[r] = fmaf(p1[r], C, mnC);
#pragma unroll
  for (int r = 0; r < 16; ++r) p0[r] = __builtin_amdgcn_exp2f(p0[r]);
}
__device__ __forceinline__ void finishSM(f32x16& p0, f32x16& p1, float alpha, float& l_reg, bf16x8& pa0, bf16x8& pa1, bf16x8& pa2, bf16x8& pa3) {
#pragma unroll
  for (int r = 0; r < 16; ++r) p1[r] = __builtin_amdgcn_exp2f(p1[r]);
  float ps = 0;
#pragma unroll
  for (int r = 0; r < 16; ++r) ps += p0[r];
#pragma unroll
  for (int r = 0; r < 16; ++r) ps += p1[r];
  { auto rr = __builtin_amdgcn_permlane32_swap(__float_as_uint(ps), __float_as_uint(ps), false, false);
    ps = __uint_as_float(rr[0]) + __uint_as_float(rr[1]); }
  l_reg = l_reg * alpha + ps;
#define PK4(P, BASE, OUT) do { unsigned a0 = cvt_pk_bf16(P[BASE + 0], P[BASE + 1]), a1 = cvt_pk_bf16(P[BASE + 2], P[BASE + 3]);   \
    unsigned b0 = cvt_pk_bf16(P[BASE + 4], P[BASE + 5]), b1 = cvt_pk_bf16(P[BASE + 6], P[BASE + 7]);                              \
    auto r0 = __builtin_amdgcn_permlane32_swap(a0, b0, false, false); auto r1 = __builtin_amdgcn_permlane32_swap(a1, b1, false, false); \
    u32x4 w = {r0[0], r1[0], r0[1], r1[1]}; OUT = *reinterpret_cast<bf16x8*>(&w); } while (0)
  PK4(p0, 0, pa0); PK4(p0, 8, pa1); PK4(p1, 0, pa2); PK4(p1, 8, pa3);
#undef PK4
}
__device__ __forceinline__ void qkt(f32x16& p0, f32x16& p1, const bf16_t* Ks, const bf16x8* qr, int r32, int hi) {
  p0 = f32x16{}; p1 = f32x16{};
#pragma unroll
  for (int d0 = 0; d0 < 8; ++d0) { int cb = (d0 * 16 + hi * 8) * 2;
    bf16x8 b0 = *reinterpret_cast<const bf16x8*>((const char*)Ks + KSWZ(r32, cb));
    bf16x8 b1 = *reinterpret_cast<const bf16x8*>((const char*)Ks + KSWZ(32 + r32, cb));
    p0 = __builtin_amdgcn_mfma_f32_32x32x16_bf16(b0, qr[d0], p0, 0, 0, 0);
    p1 = __builtin_amdgcn_mfma_f32_32x32x16_bf16(b1, qr[d0], p1, 0, 0, 0); }
}
__device__ __forceinline__ int v_st(int k, int c) { const int kk = (k & ~0xC) | ((k & 4) << 1) | ((k & 8) >> 1); return ((kk >> 3) * 4 + (c >> 5)) * 512 + ((kk & 7) * 32 + (c & 31)) * 2; }
__device__ __forceinline__ int v_rd_base(int lane) { return ((lane & 3) << 3) | (((lane >> 2) & 3) << 6) | (((lane >> 4) & 1) << 5) | (((lane >> 5) & 1) << 8); }
constexpr int v_rd_off(int d0, int ks, int half) { return d0 * 512 + ks * 4096 + half * 2048; }
template <int OFF> __device__ __forceinline__ s16x4 tr_read(int vb) {
  s16x4 r; asm volatile("ds_read_b64_tr_b16 %0, %1 offset:%2" : "=&v"(r) : "v"(vb), "i"(OFF) : "memory"); return r;
}
template <int D0> __device__ __forceinline__ void pv_one(f32x16& od, int vb, bf16x8 pa0, bf16x8 pa1, bf16x8 pa2, bf16x8 pa3) {
  const s16x4 l0 = tr_read<v_rd_off(D0, 0, 0)>(vb), h0 = tr_read<v_rd_off(D0, 0, 1)>(vb), l1 = tr_read<v_rd_off(D0, 1, 0)>(vb), h1 = tr_read<v_rd_off(D0, 1, 1)>(vb);
  const s16x4 l2 = tr_read<v_rd_off(D0, 2, 0)>(vb), h2 = tr_read<v_rd_off(D0, 2, 1)>(vb), l3 = tr_read<v_rd_off(D0, 3, 0)>(vb), h3 = tr_read<v_rd_off(D0, 3, 1)>(vb);
  asm volatile("s_waitcnt lgkmcnt(0)" ::: "memory"); SBAR();
#define PK(L, H) (bf16x8){L[0], L[1], L[2], L[3], H[0], H[1], H[2], H[3]}
  od = __builtin_amdgcn_mfma_f32_32x32x16_bf16(pa0, PK(l0, h0), od, 0, 0, 0);
  od = __builtin_amdgcn_mfma_f32_32x32x16_bf16(pa1, PK(l1, h1), od, 0, 0, 0);
  od = __builtin_amdgcn_mfma_f32_32x32x16_bf16(pa2, PK(l2, h2), od, 0, 0, 0);
  od = __builtin_amdgcn_mfma_f32_32x32x16_bf16(pa3, PK(l3, h3), od, 0, 0, 0);
#undef PK
}
__device__ __forceinline__ void pv_d0(f32x16* o, int vb, bf16x8 pa0, bf16x8 pa1, bf16x8 pa2, bf16x8 pa3) {
  pv_one<0>(o[0], vb, pa0, pa1, pa2, pa3); pv_one<1>(o[1], vb, pa0, pa1, pa2, pa3); pv_one<2>(o[2], vb, pa0, pa1, pa2, pa3); pv_one<3>(o[3], vb, pa0, pa1, pa2, pa3);
}
__device__ __forceinline__ void mask_tile(f32x16& p0, f32x16& p1, const AUnit& U, int j, int qrel, int hi, const float* rpbT) {
  if (j < U.nctx) return;
  const int jl = j - U.nctx;
  if (jl >= U.nloc) {
#pragma unroll
    for (int r = 0; r < 16; ++r) { p0[r] = NEG; p1[r] = NEG; }
    return; }
  if (U.mode == 1) {
    const int dq = (U.kt0 + jl) * 64 - (U.q0 + qrel) + 128;
#pragma unroll
    for (int r = 0; r < 16; ++r) { const int d0 = dq + crow(r, hi); if ((unsigned)d0 > 256u) p0[r] = NEG; if ((unsigned)(d0 + 32) > 256u) p1[r] = NEG; }
  } else if (U.mode == 2) {
    const int qpos = U.q0 + qrel, qrow = qpos >> 6, qcol = qpos & 63, krow = U.kt0 + jl;
    int rs = qrow - 4; rs = rs < 0 ? 0 : (rs > 8 ? 8 : rs);
    int cs = qcol - 8; cs = cs < 0 ? 0 : (cs > 48 ? 48 : cs);
    const bool rowok = (krow >= rs) && (krow < rs + 8);
    const int ib = (krow - qrow + 7) * 31 - qcol + 15;
#pragma unroll
    for (int r = 0; r < 16; ++r) { const int kc0 = crow(r, hi), kc1 = kc0 + 32;
      const bool ok0 = rowok && ((unsigned)(kc0 - cs) < 16u), ok1 = rowok && ((unsigned)(kc1 - cs) < 16u);
      const float b0 = rpbT[ok0 ? ib + kc0 : 0], b1 = rpbT[ok1 ? ib + kc1 : 0];
      p0[r] = ok0 ? p0[r] + b0 : NEG; p1[r] = ok1 ? p1[r] + b1 : NEG; }
  }
}
__device__ __forceinline__ void attn_unit(const AUnit& U, char* lds, int wv) {
  const int tid = ptid(wv);
  const int wid = wv, lane = tid & 63, r32 = lane & 31, hi = lane >> 5;
  bf16_t* V_lds = (bf16_t*)lds; bf16_t* K_lds = (bf16_t*)(lds + 2 * SHM_V);
  float* ws = (float*)(lds + 2 * SHM_V + 2 * SHM_K) + wid * 64; float* li_l = ws; float* al_l = ws + 32;
  float* rpbT = (float*)(lds + RPB_OFF);
  if (U.mode == 2) { for (int i = tid; i < 15 * 31; i += NTHR) rpbT[i] = U.rpb[i] * (1.0f / SCALE); }
  float m_reg = U.m0, l_reg = U.l0; f32x16 o[4] = {}; bf16x8 qr[8];
  const bf16_t* Qw = U.Q + (long)(wid * QBLK + r32) * D + hi * 8;
#pragma unroll
  for (int d0 = 0; d0 < 8; ++d0) qr[d0] = *reinterpret_cast<const bf16x8*>(Qw + d0 * 16);
  const int sr = tid >> 4, sc = (tid & 15) * 8, vst0 = v_st(sr, sc), vst1 = v_st(32 + sr, sc);
  const int vb0 = (int)(uintptr_t)V_lds + v_rd_base(lane);
  const int qrel = wid * QBLK + r32;
  struct { bf16x8 vs0, vs1, ks0, ks1; } sr_[1];
#define KTP(j) ((j) < U.nctx ? U.Kc + (long)(j) * 8192 : U.Kl + (long)(((j) - U.nctx) < U.nloc ? ((j) - U.nctx) : (U.nloc - 1)) * 8192)
#define VTP(j) ((j) < U.nctx ? U.Vc + (long)(j) * 8192 : U.Vl + (long)(((j) - U.nctx) < U.nloc ? ((j) - U.nctx) : (U.nloc - 1)) * 8192)
#define SLOAD(i, j) do { const bf16_t* kp_ = KTP(j); const bf16_t* vp_ = VTP(j); \
    sr_[i].vs0 = *reinterpret_cast<const bf16x8*>(&vp_[(long)(sr) * D + sc]); sr_[i].vs1 = *reinterpret_cast<const bf16x8*>(&vp_[(long)(32 + sr) * D + sc]); \
    sr_[i].ks0 = *reinterpret_cast<const bf16x8*>(&kp_[(long)(sr) * D + sc]); sr_[i].ks1 = *reinterpret_cast<const bf16x8*>(&kp_[(long)(32 + sr) * D + sc]); } while (0)
#define SWRITE(b, i) do { *(bf16x8*)((char*)V_lds + (b) * SHM_V + vst0) = sr_[i].vs0;          \
    *(bf16x8*)((char*)V_lds + (b) * SHM_V + vst1) = sr_[i].vs1; int kc = sc * 2;               \
    *(bf16x8*)((char*)K_lds + (b) * SHM_K + KSWZ(sr, kc)) = sr_[i].ks0;                       \
    *(bf16x8*)((char*)K_lds + (b) * SHM_K + KSWZ(32 + sr, kc)) = sr_[i].ks1; } while (0)
#define SWAIT() asm volatile("s_waitcnt vmcnt(0)" ::: "memory")
#define RESC(a) do { if (__any((a) < 1.f)) { if (hi == 0) al_l[r32] = (a); asm volatile("s_waitcnt lgkmcnt(0)" ::: "memory"); \
    _Pragma("unroll") for (int d = 0; d < 4; ++d) _Pragma("unroll") for (int r = 0; r < 16; ++r) o[d][r] *= al_l[crow(r, hi)]; } } while (0)
  f32x16 pA0, pA1, pB0, pB1; float mnA, mnB, alA, alB; bf16x8 pa0, pa1, pa2, pa3; const int NT = U.nt;
  SLOAD(0, 0); asm volatile("s_waitcnt vmcnt(0)" ::: "memory"); SWRITE(0, 0); __syncthreads();
  qkt(pA0, pA1, K_lds, qr, r32, hi); partialSM(pA0, pA1, m_reg, mnA, alA);
  SLOAD(0, 1);
  SWAIT(); SWRITE(1, 0); __syncthreads();
  for (int j = 1; j + 1 < NT; j += 2) {
    SBAR(); qkt(pB0, pB1, (bf16_t*)((char*)K_lds + SHM_K), qr, r32, hi);
    finishSM(pA0, pA1, alA, l_reg, pa0, pa1, pa2, pa3); SBAR();
    SLOAD(0, j + 1); SBAR();
    pv_d0(o, vb0, pa0, pa1, pa2, pa3); mask_tile(pB0, pB1, U, j, qrel, hi, rpbT); partialSM(pB0, pB1, m_reg, mnB, alB);
    __syncthreads(); SWAIT(); SWRITE(0, 0);
    RESC(alB); __syncthreads();
    SBAR(); qkt(pA0, pA1, K_lds, qr, r32, hi);
    finishSM(pB0, pB1, alB, l_reg, pa0, pa1, pa2, pa3); SBAR();
    SLOAD(0, j + 2); SBAR();
    pv_d0(o, vb0 + (int)SHM_V, pa0, pa1, pa2, pa3); mask_tile(pA0, pA1, U, j + 1, qrel, hi, rpbT); partialSM(pA0, pA1, m_reg, mnA, alA);
    __syncthreads(); SWAIT(); SWRITE(1, 0);
    RESC(alA); __syncthreads();
  }
  SBAR(); qkt(pB0, pB1, (bf16_t*)((char*)K_lds + SHM_K), qr, r32, hi);
  finishSM(pA0, pA1, alA, l_reg, pa0, pa1, pa2, pa3); SBAR();
  pv_d0(o, vb0, pa0, pa1, pa2, pa3); mask_tile(pB0, pB1, U, NT - 1, qrel, hi, rpbT); partialSM(pB0, pB1, m_reg, mnB, alB);
  __syncthreads(); RESC(alB);
  finishSM(pB0, pB1, alB, l_reg, pa0, pa1, pa2, pa3); SBAR();
  pv_d0(o, vb0 + (int)SHM_V, pa0, pa1, pa2, pa3);
  if (hi == 0) li_l[r32] = l_reg; asm volatile("s_waitcnt lgkmcnt(0)" ::: "memory");
  float rli[16];
#pragma unroll
  for (int r = 0; r < 16; ++r) rli[r] = __builtin_amdgcn_rcpf(li_l[crow(r, hi)]);
  bf16_t* Ow = U.O + (long)(wid * QBLK) * DM;
#pragma unroll
  for (int r = 0; r < 16; ++r) { int orow = crow(r, hi);
#pragma unroll
    for (int d0 = 0; d0 < 4; ++d0) Ow[(long)orow * DM + d0 * 32 + r32] = (bf16_t)f2bf(o[d0][r] * rli[r]); }
  __syncthreads();
#undef KTP
#undef VTP
#undef SLOAD
#undef SWRITE
#undef SWAIT
#undef RESC
}
#undef KSWZ
#undef SBAR
}

struct Args { const float* in[29]; float* out; unsigned char* ws; };
enum { I_XP = 0, I_XS, I_C, I_CCK, I_CCV, I_CDK, I_CDV, I_CCTX, I_WADA, I_BADA, I_GF1, I_WGU1, I_WDN1, I_GMIX, I_WOUT, I_GF2, I_WGU2, I_WDN2, I_WINE, I_GSGU, I_WSGU, I_BSGU, I_WINO,
       I_GQC, I_GKC, I_GQD, I_GKD, I_SINK, I_RPB };

__device__ __forceinline__ void transpose_item(const float* W, int K, int N, bf16_t* WT, int k0, int n0, int drow0, LAS float* scr, int lane) {
    (void)scr;
    const int r8 = lane >> 3, c4 = (lane & 7) * 4;
    f32x4 dd[8]; const float* wp = W + (size_t)(k0 + 8 * r8) * N + n0 + c4;
#pragma unroll
    for (int ii = 0; ii < 8; ++ii) dd[ii] = __builtin_nontemporal_load((const f32x4*)(wp + (size_t)ii * N));
#pragma unroll
    for (int e = 0; e < 4; ++e) { u32x4 o; o.x = pk2(dd[0][e], dd[1][e]); o.y = pk2(dd[2][e], dd[3][e]); o.z = pk2(dd[4][e], dd[5][e]); o.w = pk2(dd[6][e], dd[7][e]);
        __builtin_nontemporal_store(o, (u32x4*)(WT + (size_t)(drow0 + c4 + e) * K + k0 + 8 * r8)); }
}
__device__ __forceinline__ void transpose_item_q8(const float* W, int K, int N, signed char* WT, int k0, int n0, int drow0, const float* cmax, LAS float* scr, int lane) {
#pragma unroll 8
    for (int i = 0; i < 32; ++i) { const int kk = 2 * i + (lane >> 5); scr[kk * 33 + (lane & 31)] = W[(size_t)(k0 + kk) * N + n0 + (lane & 31)]; }
    LDS_WAIT(); asm volatile("" ::: "memory");
    const int c = lane & 7;
#pragma unroll
    for (int j = 0; j < 4; ++j) { const int n = (lane >> 3) + 8 * j; const LAS float* s = scr + (8 * c) * 33 + n;
        const float inv = 127.0f / fmaxf(cmax[drow0 + n], 1e-30f); int q[8];
#pragma unroll
        for (int i = 0; i < 8; ++i) { int v = (int)__builtin_rintf(s[i * 33] * inv); v = v > 127 ? 127 : (v < -127 ? -127 : v); q[i] = v & 255; }
        u32x2 o; o.x = (unsigned)q[0] | ((unsigned)q[1] << 8) | ((unsigned)q[2] << 16) | ((unsigned)q[3] << 24); o.y = (unsigned)q[4] | ((unsigned)q[5] << 8) | ((unsigned)q[6] << 16) | ((unsigned)q[7] << 24);
        *(u32x2*)(WT + (size_t)(drow0 + n) * K + k0 + 8 * c) = o; }
    LDS_WAIT(); asm volatile("" ::: "memory");
}
__device__ __forceinline__ int gu_row(int n) { return n < DFF ? ((n >> 7) * 256 + (n & 127)) : (((n - DFF) >> 7) * 256 + 128 + ((n - DFF) & 127)); }

constexpr int CONV_PER_LAYER = 11008 * 2 + 5504 * 2 + 2048 + 4608;
__device__ __forceinline__ void convert_item(const Args& A, int l, int r, LAS float* scr, int lane) {
    bf16_t* wl = (bf16_t*)(ws_opaque(A.ws) + WS_W) + (size_t)l * W_LAYER;
    if (r < 22016) { const int f = r / 11008; r %= 11008; const int kb = r / 344, nb = r % 344;
        transpose_item_q8(asg(A.in[f ? I_WGU2 : I_WGU1]) + (size_t)l * DM * NGU, DM, NGU, (signed char*)(wl + (f ? W_GU2 : W_GU1)), kb * 64, nb * 32, gu_row(nb * 32),
                          (const float*)(ws_opaque(A.ws) + WS_CMAX) + (size_t)(l * 2 + f) * NGU, scr, lane); return; }
    r -= 22016;
    if (r < 11008) { const int f = r / 5504; r %= 5504; const int kb = r / 64, nb = r % 64;
        transpose_item(asg(A.in[f ? I_WDN2 : I_WDN1]) + (size_t)l * DFF * DM, DFF, DM, wl + (f ? W_DN2 : W_DN1), kb * 64, nb * 32, nb * 32, scr, lane); return; }
    r -= 11008;
    if (r < 2048) { const int kb = r / 64, nb = r % 64;
        transpose_item(asg(A.in[I_WOUT]) + (size_t)l * DM * DM, DM, DM, wl + W_OUT, kb * 64, nb * 32, nb * 32, scr, lane); return; }
    r -= 2048;
    if (l & 1) { const int kb = r / 144, nb = r % 144;
        transpose_item(asg(A.in[I_WINO]) + (size_t)(l >> 1) * DM * NIN_O, DM, NIN_O, wl + W_IN, kb * 64, nb * 32, nb * 32, scr, lane); }
    else if (r < 3072) { const int kb = r / 96, nb = r % 96;
        transpose_item(asg(A.in[I_WINE]) + (size_t)(l >> 1) * DM * NIN_E, DM, NIN_E, wl + W_IN, kb * 64, nb * 32, nb * 32, scr, lane); }
}
__device__ __forceinline__ void gu_q8_wg_item(const Args& A, LAS unsigned char* lds, int l, int f, int nb, int wv) {
    const int tid = ptid(wv), lane = tid & 63, r8 = lane >> 3, c4 = (lane & 7) * 4;
    const float* W = asg(A.in[f ? I_WGU2 : I_WGU1]) + (size_t)l * DM * NGU;
    LAS float* wmax = (LAS float*)(lds + 69632);
    LAS float* cm = wmax + 256;
    f32x4 d[32];
    { const float* w = W + (size_t)(wv * 256 + 8 * r8) * NGU + nb * 32 + c4;
#pragma unroll
      for (int i = 0; i < 32; ++i) d[i] = __builtin_nontemporal_load((const f32x4*)(w + (size_t)((i >> 3) * 64 + (i & 7)) * NGU)); }
    { f32x4 mx = {0.f, 0.f, 0.f, 0.f};
#pragma unroll
      for (int i = 0; i < 32; ++i) { mx[0] = fmaxf(mx[0], fabsf(d[i][0])); mx[1] = fmaxf(mx[1], fabsf(d[i][1])); mx[2] = fmaxf(mx[2], fabsf(d[i][2])); mx[3] = fmaxf(mx[3], fabsf(d[i][3])); }
#pragma unroll
      for (int q = 0; q < 4; ++q) { mx[q] = fmaxf(mx[q], sx<8>(mx[q])); mx[q] = fmaxf(mx[q], sx<16>(mx[q])); mx[q] = max32(mx[q]); }
      if (lane < 8) { wmax[wv * 32 + lane * 4 + 0] = mx[0]; wmax[wv * 32 + lane * 4 + 1] = mx[1]; wmax[wv * 32 + lane * 4 + 2] = mx[2]; wmax[wv * 32 + lane * 4 + 3] = mx[3]; } }
    __syncthreads();
    const int drow0 = gu_row(nb * 32);
    if (tid < 32) { float m = wmax[tid];
#pragma unroll
        for (int w8 = 1; w8 < 8; ++w8) m = fmaxf(m, wmax[w8 * 32 + tid]);
        cm[tid] = m; ((float*)(ws_opaque(A.ws) + WS_CMAX))[(size_t)(l * 2 + f) * NGU + drow0 + tid] = m; }
    __syncthreads();
    signed char* WT = (signed char*)((bf16_t*)(ws_opaque(A.ws) + WS_W) + (size_t)l * W_LAYER + (f ? W_GU2 : W_GU1));
    float inv[4];
#pragma unroll
    for (int e = 0; e < 4; ++e) inv[e] = 127.0f / fmaxf(cm[c4 + e], 1e-30f);
#pragma unroll
    for (int kb = 0; kb < 4; ++kb)
#pragma unroll
        for (int e = 0; e < 4; ++e) { int q[8];
#pragma unroll
            for (int i = 0; i < 8; ++i) { int v = (int)__builtin_rintf(d[kb * 8 + i][e] * inv[e]); v = v > 127 ? 127 : (v < -127 ? -127 : v); q[i] = v & 255; }
            u32x2 o; o.x = (unsigned)q[0] | ((unsigned)q[1] << 8) | ((unsigned)q[2] << 16) | ((unsigned)q[3] << 24); o.y = (unsigned)q[4] | ((unsigned)q[5] << 8) | ((unsigned)q[6] << 16) | ((unsigned)q[7] << 24);
            __builtin_nontemporal_store(o, (u32x2*)(WT + (size_t)(drow0 + c4 + e) * DM + wv * 256 + kb * 64 + 8 * r8)); }
    __syncthreads();
}
__device__ __forceinline__ void wht32_rows(float (&v)[8], int r8) {
#pragma unroll
    for (int st = 1; st < 8; st <<= 1)
#pragma unroll
        for (int i = 0; i < 8; ++i) if (!(i & st)) { const float a = v[i], b = v[i + st]; v[i] = a + b; v[i + st] = a - b; }
#pragma unroll
    for (int i = 0; i < 8; ++i) { const float p = sx<8>(v[i]); v[i] = (r8 & 1) ? (p - v[i]) : (v[i] + p); }
#pragma unroll
    for (int i = 0; i < 8; ++i) { const float p = sx<16>(v[i]); v[i] = (r8 & 2) ? (p - v[i]) : (v[i] + p); }
}
__device__ __forceinline__ void dn_q8_wg_item(const Args& A, LAS unsigned char* lds, int l, int f, int nb, int wv) {
    const int tid = ptid(wv), lane = tid & 63, r8 = lane >> 3, c4 = (lane & 7) * 4;
    const float* W = asg(A.in[f ? I_WDN2 : I_WDN1]) + (size_t)l * DFF * DM;
    LAS float* wmax = (LAS float*)(lds + 69632);
    LAS float* cm = wmax + 256;
    signed char* WT = (signed char*)((bf16_t*)(ws_opaque(A.ws) + WS_W) + (size_t)l * W_LAYER + (f ? W_DN2 : W_DN1));
    float mx[4] = {0.f, 0.f, 0.f, 0.f}, inv[4] = {0.f, 0.f, 0.f, 0.f};
    for (int pass = 0; pass < 2; ++pass) {
#define DN_LOAD(buf, kb_) do { const float* wp_ = W + (size_t)((kb_) * 64 + 8 * r8) * DM + nb * 32 + c4; _Pragma("unroll") for (int ii = 0; ii < 8; ++ii) buf[ii] = *(const f32x4*)(wp_ + (size_t)ii * DM); } while (0)
#define DN_PROC(buf, kb_) do { const int k0_ = (kb_) * 64; _Pragma("unroll") for (int e = 0; e < 4; ++e) { float v[8]; \
            _Pragma("unroll") for (int i = 0; i < 8; ++i) v[i] = buf[i][e]; \
            wht32_rows(v, r8); \
            if (pass == 0) { _Pragma("unroll") for (int i = 0; i < 8; ++i) mx[e] = fmaxf(mx[e], fabsf(v[i])); } \
            else { int q[8]; _Pragma("unroll") for (int i = 0; i < 8; ++i) { int t = (int)__builtin_rintf(v[i] * inv[e]); t = t > 127 ? 127 : (t < -127 ? -127 : t); q[i] = t & 255; } \
                u32x2 o; o.x = (unsigned)q[0] | ((unsigned)q[1] << 8) | ((unsigned)q[2] << 16) | ((unsigned)q[3] << 24); o.y = (unsigned)q[4] | ((unsigned)q[5] << 8) | ((unsigned)q[6] << 16) | ((unsigned)q[7] << 24); \
                __builtin_nontemporal_store(o, (u32x2*)(WT + (size_t)(nb * 32 + c4 + e) * KD8 + k0_ + 8 * r8)); } } } while (0)
        f32x4 bA[8], bB[8];
        DN_LOAD(bA, wv);
        for (int kb = wv; ; kb += 16) {
            const bool h1 = kb + 8 < 86; if (h1) DN_LOAD(bB, kb + 8);
            DN_PROC(bA, kb);
            if (!h1) break;
            const bool h2 = kb + 16 < 86; if (h2) DN_LOAD(bA, kb + 16);
            DN_PROC(bB, kb + 8);
            if (!h2) break;
        }
#undef DN_LOAD
#undef DN_PROC
        if (pass == 0) {
#pragma unroll
            for (int e = 0; e < 4; ++e) { mx[e] = fmaxf(mx[e], sx<8>(mx[e])); mx[e] = fmaxf(mx[e], sx<16>(mx[e])); mx[e] = max32(mx[e]); }
            if (lane < 8) {
#pragma unroll
                for (int e = 0; e < 4; ++e) wmax[wv * 32 + c4 + e] = mx[e]; }
            __syncthreads();
            if (tid < 32) { float m = wmax[tid];
#pragma unroll
                for (int w8 = 1; w8 < 8; ++w8) m = fmaxf(m, wmax[w8 * 32 + tid]);
                cm[tid] = m; ((float*)(ws_opaque(A.ws) + WS_CMAX2))[(size_t)(l * 2 + f) * DM + nb * 32 + tid] = m * (1.0f / 32.0f); }
            __syncthreads();
#pragma unroll
            for (int e = 0; e < 4; ++e) inv[e] = 127.0f / fmaxf(cm[c4 + e], 1e-30f);
        }
    }
    if (tid < 256) { u32x4 zv = {0u, 0u, 0u, 0u}; asm volatile("" : "+v"(zv)); *(u32x4*)(WT + (size_t)(nb * 32 + (tid >> 3)) * KD8 + DFF + (tid & 7) * 16) = zv; }
    __syncthreads();
}
constexpr int CONV_GU_ROUNDS = 688, CONV_DN_ROUNDS = 128, CONV_ROUNDS = CONV_GU_ROUNDS + CONV_DN_ROUNDS + (CONV_PER_LAYER - 33024) / 8;
__device__ __forceinline__ void conv_round(const Args& A, LAS unsigned char* lds, int l, int r, int wv) {
    if (r < CONV_GU_ROUNDS) { gu_q8_wg_item(A, lds, l, r / 344, r % 344, wv); return; }
    if (r < CONV_GU_ROUNDS + CONV_DN_ROUNDS) { const int rr = r - CONV_GU_ROUNDS; dn_q8_wg_item(A, lds, l, rr >> 6, rr & 63, wv); return; }
    const int lane = ptid(wv) & 63;
    convert_item(A, l, 33024 + 8 * (r - CONV_GU_ROUNDS - CONV_DN_ROUNDS) + wv, (LAS float*)(lds + wv * 8704), lane);
}
#define QH(l) (8192 + 64 * (l))
__device__ __forceinline__ bool fill_round(const Args& A, LAS unsigned char* lds, int l, int wv) {
    volatile LAS unsigned* MISC = (volatile LAS unsigned*)(lds + LDS_MISC);
    const int tid = ptid(wv);
    if (tid == 0) MISC[4] = __hip_atomic_fetch_add((unsigned*)(ws_opaque(A.ws) + WS_CTL) + QH(l), 1u, __ATOMIC_RELAXED, __HIP_MEMORY_SCOPE_AGENT);
    __syncthreads();
    const int base = (int)MISC[4];
    __syncthreads();
    if (base >= CONV_ROUNDS) return false;
    conv_round(A, lds, l, base, wv);
    return true;
}
__device__ __forceinline__ void fill_wait(const Args& A, LAS unsigned char* lds, int G, int wv, int nbar, int& ql) {
    volatile LAS unsigned* MISC = (volatile LAS unsigned*)(lds + LDS_MISC);
    while (ql < 4) {
        const int tid = ptid(wv);
        if (tid == 0) { unsigned* bar = (unsigned*)(ws_opaque(A.ws) + WS_CTL); unsigned sum = 0u;
#pragma unroll
            for (unsigned j = 0; j < 16; ++j) sum += xb_ld(&bar[XB_XSUB(j)]);
            MISC[5] = ((sum - (unsigned)nbar * (unsigned)G) * 2u >= (unsigned)G) ? 1u : 0u; }
        __syncthreads();
        const unsigned stop = MISC[5];
        __syncthreads();
        if (stop) break;
        if (!fill_round(A, lds, ql, wv)) ++ql;
    }
}

__device__ __forceinline__ void prologue_a(const Args& A, LAS unsigned char* lds, int G, int wv) {
    const int tid = ptid(wv), lane = tid & 63, wave = wv;
    unsigned char* ws = ws_opaque(A.ws);
    LAS float* sil = (LAS float*)(lds + 69632);
    for (int i = tid; i < 3 * DM; i += NTHR) { const int cv = i / DM, k = i % DM; const float v = cv == 0 ? asg(A.in[I_CCTX])[k] : asg(A.in[I_C])[(cv - 1) * DM + k]; sil[i] = v / (1.0f + __expf(-v)); }
    __syncthreads();
    const int gw = obid() * NWAVES + wave, NGW = G * NWAVES;
    for (int it = gw; it < 4 * 144 * 4; it += NGW) {
        const int l = it / 576, r = it % 576, cg = r >> 2, ks = r & 3;
        const float* w = asg(A.in[I_WADA]) + ((size_t)l * DM + ks * 512) * NMODV + cg * 128 + 2 * lane;
        f32x2 a0 = {0.f, 0.f}, a1 = {0.f, 0.f}, a2 = {0.f, 0.f};
        const LAS float* s0 = sil + ks * 512;
#pragma unroll 8
        for (int k = 0; k < 512; ++k) { const f32x2 wv = __builtin_nontemporal_load((const f32x2*)(w + (size_t)k * NMODV)); a0 += wv * s0[k]; a1 += wv * s0[DM + k]; a2 += wv * s0[2 * DM + k]; }
        float* P = (float*)(ws + WS_ADAP) + ((size_t)(l * 4 + ks) * 3) * NMODV + cg * 128 + 2 * lane;
        *(f32x2*)P = a0; *(f32x2*)(P + NMODV) = a1; *(f32x2*)(P + 2 * NMODV) = a2;
    }
    __syncthreads();
    for (int r = obid(); r < CONV_ROUNDS; r += G) conv_round(A, lds, 0, r, wv);
    const size_t gt = (size_t)obid() * NTHR + tid, GT = (size_t)G * NTHR;
    constexpr size_t N_CK = 524288 / 8, N_DK = 2097152 / 8, N_WS = 262144 / 8, N_T = 131072 / 8, N_CS = 2097152 / 8;
    constexpr size_t E0 = N_CK, E1 = E0 + N_CK, E2 = E1 + N_DK, E3 = E2 + N_DK, E4 = E3 + N_WS, E5 = E4 + N_T, E6 = E5 + N_T, E7 = E6 + N_CS;
    for (size_t i = gt; i < E7; i += GT) {
        if (i < E4) {
            const float* src; bf16_t* dst; size_t j;
            if (i < E0) { src = asg(A.in[I_CCK]); dst = (bf16_t*)(ws + WS_CCK); j = i; }
            else if (i < E1) { src = asg(A.in[I_CCV]); dst = (bf16_t*)(ws + WS_CCV); j = i - E0; }
            else if (i < E2) { src = asg(A.in[I_CDK]); dst = (bf16_t*)(ws + WS_CDK); j = i - E1; }
            else if (i < E3) { src = asg(A.in[I_CDV]); dst = (bf16_t*)(ws + WS_CDV); j = i - E2; }
            else { src = asg(A.in[I_WSGU]); dst = (bf16_t*)(ws + WS_WSGU); j = i - E3; }
            const f32x4 x0 = *(const f32x4*)(src + j * 8), x1 = *(const f32x4*)(src + j * 8 + 4);
            u32x4 o; o.x = pk2(x0[0], x0[1]); o.y = pk2(x0[2], x0[3]); o.z = pk2(x1[0], x1[1]); o.w = pk2(x1[2], x1[3]);
            *(u32x4*)(dst + j * 8) = o;
        } else {
            float v[8]; bf16_t* dst; size_t j; size_t doff;
            if (i < E5) { j = i - E4; doff = j * 8; dst = (bf16_t*)(ws + WS_T256); const int m = (int)(j * 8) / 256, k0 = (int)(j * 8) % 256, cp = m & 255, h = m >> 8;
#pragma unroll
                for (int e = 0; e < 8; ++e) { const float ang = (float)(((cp * (k0 + e)) & 255) * 2) * (1.0f / 256.0f); v[e] = h ? sinpif(ang) : cospif(ang); } }
            else if (i < E6) { j = i - E5; dst = (bf16_t*)(ws + WS_CS256); const int sp = (int)(j * 8) / 512, kk0 = (int)(j * 8) % 512, h = kk0 / 256, s0 = kk0 % 256; doff = (size_t)sp * 2048 + kk0;
#pragma unroll
                for (int e = 0; e < 8; ++e) { const float ang = (float)(((sp * (s0 + e)) & 255) * 2) * (1.0f / 256.0f); v[e] = h ? -sinpif(ang) : cospif(ang); } }
            else { j = i - E6; doff = j * 8; dst = (bf16_t*)(ws + WS_CS1024); const int sp = (int)(j * 8) / 2048, kk0 = (int)(j * 8) % 2048, h = kk0 / 1024, s0 = kk0 % 1024;
#pragma unroll
                for (int e = 0; e < 8; ++e) { const float ang = (float)(((sp * (s0 + e)) & 1023) * 2) * (1.0f / 1024.0f); v[e] = h ? -sinpif(ang) : cospif(ang); } }
            u32x4 o; o.x = pk2(v[0], v[1]); o.y = pk2(v[2], v[3]); o.z = pk2(v[4], v[5]); o.w = pk2(v[6], v[7]);
            *(u32x4*)(dst + doff) = o;
        }
    }
    if (gt < 2048) { const int pos = (int)gt >> 5, f = (int)gt & 31; const float inv = powf(10000.0f, -(float)f / 32.0f), ang = (float)pos * inv;
        float* rt = (float*)(ws + WS_ROPE); rt[gt] = cosf(ang); rt[2048 + gt] = sinf(ang); }
}
__device__ __forceinline__ void prologue_b(const Args& A, LAS unsigned char* lds, int G, int wv) {
    const size_t gt = (size_t)obid() * NTHR + ptid(wv), GT = (size_t)G * NTHR;
    const float* P = (const float*)(ws_opaque(A.ws) + WS_ADAP); float* Mo = (float*)(ws_opaque(A.ws) + WS_MODS);
    for (size_t i = gt; i < (size_t)4 * 3 * NMODV; i += GT) { const int l = (int)(i / (3 * NMODV)), r = (int)(i % (3 * NMODV)), j = r % NMODV;
        float s = asg(A.in[I_BADA])[(size_t)l * NMODV + j];
#pragma unroll
        for (int ks = 0; ks < 4; ++ks) s += P[((size_t)(l * 4 + ks) * 3) * NMODV + r];
        Mo[i] = s; }
}

__device__ __forceinline__ void nm_phase(const Args& A, int G, bool first, bool do_slab, float coef, int layer_gate, int kgate, bool do_norm, const float* g, int layer, int kshift, int wv, bool q8, int gx, int grk) {
    const int tid = ptid(wv);
    const int lane = tid & 63, wave = wv;
    const int gw = obid() * NWAVES + wave, NGW = G * NWAVES;
    float* xd = asg(A.out); bf16_t* H = (bf16_t*)(ws_opaque(A.ws) + WS_H);
    const float* mods = (const float*)(ws_opaque(A.ws) + WS_MODS); const float* slab = (const float*)(ws_opaque(A.ws) + WS_SLAB);
    const int r_lo = do_norm ? 0 : MP;
#define NM_ROW(it_) ((((it_) < 4 ? 4 * gx + (it_) : 32 + gx) * 256) + grk * 8 + wave)
#define NM_LOAD(buf, it_) do { const int r_ = NM_ROW(it_); const float* xr_ = first ? (r_ < MP ? asg(A.in[I_XP]) + (size_t)r_ * DM : asg(A.in[I_XS]) + (size_t)(r_ - MP) * DM) : xd + (size_t)r_ * DM; \
        _Pragma("unroll") for (int j = 0; j < 8; ++j) buf[j] = *(const f32x4*)(xr_ + 4 * lane + 256 * j); } while (0)
    const int it0 = do_norm ? 0 : 4;
    f32x4 v[8], nx[8], ma[8], mb[8]; int cvl = -1;
    NM_LOAD(v, it0);
#pragma unroll 1
    for (int it = it0; it < 5; ++it) {
        const int r = NM_ROW(it);
        const int cv = r < MP ? 0 : 1 + ((r - MP) >> 10);
        if (it < 4) NM_LOAD(nx, it + 1);
        const bool wr_x = first || (do_slab && r >= MP);
        if (do_slab && r >= MP) {
            const float* gt_ = mods + ((size_t)(layer_gate * 3 + cv)) * NMODV + kgate * DM;
            const bf16_t* sb = (const bf16_t*)slab + (size_t)(r - MP) * DM;
#pragma unroll
            for (int j = 0; j < 8; ++j) { const int c = 4 * lane + 256 * j;
                const u32x2 w0 = *(const u32x2*)(sb + c), w1 = *(const u32x2*)(sb + (size_t)MS * DM + c), w2 = *(const u32x2*)(sb + (size_t)2 * MS * DM + c), w3 = *(const u32x2*)(sb + (size_t)3 * MS * DM + c);
                const f32x4 s = {(bf_lo(w0.x) + bf_lo(w1.x)) + (bf_lo(w2.x) + bf_lo(w3.x)), (bf_hi(w0.x) + bf_hi(w1.x)) + (bf_hi(w2.x) + bf_hi(w3.x)),
                                 (bf_lo(w0.y) + bf_lo(w1.y)) + (bf_lo(w2.y) + bf_lo(w3.y)), (bf_hi(w0.y) + bf_hi(w1.y)) + (bf_hi(w2.y) + bf_hi(w3.y))};
                v[j] = v[j] + (*(const f32x4*)(gt_ + c) * coef) * s; }
        }
        if (wr_x) {
#pragma unroll
            for (int j = 0; j < 8; ++j) *(f32x4*)(xd + (size_t)r * DM + 4 * lane + 256 * j) = v[j];
        }
        if (do_norm) {
            float ss = 0.f;
#pragma unroll
            for (int j = 0; j < 8; ++j) ss += (v[j][0] * v[j][0] + v[j][1] * v[j][1]) + (v[j][2] * v[j][2] + v[j][3] * v[j][3]);
            ss = wave_sum(ss);
            const float rstd = 1.0f / sqrtf(ss * (1.0f / DM) + EPS);
            if (cv != cvl) { cvl = cv; const float* sh = mods + ((size_t)(layer * 3 + cv)) * NMODV + kshift * DM; const float* scp = sh + DM;
#pragma unroll
                for (int j = 0; j < 8; ++j) { const int c = 4 * lane + 256 * j; ma[j] = *(const f32x4*)(g + c) * (*(const f32x4*)(scp + c) + 1.0f); mb[j] = *(const f32x4*)(sh + c); } }
            if (!q8) {
#pragma unroll
                for (int j = 0; j < 8; ++j) { const int c = 4 * lane + 256 * j;
                    const f32x4 y = (v[j] * rstd) * ma[j] + mb[j];
                    u32x2 w; w.x = cvt_pk_bf16(y[0], y[1]); w.y = cvt_pk_bf16(y[2], y[3]);
                    *(u32x2*)(H + (size_t)r * DM + c) = w; }
            } else {
                float amax = 0.f;
#pragma unroll
                for (int j = 0; j < 8; ++j) {
                    v[j] = (v[j] * rstd) * ma[j] + mb[j];
                    amax = fmaxf(fmaxf(amax, fmaxf(fabsf(v[j][0]), fabsf(v[j][1]))), fmaxf(fabsf(v[j][2]), fabsf(v[j][3]))); }
                amax = wave_max(amax);
                amax = fmaxf(amax, 1e-30f);
                const float inv = 127.0f / amax;
                signed char* H8 = (signed char*)H;
#pragma unroll
                for (int j = 0; j < 8; ++j) { const int c = 4 * lane + 256 * j; unsigned w = 0u;
#pragma unroll
                    for (int e = 0; e < 4; ++e) { int q = (int)__builtin_rintf(v[j][e] * inv); q = q > 127 ? 127 : (q < -127 ? -127 : q); w |= (unsigned)(q & 255) << (8 * e); }
                    *(unsigned*)(H8 + (size_t)r * DM + c) = w; }
                if (lane == 0) ((float*)(ws_opaque(A.ws) + WS_RSC))[r] = amax * (1.0f / 127.0f);
            }
        }
#pragma unroll
        for (int j = 0; j < 8; ++j) v[j] = nx[j];
    }
#undef NM_ROW
#undef NM_LOAD
}

__device__ __forceinline__ void q8act_phase(const Args& A, int wv, int gx, int grk) {
    const int tid = ptid(wv), lane = tid & 63;
    const bf16_t* act = (const bf16_t*)(ws_opaque(A.ws) + WS_ACT); signed char* a8 = (signed char*)(ws_opaque(A.ws) + WS_ACT8); float* rs2 = (float*)(ws_opaque(A.ws) + WS_RSC2);
#define QA_ROW(it_) ((((it_) < 4 ? 4 * gx + (it_) : 32 + gx) * 256) + grk * 8 + wv)
#define QA_LOAD(buf, it_) do { const bf16_t* row_ = act + (size_t)QA_ROW(it_) * DFF; \
        _Pragma("unroll") for (int j = 0; j < 11; ++j) { const int idx_ = lane + 64 * j; buf[j] = (idx_ < 688) ? __builtin_nontemporal_load((const u32x4*)(row_ + idx_ * 8)) : (u32x4){0u, 0u, 0u, 0u}; } } while (0)
    u32x4 v[11], nx[11];
    QA_LOAD(v, 0);
#pragma unroll 1
    for (int it = 0; it < 5; ++it) {
        const int r = QA_ROW(it);
        if (it < 4) QA_LOAD(nx, it + 1);
        float amax = 0.f;
#pragma unroll
        for (int j = 0; j < 11; ++j) {
#pragma unroll
            for (int e = 0; e < 4; ++e) amax = fmaxf(amax, fmaxf(fabsf(bf_lo(v[j][e])), fabsf(bf_hi(v[j][e])))); }
        amax = wave_max(amax);
        amax = fmaxf(amax, 1e-30f);
        const float inv = 127.0f / amax;
        signed char* orow = a8 + (size_t)r * KD8;
#pragma unroll
        for (int j = 0; j < 11; ++j) { const int idx = lane + 64 * j; u32x2 o;
#pragma unroll
            for (int h = 0; h < 2; ++h) { unsigned w = 0u;
#pragma unroll
                for (int e = 0; e < 2; ++e) { const unsigned src = v[j][2 * h + e];
                    int q0 = (int)__builtin_rintf(bf_lo(src) * inv), q1 = (int)__builtin_rintf(bf_hi(src) * inv);
                    q0 = q0 > 127 ? 127 : (q0 < -127 ? -127 : q0); q1 = q1 > 127 ? 127 : (q1 < -127 ? -127 : q1);
                    w |= ((unsigned)(q0 & 255) | ((unsigned)(q1 & 255) << 8)) << (16 * e); }
                o[h] = w; }
            if (idx < 688) *(u32x2*)(orow + idx * 8) = o; }
        if (lane < 16) { u32x2 zv = {0u, 0u}; asm volatile("" : "+v"(zv)); *(u32x2*)(orow + DFF + lane * 8) = zv; }
        if (lane == 0) rs2[r] = amax * (1.0f / 127.0f);
#pragma unroll
        for (int j = 0; j < 11; ++j) v[j] = nx[j];
    }
#undef QA_ROW
#undef QA_LOAD
}

__device__ __forceinline__ void vstat_phase(const Args& A, int G, int wv) {
    const int tid = ptid(wv), lane = tid & 63;
    const bf16_t* mixin = (const bf16_t*)(ws_opaque(A.ws) + WS_MIXIN); float* rst = (float*)(ws_opaque(A.ws) + WS_SSQ);
    for (int r = obid() * NWAVES + wv; r < MTOT; r += G * NWAVES) {
        const bf16_t* p = mixin + (size_t)r * NIN_E + 1024 + lane * 8;
        const u32x4 a = *(const u32x4*)p, b = *(const u32x4*)(p + 512);
        float ss = 0.f;
#pragma unroll
        for (int e = 0; e < 4; ++e) { const float x0 = bf_lo(a[e]), x1 = bf_hi(a[e]), y0 = bf_lo(b[e]), y1 = bf_hi(b[e]); ss += (x0 * x0 + x1 * x1) + (y0 * y0 + y1 * y1); }
        ss = wave_sum(ss);
        if (lane == 0) rst[r] = 1.0f / sqrtf(ss * (1.0f / 1024.0f) + EPS);
    }
}

__device__ __forceinline__ void sgu_phase(const Args& A, LAS unsigned char* lds, int G, int e, int wv) {
    const int tid = ptid(wv);
    const int lane = tid & 63, wave = wv;
    const bf16_t* mixin = (const bf16_t*)(ws_opaque(A.ws) + WS_MIXIN); bf16_t* mixout = (bf16_t*)(ws_opaque(A.ws) + WS_MIXOUT);
    const float* ssq = (const float*)(ws_opaque(A.ws) + WS_SSQ);
    const bf16_t* wsg = (const bf16_t*)(ws_opaque(A.ws) + WS_WSGU) + (size_t)e * 8 * 128 * 128;
    LAS bf16_t* LT = (LAS bf16_t*)lds;
    LAS float* rs = (LAS float*)(lds + 128 * 136 * 2);
    volatile LAS unsigned* MISCq = (volatile LAS unsigned*)(lds + LDS_MISC);
    for (;;) {
        if (tid == 0) MISCq[6] = __hip_atomic_fetch_add((unsigned*)(ws_opaque(A.ws) + WS_CTL) + (8192 + 64 * (12 + e)), 1u, __ATOMIC_RELAXED, __HIP_MEMORY_SCOPE_AGENT);
        __syncthreads();
        const int u = (int)MISCq[6];
        if (u >= 80 * 8) break;
        const int ch = u >> 3, g = u & 7, t0 = ch * 128;
        __syncthreads();
        if (tid < 128) rs[tid] = ssq[t0 + tid];
        __syncthreads();
#pragma unroll
        for (int i = 0; i < 4; ++i) { const int idx = tid + NTHR * i, q = idx >> 4, cc = idx & 15;
            const u32x4 w = *(const u32x4*)(mixin + (size_t)(t0 + q) * NIN_E + 1024 + g * 128 + cc * 8);
            const float* gs = asg(A.in[I_GSGU]) + (size_t)e * 1024 + g * 128 + cc * 8; const float r = rs[q];
            const f32x4 g0 = *(const f32x4*)gs, g1 = *(const f32x4*)(gs + 4);
            float y[8] = {bf_lo(w.x) * r * g0[0], bf_hi(w.x) * r * g0[1], bf_lo(w.y) * r * g0[2], bf_hi(w.y) * r * g0[3], bf_lo(w.z) * r * g1[0], bf_hi(w.z) * r * g1[1], bf_lo(w.w) * r * g1[2], bf_hi(w.w) * r * g1[3]};
#pragma unroll
            for (int k = 0; k < 8; ++k) LT[(cc * 8 + k) * 136 + q] = (bf16_t)f2bf(y[k]); }
        __syncthreads();
        const int p = 16 * wave + (lane & 15), kq = lane >> 4;
        bf16x8 wf[4];
#pragma unroll
        for (int ks = 0; ks < 4; ++ks) wf[ks] = *(const bf16x8*)(wsg + ((size_t)g * 128 + p) * 128 + 32 * ks + 8 * kq);
        const float bias = asg(A.in[I_BSGU])[(size_t)e * 1024 + g * 128 + p];
#pragma unroll
        for (int nt = 0; nt < 8; ++nt) { f32x4 acc = {0.f, 0.f, 0.f, 0.f};
#pragma unroll
            for (int ks = 0; ks < 4; ++ks) { const bf16x8 vf = *(const LAS bf16x8*)(LT + (16 * nt + (lane & 15)) * 136 + 32 * ks + 8 * kq);
                acc = __builtin_amdgcn_mfma_f32_16x16x32_bf16(vf, wf[ks], acc, 0, 0, 0); }
            const int c = 16 * nt + 4 * kq;
            const u32x2 uu = *(const u32x2*)(mixin + (size_t)(t0 + p) * NIN_E + g * 128 + c);
            u32x2 o; o.x = cvt_pk_bf16(bf_lo(uu.x) * (acc[0] + bias), bf_hi(uu.x) * (acc[1] + bias)); o.y = cvt_pk_bf16(bf_lo(uu.y) * (acc[2] + bias), bf_hi(uu.y) * (acc[3] + bias));
            *(u32x2*)(mixout + (size_t)(t0 + p) * DM + g * 128 + c) = o; }
    }
    __syncthreads();
}

__device__ __forceinline__ void prep_phase(const Args& A, int G, int o, int wv, int gx, int grk) {
    const int tid = ptid(wv);
    const int lane = tid & 63, wave = wv, li = lane & 15, grp = lane >> 4;
    const int gw = obid() * NWAVES + wave, NGW = G * NWAVES;
    const bf16_t* mixin = (const bf16_t*)(ws_opaque(A.ws) + WS_MIXIN); bf16_t* qkv = (bf16_t*)(ws_opaque(A.ws) + WS_QKV);
    const float* rt = (const float*)(ws_opaque(A.ws) + WS_ROPE);
    for (int it = 0; it < 5; ++it) {
        const int r = (it < 4 ? 4 * gx + it : 32 + gx) * 256 + grk * 8 + wave;
        const bool smp = r >= MP; const int b = smp ? (r - MP) >> 10 : r >> 8, s = smp ? (r - MP) & 1023 : r & 255, S = smp ? 1024 : 256;
        const int prow = s >> 6, pcol = s & 63;
#pragma unroll
        for (int j = 0; j < 9; ++j) {
            const int slot = 4 * j + grp;
            const u32x4 w = __builtin_nontemporal_load((const u32x4*)(mixin + (size_t)r * NIN_O + slot * 128 + li * 8));
            float x[8] = {bf_lo(w.x), bf_hi(w.x), bf_lo(w.y), bf_hi(w.y), bf_lo(w.z), bf_hi(w.z), bf_lo(w.w), bf_hi(w.w)};
            int ty, hd, H;
            if (slot < 8) { ty = 0; hd = slot; H = 8; } else if (slot < 10) { ty = 1; hd = slot - 8; H = 2; } else if (slot < 12) { ty = 2; hd = slot - 10; H = 2; }
            else if (slot < 20) { ty = 3; hd = slot - 12; H = 8; } else if (slot < 28) { ty = 4; hd = slot - 20; H = 8; } else { ty = 5; hd = slot - 28; H = 8; }
            const bool isn = (ty != 2) && (ty != 5);
            float ss = 0.f;
#pragma unroll
            for (int k = 0; k < 8; ++k) ss += x[k] * x[k];
            ss += sx<1>(ss); ss += sx<2>(ss); ss += sx<4>(ss); ss += sx<8>(ss);
            const float rstd = 1.0f / sqrtf(ss * (1.0f / 128.0f) + EPS);
            const float* gp = asg(A.in[ty == 0 ? I_GQC : ty == 1 ? I_GKC : ty == 3 ? I_GQD : I_GKD]) + (size_t)o * 128 + li * 8;
            if (isn) {
                const f32x4 g0 = *(const f32x4*)gp, g1 = *(const f32x4*)(gp + 4);
#pragma unroll
                for (int k = 0; k < 4; ++k) { x[k] = x[k] * rstd * g0[k]; x[4 + k] = x[4 + k] * rstd * g1[k]; }
            }
            if (smp && j <= 2) {
                const int pos = (li < 8) ? prow : pcol; const float* ct = rt + pos * 32 + 8 * (li & 3); const float* st = ct + 2048;
                const bool lo = !(li & 4), dor = ty < 2;
#pragma unroll
                for (int k = 0; k < 8; ++k) { const float xp = sx<4>(x[k]); const float c = ct[k], sn = st[k];
                    const float rr = lo ? (x[k] * c - xp * sn) : (xp * sn + x[k] * c); x[k] = dor ? rr : x[k]; }
            }
            const size_t base = smp ? (ty == 0 ? Q_QCS : ty == 1 ? Q_KCS : ty == 2 ? Q_VCS : ty == 3 ? Q_QDS : ty == 4 ? Q_KDS : Q_VDS)
                                    : (ty == 0 ? Q_QCP : ty == 1 ? Q_KCP : ty == 2 ? Q_VCP : ty == 3 ? Q_QDP : ty == 4 ? Q_KDP : Q_VDP);
            u32x4 ov; ov.x = cvt_pk_bf16(x[0], x[1]); ov.y = cvt_pk_bf16(x[2], x[3]); ov.z = cvt_pk_bf16(x[4], x[5]); ov.w = cvt_pk_bf16(x[6], x[7]);
            *(u32x4*)(qkv + base + ((size_t)(b * H + hd) * S + s) * 128 + li * 8) = ov;
            if (!smp && (ty == 1 || ty == 2 || ty == 4 || ty == 5)) {
                float* sp = asg(A.out) + (ty == 1 ? O_SCK : ty == 2 ? O_SCV : ty == 4 ? O_SDK : O_SDV) + (((size_t)(b * 2 + o) * H + hd) * 256 + s) * 128 + li * 8;
                __builtin_nontemporal_store((f32x4){x[0], x[1], x[2], x[3]}, (f32x4*)sp); __builtin_nontemporal_store((f32x4){x[4], x[5], x[6], x[7]}, (f32x4*)(sp + 4));
            }
        }
    }
}

__device__ __forceinline__ void attn_phase(const Args& A, LAS unsigned char* lds, int G, int o, int wv) {
    const bf16_t* qkv = (const bf16_t*)(ws_opaque(A.ws) + WS_QKV); bf16_t* mixout = (bf16_t*)(ws_opaque(A.ws) + WS_MIXOUT);
    const int c = obid();
    for (int i = 0;; ++i) {
        int u;
        if (G == 256) { if (c < 128) { if (i > 0) break; u = c; } else { if (i >= 4) break; u = 128 + 4 * (c - 128) + i; } }
        else { u = c + i * G; if (u >= 640) break; }
        att::AUnit U;
        if (u < 64) {
            const int b = u >> 5, h = (u >> 2) & 7, qb = u & 3;
            U.q0 = qb * 256; U.kt0 = qb == 0 ? 0 : (qb == 1 ? 0 : (qb == 2 ? 4 : 8)); U.nloc = (qb == 0 || qb == 3) ? 8 : 11; U.nctx = 8; U.nt = 8 + ((U.nloc + 1) & ~1); U.mode = 2;
            U.Q = qkv + Q_QDS + ((size_t)(b * 8 + h) * 1024 + U.q0) * 128; U.O = mixout + (size_t)(MP + b * 1024 + U.q0) * DM + (8 + h) * 128;
            U.Kc = (const bf16_t*)(ws_opaque(A.ws) + WS_CDK) + ((size_t)((b * 2 + o) * 8 + h)) * 512 * 128; U.Vc = (const bf16_t*)(ws_opaque(A.ws) + WS_CDV) + ((size_t)((b * 2 + o) * 8 + h)) * 512 * 128;
            U.Kl = qkv + Q_KDS + ((size_t)(b * 8 + h) * 1024 + U.kt0 * 64) * 128; U.Vl = qkv + Q_VDS + ((size_t)(b * 8 + h) * 1024 + U.kt0 * 64) * 128;
            U.m0 = -1e30f; U.l0 = 0.f; U.rpb = asg(A.in[I_RPB]) + ((size_t)o * 8 + h) * 15 * 31;
        } else if (u < 128) {
            const int v = u - 64, b = v >> 5, h = (v >> 2) & 7, qb = v & 3, kvh = h >> 2;
            U.q0 = qb * 256; const int k_lo = qb == 0 ? 0 : 4 * qb - 2, k_hi = qb == 3 ? 15 : 4 * qb + 5;
            U.kt0 = k_lo; U.nloc = k_hi - k_lo + 1; U.nctx = 8; U.nt = 8 + U.nloc; U.mode = 1;
            U.Q = qkv + Q_QCS + ((size_t)(b * 8 + h) * 1024 + U.q0) * 128; U.O = mixout + (size_t)(MP + b * 1024 + U.q0) * DM + h * 128;
            U.Kc = (const bf16_t*)(ws_opaque(A.ws) + WS_CCK) + ((size_t)((b * 2 + o) * 2 + kvh)) * 512 * 128; U.Vc = (const bf16_t*)(ws_opaque(A.ws) + WS_CCV) + ((size_t)((b * 2 + o) * 2 + kvh)) * 512 * 128;
            U.Kl = qkv + Q_KCS + ((size_t)(b * 2 + kvh) * 1024 + U.kt0 * 64) * 128; U.Vl = qkv + Q_VCS + ((size_t)(b * 2 + kvh) * 1024 + U.kt0 * 64) * 128;
            U.m0 = asg(A.in[I_SINK])[o * 8 + h] * (1.0f / att::SCALE); U.l0 = 1.f; U.rpb = nullptr;
        } else {
            const int v = u - 128, b = v >> 4, hh = v & 15;
            U.q0 = 0; U.kt0 = 0; U.nloc = 0; U.nctx = 4; U.nt = 4; U.mode = 0; U.rpb = nullptr; U.Kl = nullptr; U.Vl = nullptr;
            U.O = mixout + (size_t)(b * 256) * DM + hh * 128;
            if (hh < 8) { const int kvh = hh >> 2;
                U.Q = qkv + Q_QCP + ((size_t)(b * 8 + hh) * 256) * 128; U.Kc = qkv + Q_KCP + ((size_t)(b * 2 + kvh) * 256) * 128; U.Vc = qkv + Q_VCP + ((size_t)(b * 2 + kvh) * 256) * 128;
                U.m0 = asg(A.in[I_SINK])[o * 8 + hh] * (1.0f / att::SCALE); U.l0 = 1.f; }
            else { const int h = hh - 8;
                U.Q = qkv + Q_QDP + ((size_t)(b * 8 + h) * 256) * 128; U.Kc = qkv + Q_KDP + ((size_t)(b * 8 + h) * 256) * 128; U.Vc = qkv + Q_VDP + ((size_t)(b * 8 + h) * 256) * 128;
                U.m0 = -1e30f; U.l0 = 0.f; }
        }
        att::attn_unit(U, (char*)lds, wv);
    }
}

#ifndef ONLY_PH
#define ONLY_PH (-1)
#endif
#define PH(n) (ONLY_PH < 0 || ONLY_PH == (n))
#ifndef DUPMASK
#define DUPMASK 0
#endif
#define DUPN(g) (((DUPMASK >> (g)) & 1) ? 2 : 1)
#define TSMULT 8
#define TS0() do { if (ts_on) ts_t0 = __builtin_amdgcn_s_memrealtime(); } while (0)
#define TSC0() do { if (((TSMASK >> 13) & 1) && ts_on) ts_c0 = (unsigned long long)__builtin_readcyclecounter(); } while (0)
#define TSC1() do { if (((TSMASK >> 13) & 1) && ts_on) { const unsigned long long d_ = (unsigned long long)__builtin_readcyclecounter() - ts_c0; TSACC[0] += (unsigned)(d_ / 20ull); } } while (0)
#define TS1(g) do { if (((TSMASK >> (g)) & 1) && ts_on) { const unsigned long long d_ = __builtin_amdgcn_s_memrealtime() - ts_t0; TSACC[0] += (unsigned)d_; } } while (0)
__global__ void __launch_bounds__(NTHR, 2) mega_fwd(Args args) {
    extern __shared__ __attribute__((aligned(16))) unsigned char lds_raw[];
    LAS unsigned char* lds = (LAS unsigned char*)lds_raw;
    const int G = gridDim.x, wv = __builtin_amdgcn_readfirstlane((int)(threadIdx.x >> 6));
    volatile LAS unsigned* MISC = (volatile LAS unsigned*)(lds + LDS_MISC);
    { const int t0 = ptid(wv); if (t0 < 16) MISC[t0] = 0u; }
    __syncthreads();
#define WSB ws_opaque(args.ws)
    const bool ts_on = (TSMASK != 0 || TSBAR != 0) && (blockIdx.x == 0) && (wv == 0); unsigned long long ts_t0 = 0, ts_c0 = 0; (void)ts_c0; volatile LAS unsigned* TSACC = MISC + 2; (void)ts_on; (void)ts_t0; (void)TSACC;
    XcdBarrier bar = xcd_barrier_post((unsigned*)(WSB + WS_CTL), MISC + 8, ptid(wv));
    const float* mods = (const float*)(WSB + WS_MODS);

    int ql = 1, nbar = 0; int lok = 0; int gx = 0, grk = 0;
#ifndef LOCAL_BAR
#define LOCAL_BAR 1
#endif
#define BARRIER2(g, loc) do { TS0(); \
    if (LOCAL_BAR && (loc) && lok) { local_barrier((unsigned*)(WSB + WS_CTL), (unsigned*)(WSB + WS_CTL) + 8192 + 64 * (20 + gx), 32u, wv); } \
    else { fill_wait(args, lds, G, wv, nbar, ql); for (int br_ = 0; br_ < DUPN(10); ++br_) { xcd_barrier(bar, wv); ++nbar; } } \
    TS1(10); if (((TSBAR >> (g)) & 1) && ts_on) { TSACC[0] += (unsigned)(__builtin_amdgcn_s_memrealtime() - ts_t0); } } while (0)
#define BARRIER(g) BARRIER2(g, false)
    for (int rep = 0; rep < DUPN(0); ++rep) { TS0(); if (PH(0)) prologue_a(args, lds, G, wv); TS1(0); BARRIER(0); }
    if (ptid(wv) == 0) { unsigned* barw = (unsigned*)(WSB + WS_CTL); const unsigned myx = MISC[11]; unsigned npop = 0u, below = 0u; bool uni = (G == 256);
        for (unsigned j = 0; j < 16; ++j) { const unsigned cnt = xb_ld(&barw[XB_XCNT(j)]); if (cnt) { ++npop; if (j < myx) ++below; if (cnt != 32u) uni = false; } }
        uni = uni && (npop == 8u); MISC[12] = below; MISC[13] = uni ? 1u : 0u; }
    __syncthreads();
    lok = __builtin_amdgcn_readfirstlane((int)MISC[13]); asm volatile("" : "+s"(lok));
    gx = lok ? __builtin_amdgcn_readfirstlane((int)MISC[12]) : (int)(blockIdx.x & 7);
    grk = lok ? __builtin_amdgcn_readfirstlane((int)MISC[10]) : (int)(blockIdx.x >> 3);
    TS0(); if (PH(1)) prologue_b(args, lds, G, wv); TS1(11);
    BARRIER(11);

    for (int layer = 0; layer < 4; ++layer) {
        const bf16_t* wl = (const bf16_t*)(WSB + WS_W) + (size_t)layer * W_LAYER;
        const bool odd = layer & 1; const int eo = layer >> 1;
        for (int rep = 0; rep < DUPN(5); ++rep) {
            TS0(); if (PH(2)) nm_phase(args, G, layer == 0 && rep == 0, layer > 0 && rep == 0, 0.5f, layer - 1, 8, true, asg(args.in[I_GF1]) + (size_t)layer * DM, layer, 0, wv, true, gx, grk); TS1(5);
            BARRIER2(5, true); }
        for (int rep = 0; rep < DUPN(1); ++rep) {
            TS0(); TSC0(); if (PH(3)) { pg8::SchedStd S{(const char*)(WSB + WS_H), (const char*)(wl + W_GU1), DM, DM, DM / 128, MTOT / 256, NGU / 256, (MTOT / 256) * (NGU / 256), G, obid(), (char*)(WSB + WS_ACT), DFF, 128, gx, grk};
              pg8::EpiGU8 E{(const float*)(WSB + WS_RSC), (const float*)(WSB + WS_CMAX) + (size_t)(layer * 2 + 0) * NGU}; pg8::gemm_phase<pg8::EpiGU8, pg8::SchedStd, G_ALIGN, G_SP2, true>(lds, S, E, wv); } TS1(1); TSC1();
            BARRIER2(1, true); }
        for (int rep = 0; rep < DUPN(2); ++rep) {
            TS0(); if (PH(4)) { q8act_phase(args, wv, gx, grk); BARRIER2(2, true);
              pg8::SchedSplit S{(const char*)(WSB + WS_ACT8), (const char*)(wl + W_DN1), KD8, KD8, KD8 / 128, 12, G, obid(), gx, grk};
              pg8::EpiResid8 E{asg(args.out), mods + ((size_t)layer * 3) * NMODV + 2 * DM, rep == 0 ? 0.5f : 0.0f, (float*)(WSB + WS_SLAB), (const float*)(WSB + WS_RSC2), (const float*)(WSB + WS_CMAX2) + (size_t)(layer * 2 + 0) * DM};
              pg8::gemm_phase<pg8::EpiResid8, pg8::SchedSplit, G_ALIGN, G_SP2, true>(lds, S, E, wv); } TS1(2);
            BARRIER2(2, true); }
        for (int rep = 0; rep < DUPN(5); ++rep) {
            TS0(); if (PH(5)) nm_phase(args, G, false, rep == 0, 0.5f, layer, 2, true, asg(args.in[I_GMIX]) + (size_t)layer * DM, layer, 3, wv, false, gx, grk); TS1(5);
            BARRIER2(5, true); }
        for (int rep = 0; rep < DUPN(3); ++rep) {
            TS0(); if (PH(6)) { const int nin = odd ? NIN_O : NIN_E;
              pg8::SchedStd S{(const char*)(WSB + WS_H), (const char*)(wl + W_IN), DM * 2, DM * 2, DM / 64, MTOT / 256, nin / 256, (MTOT / 256) * (nin / 256), G, obid(), (char*)(WSB + WS_MIXIN), nin, 256, gx, grk};
              pg8::EpiBf16 E{1.0f};
              pg8::gemm_phase<pg8::EpiBf16, pg8::SchedStd, G_ALIGN, G_SP2>(lds, S, E, wv); } TS1(3);
            BARRIER2(3, odd); }
        if (!odd) {
            for (int rep = 0; rep < DUPN(6); ++rep) {
                TS0(); if (PH(7)) { pg8::SchedF1 S{(const char*)(WSB + WS_T256), (const char*)(WSB + WS_MIXIN), (char*)(WSB + WS_GT), (char*)(WSB + WS_GTS), 512, NIN_E * 2, G, obid()};
                  pg8::EpiBf16 E{1.0f};
                  pg8::gemm_phase<pg8::EpiBf16, pg8::SchedF1, G_ALIGN, G_SP2>(lds, S, E, wv); }
                vstat_phase(args, G, wv); TS1(6);
                BARRIER(6); }
            for (int rep = 0; rep < DUPN(7); ++rep) {
                TS0(); if (PH(9)) { pg8::SchedF2 S{(const char*)(WSB + WS_CS256), (const char*)(WSB + WS_CS1024), (const char*)(WSB + WS_GT), (const char*)(WSB + WS_GTS), (char*)(WSB + WS_MIXOUT), 4096, 4096, G, obid()};
                  pg8::EpiF2 E2;
                  pg8::gemm_phase<pg8::EpiF2, pg8::SchedF2, G_ALIGN, G_SP2>(lds, S, E2, wv); }
                if (PH(8)) sgu_phase(args, lds, G, eo, wv); TS1(7);
                }
        } else {
            for (int rep = 0; rep < DUPN(8); ++rep) { TS0(); if (PH(10)) prep_phase(args, G, eo, wv, gx, grk); TS1(8); BARRIER(8); }
            for (int rep = 0; rep < DUPN(9); ++rep) { TS0(); if (PH(11)) attn_phase(args, lds, G, eo, wv); TS1(9); }
        }
        if (layer < 3) { while (fill_round(args, lds, layer + 1, wv)) {} if (ql <= layer + 1) ql = layer + 2; }
        BARRIER(9);
        for (int rep = 0; rep < DUPN(4); ++rep) {
            TS0(); if (PH(12)) { pg8::SchedSplit S{(const char*)(WSB + WS_MIXOUT), (const char*)(wl + W_OUT), DM * 2, DM * 2, DM / 64, 8, G, obid(), gx, grk};
              pg8::EpiResid E{asg(args.out), mods + ((size_t)layer * 3) * NMODV + 5 * DM, rep == 0 ? 1.0f : 0.0f, (float*)(WSB + WS_SLAB)};
              pg8::gemm_phase<pg8::EpiResid, pg8::SchedSplit, G_ALIGN, G_SP2>(lds, S, E, wv); } TS1(4);
            BARRIER2(4, true); }
        for (int rep = 0; rep < DUPN(5); ++rep) {
            TS0(); if (PH(13)) nm_phase(args, G, false, rep == 0, 1.0f, layer, 5, true, asg(args.in[I_GF2]) + (size_t)layer * DM, layer, 6, wv, true, gx, grk); TS1(5);
            BARRIER2(5, true); }
        for (int rep = 0; rep < DUPN(1); ++rep) {
            TS0(); TSC0(); if (PH(14)) { pg8::SchedStd S{(const char*)(WSB + WS_H), (const char*)(wl + W_GU2), DM, DM, DM / 128, MTOT / 256, NGU / 256, (MTOT / 256) * (NGU / 256), G, obid(), (char*)(WSB + WS_ACT), DFF, 128, gx, grk};
              pg8::EpiGU8 E{(const float*)(WSB + WS_RSC), (const float*)(WSB + WS_CMAX) + (size_t)(layer * 2 + 1) * NGU}; pg8::gemm_phase<pg8::EpiGU8, pg8::SchedStd, G_ALIGN, G_SP2, true>(lds, S, E, wv); } TS1(1); TSC1();
            BARRIER2(1, true); }
        for (int rep = 0; rep < DUPN(2); ++rep) {
            TS0(); if (PH(15)) { q8act_phase(args, wv, gx, grk); BARRIER2(2, true);
              pg8::SchedSplit S{(const char*)(WSB + WS_ACT8), (const char*)(wl + W_DN2), KD8, KD8, KD8 / 128, 12, G, obid(), gx, grk};
              pg8::EpiResid8 E{asg(args.out), mods + ((size_t)layer * 3) * NMODV + 8 * DM, rep == 0 ? 0.5f : 0.0f, (float*)(WSB + WS_SLAB), (const float*)(WSB + WS_RSC2), (const float*)(WSB + WS_CMAX2) + (size_t)(layer * 2 + 1) * DM};
              pg8::gemm_phase<pg8::EpiResid8, pg8::SchedSplit, G_ALIGN, G_SP2, true>(lds, S, E, wv); } TS1(2);
            BARRIER2(2, true); }
    }
    TS0(); if (PH(16)) nm_phase(args, G, false, true, 0.5f, 3, 8, false, nullptr, 0, 0, wv, false, gx, grk); TS1(11);
    if (ts_on) { const unsigned long long te_ = __builtin_amdgcn_s_memrealtime() + (unsigned long long)TSMULT * TSACC[0]; while (__builtin_amdgcn_s_memrealtime() < te_) __builtin_amdgcn_s_sleep(8); }
#undef BARRIER
}

extern "C" void kernel_launch(void* const* d_in, const int* in_sizes, int n_in, void* d_out, int out_size, void* d_ws, size_t ws_size, hipStream_t stream) {
    static int grid = 0;
    if (grid == 0) {
        if (n_in != 29 || (size_t)out_size != O_END || ws_size < WS_END) {
            fprintf(stderr, "kernel_launch: unexpected shapes: n_in %d out %d ws %zu (need %zu)\n", n_in, out_size, ws_size, (size_t)WS_END); grid = -1; return; }
        int dev = 0, cus = 0, per_cu = 0;
        if (hipGetDevice(&dev) != hipSuccess || hipDeviceGetAttribute(&cus, hipDeviceAttributeMultiprocessorCount, dev) != hipSuccess) { grid = -1; return; }
        if (hipFuncSetAttribute((const void*)mega_fwd, hipFuncAttributeMaxDynamicSharedMemorySize, LDS_BYTES) != hipSuccess) { fprintf(stderr, "kernel_launch: hipFuncSetAttribute failed\n"); grid = -1; return; }
        if (hipOccupancyMaxActiveBlocksPerMultiprocessor(&per_cu, (const void*)mega_fwd, NTHR, LDS_BYTES) != hipSuccess || per_cu < 1)
            fprintf(stderr, "kernel_launch: occupancy query reports %d\n", per_cu);
        (void)hipGetLastError();
        if (cus != 256) { fprintf(stderr, "kernel_launch: built for a 256-CU device (8 groups of 32 workgroups), found %d CUs; nothing launched\n", cus); grid = -1; return; }
        grid = cus;
    }
    if (grid < 0) return;
    if (hipMemsetAsync((char*)d_ws + WS_CTL, 0, CTL_ZERO_BYTES, stream) != hipSuccess) { fprintf(stderr, "kernel_launch: memset failed\n"); return; }
    Args a{};
    for (int i = 0; i < 29; ++i) a.in[i] = (const float*)d_in[i];
    a.out = (float*)d_out; a.ws = (unsigned char*)d_ws;
    hipLaunchKernelGGL(mega_fwd, dim3(grid), dim3(NTHR), LDS_BYTES, stream, a);
    const hipError_t le = hipPeekAtLastError();
    if (le != hipSuccess) fprintf(stderr, "kernel_launch: launch failed: %s\n", hipGetErrorName(le));
}
```

```cpp
#include <hip/hip_runtime.h>
#include <cstdio>
#include <cstdint>

#define LAS __attribute__((address_space(3)))
#define GAS __attribute__((address_space(1)))
typedef unsigned short bf16_t;
typedef short bf16x8 __attribute__((ext_vector_type(8)));
typedef short s16x4 __attribute__((ext_vector_type(4)));
typedef float f32x2 __attribute__((ext_vector_type(2)));
typedef float f32x4 __attribute__((ext_vector_type(4)));
typedef float f32x8 __attribute__((ext_vector_type(8)));
typedef float f32x16 __attribute__((ext_vector_type(16)));
typedef unsigned u32x2 __attribute__((ext_vector_type(2)));
typedef unsigned u32x4 __attribute__((ext_vector_type(4)));
typedef int i32x4 __attribute__((ext_vector_type(4)));

#ifndef TSMASK
#define TSMASK 0
#endif
#ifndef TSBAR
#define TSBAR 0
#endif
constexpr int DM = 2048, MP = 8192, MS = 2048, MTOT = 10240, DFF = 5504, NGU = 11008, NIN_E = 3072, NIN_O = 4608, NMODV = 18432;
constexpr float EPS = 1e-6f;
constexpr int NWAVES = 8, NTHR = 512;
#ifndef G_ALIGN
#define G_ALIGN true
#endif
#ifndef G_SP2
#define G_SP2 true
#endif

constexpr size_t MiB = 1u << 20;
constexpr size_t WS_CTL = 0, CTL_ZERO_BYTES = 1024 * 1024;
constexpr size_t WS_CMAX = 512 * 1024;
constexpr size_t WS_MODS = 1 * MiB;
constexpr size_t WS_ADAP = 2 * MiB;
constexpr size_t WS_SSQ_OLD = 6 * MiB;
constexpr size_t WS_RSC = 6 * MiB + 704 * 1024;
constexpr size_t WS_RSC2 = 6 * MiB + 768 * 1024;
constexpr size_t WS_CMAX2 = 6 * MiB + 832 * 1024;
constexpr size_t WS_T256 = 7 * MiB;
constexpr size_t WS_ROPE = WS_T256 + 262144;
constexpr size_t WS_WSGU = 8 * MiB;
constexpr size_t WS_CS1024 = 9 * MiB;
constexpr size_t WS_CS256 = 23 * MiB;
constexpr size_t WS_CCK = 13 * MiB;
constexpr size_t WS_CCV = 14 * MiB, WS_CDK = 15 * MiB, WS_CDV = 19 * MiB;
constexpr size_t WS_H = 24 * MiB;
constexpr size_t WS_ACT = 64 * MiB;
constexpr size_t WS_MIXIN = 172 * MiB;
constexpr size_t WS_MIXOUT = 262 * MiB;
constexpr size_t WS_SLAB = 302 * MiB;
constexpr size_t WS_GT = 366 * MiB;
constexpr size_t WS_GTS = WS_GT + 128 * MiB;
constexpr size_t WS_QKV = 366 * MiB;
constexpr size_t WS_W = 502 * MiB;
constexpr size_t W_GU1 = 0, W_DN1 = (size_t)NGU * DM, W_GU2 = W_DN1 + (size_t)DM * DFF, W_DN2 = W_GU2 + (size_t)NGU * DM, W_OUT = W_DN2 + (size_t)DM * DFF,
                 W_IN = W_OUT + (size_t)DM * DM, W_LAYER = W_IN + (size_t)NIN_O * DM;
constexpr size_t WS_ACT8 = WS_W + 4 * W_LAYER * 2;
constexpr int KD8 = 5632;
constexpr size_t WS_SSQ = WS_ACT8 + (size_t)MTOT * KD8;
constexpr size_t WS_XB = (WS_SSQ + (size_t)MTOT * 4 + 4095) & ~(size_t)4095;
constexpr size_t WS_END = WS_XB + (size_t)MTOT * DM * 2;
constexpr size_t Q_QCP = 0, Q_KCP = Q_QCP + (size_t)MP * 1024, Q_VCP = Q_KCP + (size_t)MP * 256, Q_QDP = Q_VCP + (size_t)MP * 256, Q_KDP = Q_QDP + (size_t)MP * 1024,
                 Q_VDP = Q_KDP + (size_t)MP * 1024, Q_QCS = Q_VDP + (size_t)MP * 1024, Q_KCS = Q_QCS + (size_t)MS * 1024, Q_VCS = Q_KCS + (size_t)MS * 256,
                 Q_QDS = Q_VCS + (size_t)MS * 256, Q_KDS = Q_QDS + (size_t)MS * 1024, Q_VDS = Q_KDS + (size_t)MS * 1024, Q_END = Q_VDS + (size_t)MS * 1024;
static_assert(WS_QKV + Q_END * 2 <= WS_W, "qkv region");
constexpr size_t O_YP = 0, O_YS = (size_t)MP * DM, O_SCK = O_YS + (size_t)MS * DM, O_SCV = O_SCK + (size_t)32 * 2 * 2 * 256 * 128, O_SDK = O_SCV + (size_t)32 * 2 * 2 * 256 * 128,
                 O_SDV = O_SDK + (size_t)32 * 2 * 8 * 256 * 128, O_END = O_SDV + (size_t)32 * 2 * 8 * 256 * 128;

constexpr int LDS_BYTES = 147456;
constexpr int LDS_MISC = 135168;

#define LDS_WAIT() asm volatile("s_waitcnt lgkmcnt(0)" ::: "memory")
#define VM_WAIT() asm volatile("s_waitcnt vmcnt(0)" ::: "memory")
__device__ __forceinline__ unsigned f2bf(float f) { unsigned u = __builtin_bit_cast(unsigned, f); return (u + 0x7fffu + ((u >> 16) & 1u)) >> 16; }
__device__ __forceinline__ unsigned pk2(float lo, float hi) { return f2bf(lo) | (f2bf(hi) << 16); }
__device__ __forceinline__ unsigned cvt_pk_bf16(float lo, float hi) { unsigned r; asm volatile("v_cvt_pk_bf16_f32 %0, %1, %2" : "=v"(r) : "v"(lo), "v"(hi)); return r; }
typedef __bf16 bf16x2_t __attribute__((ext_vector_type(2)));
__device__ __forceinline__ unsigned cvt_pk_bf16_b(float lo, float hi) { f32x2 v = {lo, hi}; bf16x2_t b = __builtin_convertvector(v, bf16x2_t); return __builtin_bit_cast(unsigned, b); }
__device__ __forceinline__ float bf_lo(unsigned w) { return __uint_as_float(w << 16); }
__device__ __forceinline__ float bf_hi(unsigned w) { return __uint_as_float(w & 0xffff0000u); }
__device__ __forceinline__ int ptid(int wv) { unsigned z = 0u; asm volatile("" : "+v"(z)); int t = wv * 64 + (int)__builtin_amdgcn_mbcnt_hi(~0u, __builtin_amdgcn_mbcnt_lo(~0u, z)); asm volatile("" : "+v"(t)); return t; }
template <class T> __device__ __forceinline__ T* asg(T* p) { const unsigned long long v = (unsigned long long)p; return (T*)(__attribute__((address_space(1))) T*)v; }
__device__ __forceinline__ unsigned char* ws_opaque(unsigned char* p) { unsigned long long v = (unsigned long long)p; asm volatile("" : "+s"(v)); return (unsigned char*)(__attribute__((address_space(1))) unsigned char*)v; }
__device__ __forceinline__ int obid() { int b = (int)blockIdx.x; asm volatile("" : "+s"(b)); return b; }
template <int M> __device__ __forceinline__ float sx(float v) { return __int_as_float(__builtin_amdgcn_ds_swizzle(__float_as_int(v), (M << 10) | 0x1f)); }
__device__ __forceinline__ float sum32(float v) { auto rr = __builtin_amdgcn_permlane32_swap(__float_as_uint(v), __float_as_uint(v), false, false); return __uint_as_float(rr[0]) + __uint_as_float(rr[1]); }
__device__ __forceinline__ float max32(float v) { auto rr = __builtin_amdgcn_permlane32_swap(__float_as_uint(v), __float_as_uint(v), false, false); return fmaxf(__uint_as_float(rr[0]), __uint_as_float(rr[1])); }
__device__ __forceinline__ float wave_sum(float v) { v += sx<1>(v); v += sx<2>(v); v += sx<4>(v); v += sx<8>(v); v += sx<16>(v); return sum32(v); }
__device__ __forceinline__ float wave_max(float v) { v = fmaxf(v, sx<1>(v)); v = fmaxf(v, sx<2>(v)); v = fmaxf(v, sx<4>(v)); v = fmaxf(v, sx<8>(v)); v = fmaxf(v, sx<16>(v)); return max32(v); }

#define XB_TMO      128
#define XB_XCNT(j)  (256  + 64 * (j))
#define XB_XSUB(j)  (1280 + 64 * (j))
#define XB_XGEN(j)  (2304 + 64 * (j))
#define XB_TOP      3328
#define XB_TOPGEN   3392
#define XCD_BAR_WORDS 3456
#define XB_SPIN_CAP (1u << 18)
__device__ __forceinline__ unsigned xb_ld(unsigned* p)              { return __hip_atomic_load(p, __ATOMIC_RELAXED, __HIP_MEMORY_SCOPE_AGENT); }
__device__ __forceinline__ unsigned xb_add(unsigned* p, unsigned v) { return __hip_atomic_fetch_add(p, v, __ATOMIC_RELAXED, __HIP_MEMORY_SCOPE_AGENT); }
__device__ __forceinline__ unsigned xb_xcc_id() { return (unsigned)__builtin_amdgcn_s_getreg((3 << 11) | 20) & 0xFu; }
#define XB_SPIN(cond, bar) do { unsigned _sp = 0; while (cond) { __builtin_amdgcn_s_sleep(1); \
    if ((++_sp & 255u) == 0u) { if (xb_ld(&(bar)[XB_TMO])) break; if (_sp > XB_SPIN_CAP) { atomicAdd(&(bar)[XB_TMO], 1u); break; } } } } while (0)
struct XcdBarrier { unsigned* bar; unsigned x; volatile LAS unsigned* st; };
__device__ __forceinline__ XcdBarrier xcd_barrier_post(unsigned* bar, volatile LAS unsigned* st, int tid) {
    XcdBarrier b; b.bar = bar; b.x = 0; b.st = st;
    if (tid == 0) { const unsigned xcc = xb_xcc_id(); st[2] = xb_add(&bar[XB_XCNT(xcc)], 1u); st[3] = xcc; }
    return b;
}
__device__ __forceinline__ void xcd_barrier_complete(unsigned* bar, unsigned x, unsigned& nloc, unsigned& nx) {
    const unsigned G = gridDim.x * gridDim.y * gridDim.z;
    unsigned sum, cnt, mine, sp = 0u;
    for (;;) {
        sum = 0u; cnt = 0u; mine = 0u;
#pragma unroll
        for (unsigned j = 0; j < 16; ++j) { const unsigned c = xb_ld(&bar[XB_XCNT(j)]); sum += c; cnt += (c > 0u) ? 1u : 0u; mine = (j == x) ? c : mine; }
        if (sum == G) break;
        __builtin_amdgcn_s_sleep(1);
        if ((++sp & 255u) == 0u) { if (xb_ld(&bar[XB_TMO])) break; if (sp > XB_SPIN_CAP) { atomicAdd(&bar[XB_TMO], 1u); break; } }
    }
    nloc = mine > 0u ? mine : 1u; nx = cnt > 0u ? cnt : 1u;
}
__device__ __forceinline__ void xcd_barrier(const XcdBarrier& b, int wv) {
    asm volatile("s_waitcnt vmcnt(0)" ::: "memory");
    __syncthreads();
    if (ptid(wv) == 0) {
        unsigned* bar = b.bar; const unsigned bx = xb_xcc_id();
        __builtin_amdgcn_s_waitcnt(0);
        unsigned nloc = b.st[0], nx = b.st[1];
        if (nloc == 0u) { xcd_barrier_complete(bar, bx, nloc, nx); b.st[0] = nloc; b.st[1] = nx; }
        const unsigned old = xb_add(&bar[XB_XSUB(bx)], 1u);
        const unsigned gen = old / nloc;
        if (old + 1u == (gen + 1u) * nloc) {
            __builtin_amdgcn_fence(__ATOMIC_RELEASE, "agent");
            asm volatile("s_waitcnt vmcnt(0)" ::: "memory");
            const unsigned og = xb_add(&bar[XB_TOP], 1u);
            const unsigned tg = og / nx;
            if (og + 1u == (tg + 1u) * nx) xb_add(&bar[XB_TOPGEN], 1u);
            else XB_SPIN(xb_ld(&bar[XB_TOPGEN]) == tg, bar);
            __builtin_amdgcn_fence(__ATOMIC_ACQUIRE, "agent");
            xb_add(&bar[XB_XGEN(bx)], 1u);
            asm volatile("s_waitcnt vmcnt(0)" ::: "memory");
        } else {
            XB_SPIN(xb_ld(&bar[XB_XGEN(bx)]) == gen, bar);
            __builtin_amdgcn_fence(__ATOMIC_ACQUIRE, "agent");
            asm volatile("s_waitcnt vmcnt(0)" ::: "memory");
        }
    }
    __syncthreads();
}

__device__ __forceinline__ void local_barrier(unsigned* bar, unsigned* lb, unsigned gsize, int wv) {
    asm volatile("s_waitcnt vmcnt(0)" ::: "memory");
    __syncthreads();
    if (ptid(wv) == 0) {
        __builtin_amdgcn_s_waitcnt(0);
        const unsigned old = xb_add(lb, 1u), target = (old / gsize + 1u) * gsize;
        XB_SPIN(xb_ld(lb) < target, bar);
        __builtin_amdgcn_fence(__ATOMIC_ACQUIRE, "agent");
        asm volatile("s_waitcnt vmcnt(0)" ::: "memory");
    }
    __syncthreads();
}

namespace pg8 {
constexpr int BM = 256, BK = 64, HALF = 128, HTB = HALF * BK * 2, STAGE_BYTES = 8 * HTB;
__device__ __forceinline__ int lds_byte(int r, int c) { const int st = (r >> 4) * 2 + (c >> 5), rr = r & 15, cc = c & 31, ob = rr * 64 + cc * 2; return st * 1024 + (ob ^ (((ob >> 9) & 1) << 5)); }
__device__ __forceinline__ void stage_rc(int b, int& R, int& C) { const int st = b / 1024, sb = b % 1024, swz = sb ^ (((sb >> 9) & 1) << 5); R = (st >> 1) * 16 + swz / 64; C = (st & 1) * 32 + (swz % 64) / 2; }
__device__ __forceinline__ int perm32(int rho) { const int n = rho >> 4, i = rho & 15; return 8 * (i >> 2) + 4 * n + (i & 3); }

struct GUnit { const char* a; const char* b; int nt; int pm, pn, ks; };

template <bool I8> struct AccT { typedef f32x4 T; };
template <> struct AccT<true> { typedef i32x4 T; };
template <class Epi, class Sched, bool ALIGN_EPI, bool SP2, bool I8 = false>
__device__ __forceinline__ void gemm_phase(LAS unsigned char* lds, const Sched& S, const Epi& E, int wv) {
    const int tid = ptid(wv);
    const int wid = wv, lane = tid & 63, wr = wid >> 2, wc = wid & 3, fr = lane & 15, fq = lane >> 4;
    unsigned cvA0, cvA1, cvB0, cvB1;
    { int R0, C0, R1, C1; stage_rc(tid * 16, R0, C0); stage_rc(tid * 16 + 8192, R1, C1);
      const int Rb0 = Epi::PERM ? ((R0 & ~31) + perm32(R0 & 31)) : R0, Rb1 = Epi::PERM ? ((R1 & ~31) + perm32(R1 & 31)) : R1;
      cvA0 = (unsigned)(R0 * S.lda2 + C0 * 2); cvA1 = (unsigned)(R1 * S.lda2 + C1 * 2); cvB0 = (unsigned)(Rb0 * S.ldb2 + C0 * 2); cvB1 = (unsigned)(Rb1 * S.ldb2 + C1 * 2); }
    const unsigned ldsw = (unsigned)wid * 1024u;
    const int aoff = lds_byte(wr * 64 + fr, fq * 8), boff = lds_byte(wc * 32 + fr, fq * 8);
#define PG8_SA(b, h) (((b) * 2 + (h)) * HTB)
#define PG8_SB(b, h) ((4 + (b) * 2 + (h)) * HTB)
#define PG8_STAGE(bufoff, gbase, v0, v1) do { \
        __builtin_amdgcn_global_load_lds((const unsigned*)((const char*)(gbase) + (v0)), (LAS unsigned*)(lds + (bufoff) + ldsw), 16, 0, 0); \
        __builtin_amdgcn_global_load_lds((const unsigned*)((const char*)(gbase) + (v1)), (LAS unsigned*)(lds + (bufoff) + ldsw + 8192), 16, 0, 0); } while (0)
#define PG8_LDA(dst, b, h) do { _Pragma("unroll") for (int m = 0; m < 4; ++m) _Pragma("unroll") for (int k = 0; k < 2; ++k) dst[m][k] = *(const LAS bf16x8*)(lds + PG8_SA(b, h) + aoff + m * 2048 + k * 1024); } while (0)
#define PG8_LDB(dst, b, h) do { _Pragma("unroll") for (int n = 0; n < 2; ++n) _Pragma("unroll") for (int k = 0; k < 2; ++k) dst[n][k] = *(const LAS bf16x8*)(lds + PG8_SB(b, h) + boff + n * 2048 + k * 1024); } while (0)
#define PG8_MMA(ai, bj, At, Bt) do { __builtin_amdgcn_s_setprio(1); _Pragma("unroll") for (int m = 0; m < 4; ++m) _Pragma("unroll") for (int n = 0; n < 2; ++n) _Pragma("unroll") for (int k = 0; k < 2; ++k) { \
        if constexpr (I8) acc[ai][bj][m][n] = __builtin_amdgcn_mfma_i32_16x16x64_i8(__builtin_bit_cast(i32x4, Bt[n][k]), __builtin_bit_cast(i32x4, At[m][k]), acc[ai][bj][m][n], 0, 0, 0); \
        else acc[ai][bj][m][n] = __builtin_amdgcn_mfma_f32_16x16x32_bf16(Bt[n][k], At[m][k], acc[ai][bj][m][n], 0, 0, 0); } __builtin_amdgcn_s_setprio(0); } while (0)
#define PG8_WAIT_V(n) asm volatile("s_waitcnt vmcnt(" #n ")" ::: "memory")
#define PG8_WAIT_L(n) asm volatile("s_waitcnt lgkmcnt(" #n ")" ::: "memory")
#define PG8_BAR __builtin_amdgcn_s_barrier()
#define PG8_SCHED __builtin_amdgcn_sched_barrier(0)
    GUnit cur, nxt; int ui = 0;
    if (!S.next(0, cur)) return;
    typedef typename AccT<I8>::T acc_t;
    acc_t acc[2][2][4][2];
    acc_t zz = (acc_t){0, 0, 0, 0}; asm volatile("" : "+v"(zz));
#pragma unroll
    for (int a = 0; a < 2; ++a)
#pragma unroll
        for (int b = 0; b < 2; ++b)
#pragma unroll
            for (int m = 0; m < 4; ++m)
#pragma unroll
                for (int n = 0; n < 2; ++n) acc[a][b][m][n] = zz;
    bf16x8 At[4][2], B0[2][2], B1[2][2];
    const size_t chA = (size_t)HALF * S.lda2, chB = (size_t)HALF * S.ldb2;
    const size_t kstep = (size_t)(BK * 2);
    const char* cA = cur.a; const char* cB = cur.b;
    if constexpr (SP2) {
        PG8_STAGE(PG8_SB(0, 0), cB, cvB0, cvB1); PG8_STAGE(PG8_SB(0, 1), cB + chB, cvB0, cvB1); PG8_STAGE(PG8_SA(0, 0), cA, cvA0, cvA1); PG8_STAGE(PG8_SA(0, 1), cA + chA, cvA0, cvA1);
        if (wr == 1) PG8_BAR;
        PG8_WAIT_V(2); PG8_BAR;
        PG8_STAGE(PG8_SB(1, 0), cB + kstep, cvB0, cvB1); PG8_STAGE(PG8_SA(1, 0), cA + kstep, cvA0, cvA1); PG8_STAGE(PG8_SB(1, 1), cB + chB + kstep, cvB0, cvB1);
        PG8_WAIT_V(6); PG8_BAR;
    } else {
        PG8_STAGE(PG8_SB(0, 0), cB, cvB0, cvB1); PG8_STAGE(PG8_SA(0, 0), cA, cvA0, cvA1); PG8_STAGE(PG8_SB(0, 1), cB + chB, cvB0, cvB1); PG8_STAGE(PG8_SA(0, 1), cA + chA, cvA0, cvA1);
        if (wr == 1) PG8_BAR;
        PG8_WAIT_V(4); PG8_BAR;
        PG8_STAGE(PG8_SB(1, 0), cB + kstep, cvB0, cvB1); PG8_STAGE(PG8_SA(1, 0), cA + kstep, cvA0, cvA1); PG8_STAGE(PG8_SB(1, 1), cB + chB + kstep, cvB0, cvB1);
        PG8_WAIT_V(6); PG8_BAR;
    }
    for (;;) {
        const bool has_next = S.next(ui + 1, nxt);
        const char* nA = has_next ? nxt.a : cA; const char* nB = has_next ? nxt.b : cB;
        int nt = cur.nt; asm volatile("" : "+s"(nt));
        for (int t = 0; t < nt; t += 2) {
            const bool last = (t == nt - 2);
            const char* a1 = cA + (size_t)(t + 1) * kstep;
            const char* a2 = last ? nA : cA + (size_t)(t + 2) * kstep; const char* b2 = last ? nB : cB + (size_t)(t + 2) * kstep;
            const char* a3 = a2 + kstep; const char* b3 = b2 + kstep;
            if constexpr (SP2) {
            PG8_LDB(B0, 0, 0); PG8_LDB(B1, 0, 1); PG8_SCHED; PG8_LDA(At, 0, 0); PG8_STAGE(PG8_SA(1, 1), a1 + chA, cvA0, cvA1);
            PG8_WAIT_V(8); PG8_WAIT_L(0); PG8_BAR; PG8_MMA(0, 0, At, B0); PG8_MMA(0, 1, At, B1); PG8_BAR; PG8_SCHED;
            PG8_LDA(At, 0, 1); PG8_STAGE(PG8_SB(0, 0), b2, cvB0, cvB1); PG8_STAGE(PG8_SB(0, 1), b2 + chB, cvB0, cvB1); PG8_STAGE(PG8_SA(0, 0), a2, cvA0, cvA1);
            PG8_WAIT_V(8); PG8_WAIT_L(0); PG8_BAR; PG8_MMA(1, 0, At, B0); PG8_MMA(1, 1, At, B1); PG8_BAR; PG8_SCHED;
            PG8_LDB(B0, 1, 0); PG8_LDB(B1, 1, 1); PG8_SCHED; PG8_LDA(At, 1, 0); PG8_STAGE(PG8_SA(0, 1), a2 + chA, cvA0, cvA1);
            PG8_WAIT_V(8); PG8_WAIT_L(0); PG8_BAR; PG8_MMA(0, 0, At, B0); PG8_MMA(0, 1, At, B1); PG8_BAR; PG8_SCHED;
            PG8_LDA(At, 1, 1); PG8_STAGE(PG8_SB(1, 0), b3, cvB0, cvB1); PG8_STAGE(PG8_SB(1, 1), b3 + chB, cvB0, cvB1); PG8_STAGE(PG8_SA(1, 0), a3, cvA0, cvA1);
            PG8_WAIT_V(8); PG8_WAIT_L(0); PG8_BAR; PG8_MMA(1, 0, At, B0); PG8_MMA(1, 1, At, B1); PG8_BAR; PG8_SCHED;
            } else {
            PG8_LDB(B0, 0, 0); PG8_SCHED; PG8_LDA(At, 0, 0); PG8_STAGE(PG8_SA(1, 1), a1 + chA, cvA0, cvA1);
            PG8_WAIT_L(8); PG8_BAR; PG8_WAIT_L(0); PG8_MMA(0, 0, At, B0); PG8_BAR; PG8_SCHED;
            PG8_LDB(B1, 0, 1); PG8_STAGE(PG8_SB(0, 0), b2, cvB0, cvB1);
            PG8_BAR; PG8_WAIT_L(0); PG8_MMA(0, 1, At, B1); PG8_BAR;
            PG8_LDA(At, 0, 1); PG8_STAGE(PG8_SA(0, 0), a2, cvA0, cvA1);
            PG8_BAR; PG8_WAIT_L(0); PG8_MMA(1, 0, At, B0); PG8_BAR; PG8_SCHED;
            PG8_STAGE(PG8_SB(0, 1), b2 + chB, cvB0, cvB1);
            PG8_WAIT_V(6); PG8_BAR; PG8_MMA(1, 1, At, B1); PG8_BAR;
            PG8_LDB(B0, 1, 0); PG8_SCHED; PG8_LDA(At, 1, 0); PG8_STAGE(PG8_SA(0, 1), a2 + chA, cvA0, cvA1);
            PG8_WAIT_L(8); PG8_BAR; PG8_WAIT_L(0); PG8_MMA(0, 0, At, B0); PG8_BAR; PG8_SCHED;
            PG8_LDB(B1, 1, 1); PG8_STAGE(PG8_SB(1, 0), b3, cvB0, cvB1);
            PG8_BAR; PG8_WAIT_L(0); PG8_MMA(0, 1, At, B1); PG8_BAR;
            PG8_LDA(At, 1, 1); PG8_STAGE(PG8_SA(1, 0), a3, cvA0, cvA1);
            PG8_BAR; PG8_WAIT_L(0); PG8_MMA(1, 0, At, B0); PG8_BAR; PG8_SCHED;
            PG8_STAGE(PG8_SB(1, 1), b3 + chB, cvB0, cvB1);
            PG8_WAIT_V(6); PG8_BAR; PG8_MMA(1, 1, At, B1); PG8_BAR;
            }
        }
        unsigned long long te0_ = 0; const bool tse_ = ((TSMASK >> 12) & 1) && blockIdx.x == 0 && wv == 0;
        if (tse_) te0_ = __builtin_amdgcn_s_memrealtime();
        if constexpr (ALIGN_EPI) { if (wr == 0) PG8_BAR; }
        E(acc, cur, S, wr, wc, fr, fq);
        if (tse_) { volatile LAS unsigned* ta_ = (volatile LAS unsigned*)(lds + 135168 + 8); ta_[0] += (unsigned)(__builtin_amdgcn_s_memrealtime() - te0_); }
        if (!has_next) break;
        acc_t z2 = (acc_t){0, 0, 0, 0}; asm volatile("" : "+v"(z2));
#pragma unroll
        for (int a = 0; a < 2; ++a)
#pragma unroll
            for (int b = 0; b < 2; ++b)
#pragma unroll
                for (int m = 0; m < 4; ++m)
#pragma unroll
                    for (int n = 0; n < 2; ++n) acc[a][b][m][n] = z2;
        cur = nxt; cA = nA; cB = nB; ++ui;
        if constexpr (ALIGN_EPI) { if (wr == 1) PG8_BAR; }
    }
    PG8_WAIT_V(0);
    if constexpr (!ALIGN_EPI) { if (wr == 0) PG8_BAR; }
    PG8_BAR;
#undef PG8_SA
#undef PG8_SB
#undef PG8_STAGE
#undef PG8_LDA
#undef PG8_LDB
#undef PG8_MMA
#undef PG8_WAIT_V
#undef PG8_WAIT_L
#undef PG8_BAR
#undef PG8_SCHED
}

struct SchedStd {
    const char* A; const char* Bt; int lda2, ldb2, nt; int nM, nN, nwg, G, c; char* O; int ldc, otile;
    int gx, grk;
    __device__ __forceinline__ bool next(int i, GUnit& u) const {
        if (G == 256) { const int uu = i * 32 + grk; if (uu >= 5 * nN) return false;
            const int pl = uu % 5; u.pm = pl < 4 ? 4 * gx + pl : 32 + gx; u.pn = uu / 5; u.ks = -1;
            u.a = A + (size_t)u.pm * 256 * lda2; u.b = Bt + (size_t)u.pn * 256 * ldb2; u.nt = nt; return true; }
        const long L = (long)i * G + c; if (L >= nwg) return false;
        int wgid = (int)L; { const int q = nwg / 8, r = nwg % 8, xcd = wgid % 8, off = wgid / 8; wgid = (xcd < r ? xcd * (q + 1) : r * (q + 1) + (xcd - r) * q) + off; }
        const int nig = 8 * nN, gid = wgid / nig, fm = gid * 8, gsz = (nM - fm) < 8 ? (nM - fm) : 8;
        u.pm = fm + ((wgid % nig) % gsz); u.pn = (wgid % nig) / gsz; u.ks = -1;
        u.a = A + (size_t)u.pm * 256 * lda2; u.b = Bt + (size_t)u.pn * 256 * ldb2; u.nt = nt;
        return true;
    }
    __device__ __forceinline__ void out(const GUnit& u, char*& o, int& ld) const { o = O + ((size_t)u.pm * 256 * ldc + (size_t)u.pn * otile) * 2; ld = ldc; }
};
struct SchedSplit {
    const char* A; const char* Bt; int lda2, ldb2, ntot, kq; int G, c; int gx, grk;
    __device__ __forceinline__ bool next(int i, GUnit& u) const {
        const int L = i * G + c; if (L >= 512) return false;
        const int Lr = L & 255; int x = Lr & 7, j = Lr >> 3, kt0 = 0;
        if (G == 256) { x = gx; j = grk; }
        if (L < 256) { u.pm = 4 * x + (j >> 3); u.pn = j & 7; u.ks = -1; u.nt = ntot; }
        else { u.pm = 32 + x; u.pn = j & 7; u.ks = j >> 3; kt0 = u.ks * kq; u.nt = (u.ks < 3) ? kq : ntot - 3 * kq; }
        u.a = A + (size_t)u.pm * 256 * lda2 + (size_t)kt0 * 128; u.b = Bt + (size_t)u.pn * 256 * ldb2 + (size_t)kt0 * 128;
        return true;
    }
};
struct SchedF1 {
    const char* T; const char* mixin; char* gtp; char* gts; int lda2, ldb2; int G, c;
    __device__ __forceinline__ bool next(int i, GUnit& u) const {
        const int L = i * G + c; if (L >= 320) return false;
        u.nt = 4; u.ks = L;
        if (L < 256) { const int bg = L >> 1, b = bg >> 2, g = bg & 3; u.pm = L & 1; u.pn = 0;
            u.b = mixin + ((size_t)(b * 256) * NIN_E + 2048 + g * 256) * 2; }
        else { const int l2 = L - 256, bg = l2 >> 3, b = bg >> 2, g = bg & 3; u.pm = (l2 >> 2) & 1; u.pn = l2 & 3;
            u.b = mixin + ((size_t)(MP + b * 1024 + u.pn * 256) * NIN_E + 2048 + g * 256) * 2; }
        u.a = T + (size_t)u.pm * 256 * 512;
        return true;
    }
    __device__ __forceinline__ void out(const GUnit& u, char*& o, int& ld) const { const int L = u.ks; ld = 2048;
        if (L < 256) o = gtp + ((size_t)(L >> 1) * 256 * 2048 + (size_t)u.pm * 256) * 2;
        else o = gts + ((size_t)((L - 256) >> 3) * 256 * 2048 + (size_t)u.pm * 1024 + u.pn * 256) * 2; }
};
struct SchedF2 {
    const char* cs256; const char* cs1024; const char* gtp; const char* gts; char* mixout; int lda2, ldb2; int G, c;
    __device__ __forceinline__ bool next(int i, GUnit& u) const {
        const int L = i * G + c; if (L >= 160) return false;
        u.ks = L; u.pn = 0;
        if (L < 32) { const int bg = L >> 2; u.pm = L & 3; u.nt = 32; u.a = cs1024 + (size_t)u.pm * 256 * 4096; u.b = gts + (size_t)bg * 256 * 2048 * 2; }
        else { const int bg = L - 32; u.pm = 0; u.nt = 8; u.a = cs256; u.b = gtp + (size_t)bg * 256 * 2048 * 2; }
        return true;
    }
    __device__ __forceinline__ void out(const GUnit& u, char*& o, int& ld) const { const int L = u.ks; ld = DM;
        if (L < 32) { const int bg = L >> 2, b = bg >> 2, g = bg & 3; o = mixout + ((size_t)(MP + b * 1024 + u.pm * 256) * DM + 1024 + g * 256) * 2; }
        else { const int bg = L - 32, b = bg >> 2, g = bg & 3; o = mixout + ((size_t)(b * 256) * DM + 1024 + g * 256) * 2; } }
};

struct EpiBf16 {
    static constexpr bool PERM = true;
    float scale;
    template <class Sched>
    __device__ __forceinline__ void operator()(const f32x4 (&acc)[2][2][4][2], const GUnit& u, const Sched& S, int wr, int wc, int fr, int fq) const {
        char* o; int ldc; S.out(u, o, ldc); bf16_t* T = (bf16_t*)o;
        const unsigned off0 = (unsigned)((wr * 64 + fr) * ldc + wc * 32 + 8 * fq);
#pragma unroll
        for (int ai = 0; ai < 2; ++ai)
#pragma unroll
            for (int m = 0; m < 4; ++m) { const unsigned off = off0 + (unsigned)((ai * HALF + m * 16) * ldc);
#pragma unroll
                for (int bj = 0; bj < 2; ++bj) { const f32x4 v0 = acc[ai][bj][m][0] * scale, v1 = acc[ai][bj][m][1] * scale;
                    u32x4 w; w.x = cvt_pk_bf16(v0[0], v0[1]); w.y = cvt_pk_bf16(v0[2], v0[3]); w.z = cvt_pk_bf16(v1[0], v1[1]); w.w = cvt_pk_bf16(v1[2], v1[3]);
                    *(u32x4*)(T + off + bj * HALF) = w; } }
    }
};
struct EpiF2 { static constexpr bool PERM = true;
    template <class Sched>
    __device__ __forceinline__ void operator()(const f32x4 (&acc)[2][2][4][2], const GUnit& u, const Sched& S, int wr, int wc, int fr, int fq) const {
        EpiBf16 e{u.nt == 32 ? 1.0f / 512.0f : 1.0f / 256.0f}; e(acc, u, S, wr, wc, fr, fq); } };
struct EpiGU {
    static constexpr bool PERM = true;
    template <class Sched>
    __device__ __forceinline__ void operator()(const f32x4 (&acc)[2][2][4][2], const GUnit& u, const Sched& S, int wr, int wc, int fr, int fq) const {
        char* o; int ldc; S.out(u, o, ldc); bf16_t* T = (bf16_t*)o;
        const unsigned off0 = (unsigned)((wr * 64 + fr) * ldc + wc * 32 + 8 * fq);
#pragma unroll
        for (int ai = 0; ai < 2; ++ai)
#pragma unroll
            for (int m = 0; m < 4; ++m) { const unsigned off = off0 + (unsigned)((ai * HALF + m * 16) * ldc); float t[8], r[8];
#pragma unroll
                for (int i = 0; i < 8; ++i) t[i] = acc[ai][0][m][i >> 2][i & 3] * -1.4426950408889634f;
#pragma unroll
                for (int i = 0; i < 8; ++i) t[i] = __builtin_amdgcn_exp2f(t[i]);
#pragma unroll
                for (int i = 0; i < 8; ++i) t[i] = t[i] + 1.0f;
#pragma unroll
                for (int i = 0; i < 8; ++i) t[i] = __builtin_amdgcn_rcpf(t[i]);
#pragma unroll
                for (int i = 0; i < 8; ++i) r[i] = (acc[ai][0][m][i >> 2][i & 3] * acc[ai][1][m][i >> 2][i & 3]) * t[i];
                asm volatile("" : "+v"(r[0]), "+v"(r[1]), "+v"(r[2]), "+v"(r[3]), "+v"(r[4]), "+v"(r[5]), "+v"(r[6]), "+v"(r[7]));
                u32x4 w; w.x = cvt_pk_bf16(r[0], r[1]); w.y = cvt_pk_bf16(r[2], r[3]); w.z = cvt_pk_bf16(r[4], r[5]); w.w = cvt_pk_bf16(r[6], r[7]);
                *(u32x4*)(T + off) = w; }
    }
};
struct EpiGU8 {
    static constexpr bool PERM = true;
    const float* rsc; const float* cmax;
    template <class Sched>
    __device__ __forceinline__ void operator()(const i32x4 (&acc)[2][2][4][2], const GUnit& u, const Sched& S, int wr, int wc, int fr, int fq) const {
        char* o; int ldc; S.out(u, o, ldc); bf16_t* T = (bf16_t*)o;
        const unsigned off0 = (unsigned)((wr * 64 + fr) * ldc + wc * 32 + 4 * fq);
        bf16x8 hf[2];
#pragma unroll
        for (int nt = 0; nt < 2; ++nt) { u32x4 hw;
#pragma unroll
            for (int p = 0; p < 4; ++p) { const unsigned s0 = __builtin_popcount((unsigned)((8 * fq + 2 * p) & (16 * nt + fr))) & 1u, s1 = __builtin_popcount((unsigned)((8 * fq + 2 * p + 1) & (16 * nt + fr))) & 1u;
                hw[p] = (s0 ? 0xbf80u : 0x3f80u) | ((s1 ? 0xbf80u : 0x3f80u) << 16); }
            hf[nt] = __builtin_bit_cast(bf16x8, hw); }
        const float* cp = cmax + u.pn * BM + wc * 32 + 8 * fq;
        f32x4 cs[2][2];
#pragma unroll
        for (int bj = 0; bj < 2; ++bj)
#pragma unroll
            for (int n = 0; n < 2; ++n) cs[bj][n] = *(const f32x4*)(cp + bj * HALF + 4 * n) * (1.0f / 127.0f);
        const float* rp = rsc + u.pm * BM + wr * 64 + fr;
#pragma unroll
        for (int ai = 0; ai < 2; ++ai)
#pragma unroll
            for (int m = 0; m < 4; ++m) { const unsigned off = off0 + (unsigned)((ai * HALF + m * 16) * ldc); float t[8], gg[8], r[8];
                const float rs = rp[ai * HALF + m * 16];
#pragma unroll
                for (int i = 0; i < 8; ++i) gg[i] = (float)acc[ai][0][m][i >> 2][i & 3] * (rs * cs[0][i >> 2][i & 3]);
#pragma unroll
                for (int i = 0; i < 8; ++i) t[i] = gg[i] * -1.4426950408889634f;
#pragma unroll
                for (int i = 0; i < 8; ++i) t[i] = __builtin_amdgcn_exp2f(t[i]);
#pragma unroll
                for (int i = 0; i < 8; ++i) t[i] = t[i] + 1.0f;
#pragma unroll
                for (int i = 0; i < 8; ++i) t[i] = __builtin_amdgcn_rcpf(t[i]);
#pragma unroll
                for (int i = 0; i < 8; ++i) r[i] = (gg[i] * ((float)acc[ai][1][m][i >> 2][i & 3] * (rs * cs[1][i >> 2][i & 3]))) * t[i];
                asm volatile("" : "+v"(r[0]), "+v"(r[1]), "+v"(r[2]), "+v"(r[3]), "+v"(r[4]), "+v"(r[5]), "+v"(r[6]), "+v"(r[7]));
                u32x4 w; w.x = cvt_pk_bf16_b(r[0], r[1]); w.y = cvt_pk_bf16_b(r[2], r[3]); w.z = cvt_pk_bf16_b(r[4], r[5]); w.w = cvt_pk_bf16_b(r[6], r[7]);
                const bf16x8 af = __builtin_bit_cast(bf16x8, w);
                float zf = 0.f; asm volatile("" : "+v"(zf));
                const f32x4 z4 = {zf, zf, zf, zf};
                const f32x4 h0 = __builtin_amdgcn_mfma_f32_16x16x32_bf16(hf[0], af, z4, 0, 0, 0), h1 = __builtin_amdgcn_mfma_f32_16x16x32_bf16(hf[1], af, z4, 0, 0, 0);
                u32x2 o0, o1; o0.x = cvt_pk_bf16_b(h0[0], h0[1]); o0.y = cvt_pk_bf16_b(h0[2], h0[3]); o1.x = cvt_pk_bf16_b(h1[0], h1[1]); o1.y = cvt_pk_bf16_b(h1[2], h1[3]);
                *(u32x2*)(T + off) = o0; *(u32x2*)(T + off + 16) = o1;
                __builtin_amdgcn_sched_barrier(0); }
    }
};
struct EpiResid8 {
    static constexpr bool PERM = false;
    bf16_t* x; const float* gate; float coef; float* slab; const float* rsc; const float* cmax; float* yout;
    template <class Sched>
    __device__ __forceinline__ void operator()(const i32x4 (&acc)[2][2][4][2], const GUnit& u, const Sched& S, int wr, int wc, int fr, int fq) const {
        const unsigned off0 = (unsigned)((wr * 64 + fr) * DM + wc * 32 + 4 * fq);
        const float* cp = cmax + u.pn * BM + wc * 32 + 4 * fq;
        const float* rp = rsc + u.pm * BM + wr * 64 + fr;
        float rsv[8];
#pragma unroll
        for (int i = 0; i < 8; ++i) rsv[i] = rp[(i >> 2) * HALF + (i & 3) * 16];
        f32x4 gv[2][2];
        if (u.ks < 0) { const float* gt = gate + u.pn * BM + wc * 32 + 4 * fq;
#pragma unroll
            for (int bj = 0; bj < 2; ++bj)
#pragma unroll
                for (int n = 0; n < 2; ++n) gv[bj][n] = (*(const f32x4*)(gt + bj * HALF + n * 16) * coef) * (*(const f32x4*)(cp + bj * HALF + n * 16) * (1.0f / 127.0f));
        } else {
#pragma unroll
            for (int bj = 0; bj < 2; ++bj)
#pragma unroll
                for (int n = 0; n < 2; ++n) gv[bj][n] = *(const f32x4*)(cp + bj * HALF + n * 16) * (1.0f / 127.0f);
        }
        asm volatile("" : "+v"(rsv[0]), "+v"(rsv[1]), "+v"(rsv[2]), "+v"(rsv[3]), "+v"(rsv[4]), "+v"(rsv[5]), "+v"(rsv[6]), "+v"(rsv[7]));
        if (u.ks < 0) {
            bf16_t* T = x + (size_t)u.pm * BM * DM + u.pn * BM; float* Y = yout ? yout + (size_t)u.pm * BM * DM + u.pn * BM : nullptr;
#pragma unroll
            for (int ai = 0; ai < 2; ++ai)
#pragma unroll
                for (int m = 0; m < 4; ++m) { const unsigned off = off0 + (unsigned)((ai * HALF + m * 16) * DM); const float rs = rsv[ai * 4 + m];
#pragma unroll
                    for (int bj = 0; bj < 2; ++bj)
#pragma unroll
                        for (int n = 0; n < 2; ++n) { u32x2* p = (u32x2*)(T + off + bj * HALF + n * 16); const i32x4 a = acc[ai][bj][m][n]; const u32x2 xo = *p;
                            const f32x4 af = {(float)a[0], (float)a[1], (float)a[2], (float)a[3]};
                            const f32x4 xn = (f32x4){bf_lo(xo.x), bf_hi(xo.x), bf_lo(xo.y), bf_hi(xo.y)} + (gv[bj][n] * rs) * af;
                            if (Y) *(f32x4*)(Y + off + bj * HALF + n * 16) = xn;
                            else { u32x2 w; w.x = cvt_pk_bf16(xn[0], xn[1]); w.y = cvt_pk_bf16(xn[2], xn[3]); *p = w; } }
                    if (m == 3) asm volatile("" ::: "memory"); }
        } else {
            bf16_t* T = (bf16_t*)slab + (size_t)u.ks * MS * DM + (size_t)(u.pm - 32) * BM * DM + u.pn * BM;
#pragma unroll
            for (int ai = 0; ai < 2; ++ai)
#pragma unroll
                for (int m = 0; m < 4; ++m) { const unsigned off = off0 + (unsigned)((ai * HALF + m * 16) * DM); const float rs = rsv[ai * 4 + m];
#pragma unroll
                    for (int bj = 0; bj < 2; ++bj)
#pragma unroll
                        for (int n = 0; n < 2; ++n) { const i32x4 a = acc[ai][bj][m][n]; const f32x4 v = (f32x4){(float)a[0], (float)a[1], (float)a[2], (float)a[3]} * (gv[bj][n] * rs);
                            u32x2 w; w.x = cvt_pk_bf16(v[0], v[1]); w.y = cvt_pk_bf16(v[2], v[3]); *(u32x2*)(T + off + bj * HALF + n * 16) = w; } }
        }
    }
};
struct EpiResid {
    static constexpr bool PERM = false;
    bf16_t* x; const float* gate; float coef; float* slab;
    template <class Sched>
    __device__ __forceinline__ void operator()(const f32x4 (&acc)[2][2][4][2], const GUnit& u, const Sched& S, int wr, int wc, int fr, int fq) const {
        const unsigned off0 = (unsigned)((wr * 64 + fr) * DM + wc * 32 + 4 * fq);
        if (u.ks < 0) {
            bf16_t* T = x + (size_t)u.pm * BM * DM + u.pn * BM; const float* gt = gate + u.pn * BM + wc * 32 + 4 * fq;
            f32x4 gv[2][2];
#pragma unroll
            for (int bj = 0; bj < 2; ++bj)
#pragma unroll
                for (int n = 0; n < 2; ++n) gv[bj][n] = *(const f32x4*)(gt + bj * HALF + n * 16) * coef;
#pragma unroll
            for (int ai = 0; ai < 2; ++ai)
#pragma unroll
                for (int m = 0; m < 4; ++m) { const unsigned off = off0 + (unsigned)((ai * HALF + m * 16) * DM);
#pragma unroll
                    for (int bj = 0; bj < 2; ++bj)
#pragma unroll
                        for (int n = 0; n < 2; ++n) { u32x2* p = (u32x2*)(T + off + bj * HALF + n * 16); const u32x2 xo = *p;
                            const f32x4 xn = (f32x4){bf_lo(xo.x), bf_hi(xo.x), bf_lo(xo.y), bf_hi(xo.y)} + gv[bj][n] * acc[ai][bj][m][n];
                            u32x2 w; w.x = cvt_pk_bf16(xn[0], xn[1]); w.y = cvt_pk_bf16(xn[2], xn[3]); *p = w; }
                    if (m == 3) asm volatile("" ::: "memory"); }
        } else {
            bf16_t* T = (bf16_t*)slab + (size_t)u.ks * MS * DM + (size_t)(u.pm - 32) * BM * DM + u.pn * BM;
#pragma unroll
            for (int ai = 0; ai < 2; ++ai)
#pragma unroll
                for (int m = 0; m < 4; ++m) { const unsigned off = off0 + (unsigned)((ai * HALF + m * 16) * DM);
#pragma unroll
                    for (int bj = 0; bj < 2; ++bj)
#pragma unroll
                        for (int n = 0; n < 2; ++n) { const f32x4 v = acc[ai][bj][m][n]; u32x2 w; w.x = cvt_pk_bf16(v[0], v[1]); w.y = cvt_pk_bf16(v[2], v[3]); *(u32x2*)(T + off + bj * HALF + n * 16) = w; } }
        }
    }
};
}

namespace att {
constexpr int D = 128, QBLK = 32, KVBLK = 64;
constexpr float SCALE = 0.088388347648318440f;
constexpr float THR = 8.f;
constexpr float NEG = -1e30f;
constexpr size_t SHM_V = KVBLK * D * 2, SHM_K = KVBLK * D * 2, SHM_ATTN = 2 * SHM_V + 2 * SHM_K + 8 * 64 * 4;
constexpr int RPB_OFF = (int)SHM_ATTN;
#define KSWZ(row, colB) ((row) * 256 + ((colB) ^ (((row) & 7) << 4)))
#define SBAR() __builtin_amdgcn_sched_barrier(0)
__device__ __forceinline__ int crow(int r, int hi) { return (r & 3) + 8 * (r >> 2) + 4 * hi; }

struct AUnit { const bf16_t* Q; bf16_t* O; const bf16_t* Kc; const bf16_t* Vc; const bf16_t* Kl; const bf16_t* Vl; int nctx, nloc, nt, mode, q0, kt0; float m0, l0; const float* rpb; };

__device__ __forceinline__ void partialSM(f32x16& p0, f32x16& p1, float& m_reg, float& mn, float& alpha) {
  constexpr float C = SCALE * 1.4426950408889634f;
  float pmax = p0[0];
#pragma unroll
  for (int r = 1; r < 16; ++r) pmax = fmaxf(pmax, p0[r]);
#pragma unroll
  for (int r = 0; r < 16; ++r) pmax = fmaxf(pmax, p1[r]);
  { auto rr = __builtin_amdgcn_permlane32_swap(__float_as_uint(pmax), __float_as_uint(pmax), false, false);
    pmax = fmaxf(__uint_as_float(rr[0]), __uint_as_float(rr[1])); }
  if (__builtin_expect(__all(pmax - m_reg <= THR / SCALE), 1)) { mn = m_reg; alpha = 1.f; }
  else { mn = fmaxf(m_reg, pmax); alpha = __builtin_amdgcn_exp2f((m_reg - mn) * C); m_reg = mn; }
  float mnC = -mn * C;
#pragma unroll
  for (int r = 0; r < 16; ++r) p0[r] = fmaf(p0[r], C, mnC);
#pragma unroll
  for (int r = 0; r < 16; ++r) p1[r] = fmaf(p1[r], C, mnC);
#pragma unroll
  for (int r = 0; r < 16; ++r) p0[r] = __builtin_amdgcn_exp2f(p0[r]);
}
__device__ __forceinline__ void finishSM(f32x16& p0, f32x16& p1, float alpha, float& l_reg, bf16x8& pa0, bf16x8& pa1, bf16x8& pa2, bf16x8& pa3) {
#pragma unroll
  for (int r = 0; r < 16; ++r) p1[r] = __builtin_amdgcn_exp2f(p1[r]);
  float ps = 0;
#pragma unroll
  for (int r = 0; r < 16; ++r) ps += p0[r];
#pragma unroll
  for (int r = 0; r < 16; ++r) ps += p1[r];
  { auto rr = __builtin_amdgcn_permlane32_swap(__float_as_uint(ps), __float_as_uint(ps), false, false);
    ps = __uint_as_float(rr[0]) + __uint_as_float(rr[1]); }
  l_reg = l_reg * alpha + ps;
#define PK4(P, BASE, OUT) do { unsigned a0 = cvt_pk_bf16(P[BASE + 0], P[BASE + 1]), a1 = cvt_pk_bf16(P[BASE + 2], P[BASE + 3]);   \
    unsigned b0 = cvt_pk_bf16(P[BASE + 4], P[BASE + 5]), b1 = cvt_pk_bf16(P[BASE + 6], P[BASE + 7]);                              \
    auto r0 = __builtin_amdgcn_permlane32_swap(a0, b0, false, false); auto r1 = __builtin_amdgcn_permlane32_swap(a1, b1, false, false); \
    u32x4 w = {r0[0], r1[0], r0[1], r1[1]}; OUT = *reinterpret_cast<bf16x8*>(&w); } while (0)
  PK4(p0, 0, pa0); PK4(p0, 8, pa1); PK4(p1, 0, pa2); PK4(p1, 8, pa3);
#undef PK4
}
__device__ __forceinline__ void qkt(f32x16& p0, f32x16& p1, const bf16_t* Ks, const bf16x8* qr, int r32, int hi) {
  p0 = f32x16{}; p1 = f32x16{};
#pragma unroll
  for (int d0 = 0; d0 < 8; ++d0) { int cb = (d0 * 16 + hi * 8) * 2;
    bf16x8 b0 = *reinterpret_cast<const bf16x8*>((const char*)Ks + KSWZ(r32, cb));
    bf16x8 b1 = *reinterpret_cast<const bf16x8*>((const char*)Ks + KSWZ(32 + r32, cb));
    p0 = __builtin_amdgcn_mfma_f32_32x32x16_bf16(b0, qr[d0], p0, 0, 0, 0);
    p1 = __builtin_amdgcn_mfma_f32_32x32x16_bf16(b1, qr[d0], p1, 0, 0, 0); }
}
__device__ __forceinline__ int v_st(int k, int c) { const int kk = (k & ~0xC) | ((k & 4) << 1) | ((k & 8) >> 1); return ((kk >> 3) * 4 + (c >> 5)) * 512 + ((kk & 7) * 32 + (c & 31)) * 2; }
__device__ __forceinline__ int v_rd_base(int lane) { return ((lane & 3) << 3) | (((lane >> 2) & 3) << 6) | (((lane >> 4) & 1) << 5) | (((lane >> 5) & 1) << 8); }
constexpr int v_rd_off(int d0, int ks, int half) { return d0 * 512 + ks * 4096 + half * 2048; }
template <int OFF> __device__ __forceinline__ s16x4 tr_read(int vb) {
  s16x4 r; asm volatile("ds_read_b64_tr_b16 %0, %1 offset:%2" : "=&v"(r) : "v"(vb), "i"(OFF) : "memory"); return r;
}
template <int D0> __device__ __forceinline__ void pv_one(f32x16& od, int vb, bf16x8 pa0, bf16x8 pa1, bf16x8 pa2, bf16x8 pa3) {
  const s16x4 l0 = tr_read<v_rd_off(D0, 0, 0)>(vb), h0 = tr_read<v_rd_off(D0, 0, 1)>(vb), l1 = tr_read<v_rd_off(D0, 1, 0)>(vb), h1 = tr_read<v_rd_off(D0, 1, 1)>(vb);
  const s16x4 l2 = tr_read<v_rd_off(D0, 2, 0)>(vb), h2 = tr_read<v_rd_off(D0, 2, 1)>(vb), l3 = tr_read<v_rd_off(D0, 3, 0)>(vb), h3 = tr_read<v_rd_off(D0, 3, 1)>(vb);
  asm volatile("s_waitcnt lgkmcnt(0)" ::: "memory"); SBAR();
#define PK(L, H) (bf16x8){L[0], L[1], L[2], L[3], H[0], H[1], H[2], H[3]}
  od = __builtin_amdgcn_mfma_f32_32x32x16_bf16(pa0, PK(l0, h0), od, 0, 0, 0);
  od = __builtin_amdgcn_mfma_f32_32x32x16_bf16(pa1, PK(l1, h1), od, 0, 0, 0);
  od = __builtin_amdgcn_mfma_f32_32x32x16_bf16(pa2, PK(l2, h2), od, 0, 0, 0);
  od = __builtin_amdgcn_mfma_f32_32x32x16_bf16(pa3, PK(l3, h3), od, 0, 0, 0);
#undef PK
}
__device__ __forceinline__ void pv_d0(f32x16* o, int vb, bf16x8 pa0, bf16x8 pa1, bf16x8 pa2, bf16x8 pa3) {
  pv_one<0>(o[0], vb, pa0, pa1, pa2, pa3); pv_one<1>(o[1], vb, pa0, pa1, pa2, pa3); pv_one<2>(o[2], vb, pa0, pa1, pa2, pa3); pv_one<3>(o[3], vb, pa0, pa1, pa2, pa3);
}
__device__ __forceinline__ void mask_tile(f32x16& p0, f32x16& p1, const AUnit& U, int j, int qrel, int hi, const float* rpbT) {
  if (j < U.nctx) return;
  const int jl = j - U.nctx;
  if (jl >= U.nloc) {
#pragma unroll
    for (int r = 0; r < 16; ++r) { p0[r] = NEG; p1[r] = NEG; }
    return; }
  if (U.mode == 1) {
    const int dq = (U.kt0 + jl) * 64 - (U.q0 + qrel) + 128;
#pragma unroll
    for (int r = 0; r < 16; ++r) { const int d0 = dq + crow(r, hi); if ((unsigned)d0 > 256u) p0[r] = NEG; if ((unsigned)(d0 + 32) > 256u) p1[r] = NEG; }
  } else if (U.mode == 2) {
    const int qpos = U.q0 + qrel, qrow = qpos >> 6, qcol = qpos & 63, krow = U.kt0 + jl;
    int rs = qrow - 4; rs = rs < 0 ? 0 : (rs > 8 ? 8 : rs);
    int cs = qcol - 8; cs = cs < 0 ? 0 : (cs > 48 ? 48 : cs);
    const bool rowok = (krow >= rs) && (krow < rs + 8);
    const int ib = (krow - qrow + 7) * 31 - qcol + 15;
#pragma unroll
    for (int r = 0; r < 16; ++r) { const int kc0 = crow(r, hi), kc1 = kc0 + 32;
      const bool ok0 = rowok && ((unsigned)(kc0 - cs) < 16u), ok1 = rowok && ((unsigned)(kc1 - cs) < 16u);
      const float b0 = rpbT[ok0 ? ib + kc0 : 0], b1 = rpbT[ok1 ? ib + kc1 : 0];
      p0[r] = ok0 ? p0[r] + b0 : NEG; p1[r] = ok1 ? p1[r] + b1 : NEG; }
  }
}
__device__ __forceinline__ void attn_unit(const AUnit& U, char* lds, int wv) {
  const int tid = ptid(wv);
  const int wid = wv, lane = tid & 63, r32 = lane & 31, hi = lane >> 5;
  bf16_t* V_lds = (bf16_t*)lds; bf16_t* K_lds = (bf16_t*)(lds + 2 * SHM_V);
  float* ws = (float*)(lds + 2 * SHM_V + 2 * SHM_K) + wid * 64; float* li_l = ws; float* al_l = ws + 32;
  float* rpbT = (float*)(lds + RPB_OFF);
  if (U.mode == 2) { for (int i = tid; i < 15 * 31; i += NTHR) rpbT[i] = U.rpb[i] * (1.0f / SCALE); }
  float m_reg = U.m0, l_reg = U.l0; f32x16 o[4] = {}; bf16x8 qr[8];
  const bf16_t* Qw = U.Q + (long)(wid * QBLK + r32) * D + hi * 8;
#pragma unroll
  for (int d0 = 0; d0 < 8; ++d0) qr[d0] = *reinterpret_cast<const bf16x8*>(Qw + d0 * 16);
  const int sr = tid >> 4, sc = (tid & 15) * 8, vst0 = v_st(sr, sc), vst1 = v_st(32 + sr, sc);
  const int vb0 = (int)(uintptr_t)V_lds + v_rd_base(lane);
  const int qrel = wid * QBLK + r32;
  struct { bf16x8 vs0, vs1, ks0, ks1; } sr_[1];
#define KTP(j) ((j) < U.nctx ? U.Kc + (long)(j) * 8192 : U.Kl + (long)(((j) - U.nctx) < U.nloc ? ((j) - U.nctx) : (U.nloc - 1)) * 8192)
#define VTP(j) ((j) < U.nctx ? U.Vc + (long)(j) * 8192 : U.Vl + (long)(((j) - U.nctx) < U.nloc ? ((j) - U.nctx) : (U.nloc - 1)) * 8192)
#define SLOAD(i, j) do { const bf16_t* kp_ = KTP(j); const bf16_t* vp_ = VTP(j); \
    sr_[i].vs0 = *reinterpret_cast<const bf16x8*>(&vp_[(long)(sr) * D + sc]); sr_[i].vs1 = *reinterpret_cast<const bf16x8*>(&vp_[(long)(32 + sr) * D + sc]); \
    sr_[i].ks0 = *reinterpret_cast<const bf16x8*>(&kp_[(long)(sr) * D + sc]); sr_[i].ks1 = *reinterpret_cast<const bf16x8*>(&kp_[(long)(32 + sr) * D + sc]); } while (0)
#define SWRITE(b, i) do { *(bf16x8*)((char*)V_lds + (b) * SHM_V + vst0) = sr_[i].vs0;          \
    *(bf16x8*)((char*)V_lds + (b) * SHM_V + vst1) = sr_[i].vs1; int kc = sc * 2;               \
    *(bf16x8*)((char*)K_lds + (b) * SHM_K + KSWZ(sr, kc)) = sr_[i].ks0;                       \
    *(bf16x8*)((char*)K_lds + (b) * SHM_K + KSWZ(32 + sr, kc)) = sr_[i].ks1; } while (0)
#define SWAIT() asm volatile("s_waitcnt vmcnt(0)" ::: "memory")
#define RESC(a) do { if (__any((a) < 1.f)) { if (hi == 0) al_l[r32] = (a); asm volatile("s_waitcnt lgkmcnt(0)" ::: "memory"); \
    _Pragma("unroll") for (int d = 0; d < 4; ++d) _Pragma("unroll") for (int r = 0; r < 16; ++r) o[d][r] *= al_l[crow(r, hi)]; } } while (0)
  f32x16 pA0, pA1, pB0, pB1; float mnA, mnB, alA, alB; bf16x8 pa0, pa1, pa2, pa3; const int NT = U.nt;
  SLOAD(0, 0); asm volatile("s_waitcnt vmcnt(0)" ::: "memory"); SWRITE(0, 0); __syncthreads();
  qkt(pA0, pA1, K_lds, qr, r32, hi); partialSM(pA0, pA1, m_reg, mnA, alA);
  SLOAD(0, 1);
  SWAIT(); SWRITE(1, 0); __syncthreads();
  for (int j = 1; j + 1 < NT; j += 2) {
    SBAR(); qkt(pB0, pB1, (bf16_t*)((char*)K_lds + SHM_K), qr, r32, hi);
    finishSM(pA0, pA1, alA, l_reg, pa0, pa1, pa2, pa3); SBAR();
    SLOAD(0, j + 1); SBAR();
    pv_d0(o, vb0, pa0, pa1, pa2, pa3); mask_tile(pB0, pB1, U, j, qrel, hi, rpbT); partialSM(pB0, pB1, m_reg, mnB, alB);
    __syncthreads(); SWAIT(); SWRITE(0, 0);
    RESC(alB); __syncthreads();
    SBAR(); qkt(pA0, pA1, K_lds, qr, r32, hi);
    finishSM(pB0, pB1, alB, l_reg, pa0, pa1, pa2, pa3); SBAR();
    SLOAD(0, j + 2); SBAR();
    pv_d0(o, vb0 + (int)SHM_V, pa0, pa1, pa2, pa3); mask_tile(pA0, pA1, U, j + 1, qrel, hi, rpbT); partialSM(pA0, pA1, m_reg, mnA, alA);
    __syncthreads(); SWAIT(); SWRITE(1, 0);
    RESC(alA); __syncthreads();
  }
  SBAR(); qkt(pB0, pB1, (bf16_t*)((char*)K_lds + SHM_K), qr, r32, hi);
  finishSM(pA0, pA1, alA, l_reg, pa0, pa1, pa2, pa3); SBAR();
  pv_d0(o, vb0, pa0, pa1, pa2, pa3); mask_tile(pB0, pB1, U, NT - 1, qrel, hi, rpbT); partialSM(pB0, pB1, m_reg, mnB, alB);
  __syncthreads(); RESC(alB);
  finishSM(pB0, pB1, alB, l_reg, pa0, pa1, pa2, pa3); SBAR();
  pv_d0(o, vb0 + (int)SHM_V, pa0, pa1, pa2, pa3);
  if (hi == 0) li_l[r32] = l_reg; asm volatile("s_waitcnt lgkmcnt(0)" ::: "memory");
  float rli[16];
#pragma unroll
  for (int r = 0; r < 16; ++r) rli[r] = __builtin_amdgcn_rcpf(li_l[crow(r, hi)]);
  bf16_t* Ow = U.O + (long)(wid * QBLK) * DM;
#pragma unroll
  for (int r = 0; r < 16; ++r) { int orow = crow(r, hi);
#pragma unroll
    for (int d0 = 0; d0 < 4; ++d0) Ow[(long)orow * DM + d0 * 32 + r32] = (bf16_t)f2bf(o[d0][r] * rli[r]); }
  __syncthreads();
#undef KTP
#undef VTP
#undef SLOAD
#undef SWRITE
#undef SWAIT
#undef RESC
}
#undef KSWZ
#undef SBAR
}

struct Args { const float* in[29]; float* out; unsigned char* ws; };
enum { I_XP = 0, I_XS, I_C, I_CCK, I_CCV, I_CDK, I_CDV, I_CCTX, I_WADA, I_BADA, I_GF1, I_WGU1, I_WDN1, I_GMIX, I_WOUT, I_GF2, I_WGU2, I_WDN2, I_WINE, I_GSGU, I_WSGU, I_BSGU, I_WINO,
       I_GQC, I_GKC, I_GQD, I_GKD, I_SINK, I_RPB };

__device__ __forceinline__ void transpose_item(const float* W, int K, int N, bf16_t* WT, int k0, int n0, int drow0, LAS float* scr, int lane) {
    (void)scr;
    const int r8 = lane >> 3, c4 = (lane & 7) * 4;
    f32x4 dd[8]; const float* wp = W + (size_t)(k0 + 8 * r8) * N + n0 + c4;
#pragma unroll
    for (int ii = 0; ii < 8; ++ii) dd[ii] = __builtin_nontemporal_load((const f32x4*)(wp + (size_t)ii * N));
#pragma unroll
    for (int e = 0; e < 4; ++e) { u32x4 o; o.x = pk2(dd[0][e], dd[1][e]); o.y = pk2(dd[2][e], dd[3][e]); o.z = pk2(dd[4][e], dd[5][e]); o.w = pk2(dd[6][e], dd[7][e]);
        __builtin_nontemporal_store(o, (u32x4*)(WT + (size_t)(drow0 + c4 + e) * K + k0 + 8 * r8)); }
}
__device__ __forceinline__ void transpose_item_q8(const float* W, int K, int N, signed char* WT, int k0, int n0, int drow0, const float* cmax, LAS float* scr, int lane) {
#pragma unroll 8
    for (int i = 0; i < 32; ++i) { const int kk = 2 * i + (lane >> 5); scr[kk * 33 + (lane & 31)] = W[(size_t)(k0 + kk) * N + n0 + (lane & 31)]; }
    LDS_WAIT(); asm volatile("" ::: "memory");
    const int c = lane & 7;
#pragma unroll
    for (int j = 0; j < 4; ++j) { const int n = (lane >> 3) + 8 * j; const LAS float* s = scr + (8 * c) * 33 + n;
        const float inv = 127.0f / fmaxf(cmax[drow0 + n], 1e-30f); int q[8];
#pragma unroll
        for (int i = 0; i < 8; ++i) { int v = (int)__builtin_rintf(s[i * 33] * inv); v = v > 127 ? 127 : (v < -127 ? -127 : v); q[i] = v & 255; }
        u32x2 o; o.x = (unsigned)q[0] | ((unsigned)q[1] << 8) | ((unsigned)q[2] << 16) | ((unsigned)q[3] << 24); o.y = (unsigned)q[4] | ((unsigned)q[5] << 8) | ((unsigned)q[6] << 16) | ((unsigned)q[7] << 24);
        *(u32x2*)(WT + (size_t)(drow0 + n) * K + k0 + 8 * c) = o; }
    LDS_WAIT(); asm volatile("" ::: "memory");
}
__device__ __forceinline__ int gu_row(int n) { return n < DFF ? ((n >> 7) * 256 + (n & 127)) : (((n - DFF) >> 7) * 256 + 128 + ((n - DFF) & 127)); }

constexpr int CONV_PER_LAYER = 11008 * 2 + 5504 * 2 + 2048 + 4608;
__device__ __forceinline__ void convert_item(const Args& A, int l, int r, LAS float* scr, int lane) {
    bf16_t* wl = (bf16_t*)(ws_opaque(A.ws) + WS_W) + (size_t)l * W_LAYER;
    if (r < 22016) { const int f = r / 11008; r %= 11008; const int kb = r / 344, nb = r % 344;
        transpose_item_q8(asg(A.in[f ? I_WGU2 : I_WGU1]) + (size_t)l * DM * NGU, DM, NGU, (signed char*)(wl + (f ? W_GU2 : W_GU1)), kb * 64, nb * 32, gu_row(nb * 32),
                          (const float*)(ws_opaque(A.ws) + WS_CMAX) + (size_t)(l * 2 + f) * NGU, scr, lane); return; }
    r -= 22016;
    if (r < 11008) { const int f = r / 5504; r %= 5504; const int kb = r / 64, nb = r % 64;
        transpose_item(asg(A.in[f ? I_WDN2 : I_WDN1]) + (size_t)l * DFF * DM, DFF, DM, wl + (f ? W_DN2 : W_DN1), kb * 64, nb * 32, nb * 32, scr, lane); return; }
    r -= 11008;
    if (r < 2048) { const int kb = r / 64, nb = r % 64;
        transpose_item(asg(A.in[I_WOUT]) + (size_t)l * DM * DM, DM, DM, wl + W_OUT, kb * 64, nb * 32, nb * 32, scr, lane); return; }
    r -= 2048;
    if (l & 1) { const int kb = r / 144, nb = r % 144;
        transpose_item(asg(A.in[I_WINO]) + (size_t)(l >> 1) * DM * NIN_O, DM, NIN_O, wl + W_IN, kb * 64, nb * 32, nb * 32, scr, lane); }
    else if (r < 3072) { const int kb = r / 96, nb = r % 96;
        transpose_item(asg(A.in[I_WINE]) + (size_t)(l >> 1) * DM * NIN_E, DM, NIN_E, wl + W_IN, kb * 64, nb * 32, nb * 32, scr, lane); }
}
__device__ __forceinline__ void gu_q8_wg_item(const Args& A, LAS unsigned char* lds, int l, int f, int nb, int wv) {
    const int tid = ptid(wv), lane = tid & 63, r8 = lane >> 3, c4 = (lane & 7) * 4;
    const float* W = asg(A.in[f ? I_WGU2 : I_WGU1]) + (size_t)l * DM * NGU;
    LAS float* wmax = (LAS float*)(lds + 69632);
    LAS float* cm = wmax + 256;
    f32x4 d[32];
    { const float* w = W + (size_t)(wv * 256 + 8 * r8) * NGU + nb * 32 + c4;
#pragma unroll
      for (int i = 0; i < 32; ++i) d[i] = __builtin_nontemporal_load((const f32x4*)(w + (size_t)((i >> 3) * 64 + (i & 7)) * NGU)); }
    { f32x4 mx = {0.f, 0.f, 0.f, 0.f};
#pragma unroll
      for (int i = 0; i < 32; ++i) { mx[0] = fmaxf(mx[0], fabsf(d[i][0])); mx[1] = fmaxf(mx[1], fabsf(d[i][1])); mx[2] = fmaxf(mx[2], fabsf(d[i][2])); mx[3] = fmaxf(mx[3], fabsf(d[i][3])); }
#pragma unroll
      for (int q = 0; q < 4; ++q) { mx[q] = fmaxf(mx[q], sx<8>(mx[q])); mx[q] = fmaxf(mx[q], sx<16>(mx[q])); mx[q] = max32(mx[q]); }
      if (lane < 8) { wmax[wv * 32 + lane * 4 + 0] = mx[0]; wmax[wv * 32 + lane * 4 + 1] = mx[1]; wmax[wv * 32 + lane * 4 + 2] = mx[2]; wmax[wv * 32 + lane * 4 + 3] = mx[3]; } }
    __syncthreads();
    const int drow0 = gu_row(nb * 32);
    if (tid < 32) { float m = wmax[tid];
#pragma unroll
        for (int w8 = 1; w8 < 8; ++w8) m = fmaxf(m, wmax[w8 * 32 + tid]);
        cm[tid] = m; ((float*)(ws_opaque(A.ws) + WS_CMAX))[(size_t)(l * 2 + f) * NGU + drow0 + tid] = m; }
    __syncthreads();
    signed char* WT = (signed char*)((bf16_t*)(ws_opaque(A.ws) + WS_W) + (size_t)l * W_LAYER + (f ? W_GU2 : W_GU1));
    float inv[4];
#pragma unroll
    for (int e = 0; e < 4; ++e) inv[e] = 127.0f / fmaxf(cm[c4 + e], 1e-30f);
#pragma unroll
    for (int kb = 0; kb < 4; ++kb)
#pragma unroll
        for (int e = 0; e < 4; ++e) { int q[8];
#pragma unroll
            for (int i = 0; i < 8; ++i) { int v = (int)__builtin_rintf(d[kb * 8 + i][e] * inv[e]); v = v > 127 ? 127 : (v < -127 ? -127 : v); q[i] = v & 255; }
            u32x2 o; o.x = (unsigned)q[0] | ((unsigned)q[1] << 8) | ((unsigned)q[2] << 16) | ((unsigned)q[3] << 24); o.y = (unsigned)q[4] | ((unsigned)q[5] << 8) | ((unsigned)q[6] << 16) | ((unsigned)q[7] << 24);
            __builtin_nontemporal_store(o, (u32x2*)(WT + (size_t)(drow0 + c4 + e) * DM + wv * 256 + kb * 64 + 8 * r8)); }
    __syncthreads();
}
__device__ __forceinline__ void wht32_rows(float (&v)[8], int r8) {
#pragma unroll
    for (int st = 1; st < 8; st <<= 1)
#pragma unroll
        for (int i = 0; i < 8; ++i) if (!(i & st)) { const float a = v[i], b = v[i + st]; v[i] = a + b; v[i + st] = a - b; }
#pragma unroll
    for (int i = 0; i < 8; ++i) { const float p = sx<8>(v[i]); v[i] = (r8 & 1) ? (p - v[i]) : (v[i] + p); }
#pragma unroll
    for (int i = 0; i < 8; ++i) { const float p = sx<16>(v[i]); v[i] = (r8 & 2) ? (p - v[i]) : (v[i] + p); }
}
__device__ __forceinline__ void dn_q8_wg_item(const Args& A, LAS unsigned char* lds, int l, int f, int nb, int wv) {
    const int tid = ptid(wv), lane = tid & 63, r8 = lane >> 3, c4 = (lane & 7) * 4;
    const float* W = asg(A.in[f ? I_WDN2 : I_WDN1]) + (size_t)l * DFF * DM;
    LAS float* wmax = (LAS float*)(lds + 69632);
    LAS float* cm = wmax + 256;
    signed char* WT = (signed char*)((bf16_t*)(ws_opaque(A.ws) + WS_W) + (size_t)l * W_LAYER + (f ? W_DN2 : W_DN1));
    float mx[4] = {0.f, 0.f, 0.f, 0.f}, inv[4] = {0.f, 0.f, 0.f, 0.f};
    for (int pass = 0; pass < 2; ++pass) {
#define DN_LOAD(buf, kb_) do { const float* wp_ = W + (size_t)((kb_) * 64 + 8 * r8) * DM + nb * 32 + c4; _Pragma("unroll") for (int ii = 0; ii < 8; ++ii) buf[ii] = *(const f32x4*)(wp_ + (size_t)ii * DM); } while (0)
#define DN_PROC(buf, kb_) do { const int k0_ = (kb_) * 64; _Pragma("unroll") for (int e = 0; e < 4; ++e) { float v[8]; \
            _Pragma("unroll") for (int i = 0; i < 8; ++i) v[i] = buf[i][e]; \
            wht32_rows(v, r8); \
            if (pass == 0) { _Pragma("unroll") for (int i = 0; i < 8; ++i) mx[e] = fmaxf(mx[e], fabsf(v[i])); } \
            else { int q[8]; _Pragma("unroll") for (int i = 0; i < 8; ++i) { int t = (int)__builtin_rintf(v[i] * inv[e]); t = t > 127 ? 127 : (t < -127 ? -127 : t); q[i] = t & 255; } \
                u32x2 o; o.x = (unsigned)q[0] | ((unsigned)q[1] << 8) | ((unsigned)q[2] << 16) | ((unsigned)q[3] << 24); o.y = (unsigned)q[4] | ((unsigned)q[5] << 8) | ((unsigned)q[6] << 16) | ((unsigned)q[7] << 24); \
                __builtin_nontemporal_store(o, (u32x2*)(WT + (size_t)(nb * 32 + c4 + e) * KD8 + k0_ + 8 * r8)); } } } while (0)
        f32x4 bA[8], bB[8];
        DN_LOAD(bA, wv);
        for (int kb = wv; ; kb += 16) {
            const bool h1 = kb + 8 < 86; if (h1) DN_LOAD(bB, kb + 8);
            DN_PROC(bA, kb);
            if (!h1) break;
            const bool h2 = kb + 16 < 86; if (h2) DN_LOAD(bA, kb + 16);
            DN_PROC(bB, kb + 8);
            if (!h2) break;
        }
#undef DN_LOAD
#undef DN_PROC
        if (pass == 0) {
#pragma unroll
            for (int e = 0; e < 4; ++e) { mx[e] = fmaxf(mx[e], sx<8>(mx[e])); mx[e] = fmaxf(mx[e], sx<16>(mx[e])); mx[e] = max32(mx[e]); }
            if (lane < 8) {
#pragma unroll
                for (int e = 0; e < 4; ++e) wmax[wv * 32 + c4 + e] = mx[e]; }
            __syncthreads();
            if (tid < 32) { float m = wmax[tid];
#pragma unroll
                for (int w8 = 1; w8 < 8; ++w8) m = fmaxf(m, wmax[w8 * 32 + tid]);
                cm[tid] = m; ((float*)(ws_opaque(A.ws) + WS_CMAX2))[(size_t)(l * 2 + f) * DM + nb * 32 + tid] = m * (1.0f / 32.0f); }
            __syncthreads();
#pragma unroll
            for (int e = 0; e < 4; ++e) inv[e] = 127.0f / fmaxf(cm[c4 + e], 1e-30f);
        }
    }
    if (tid < 256) { u32x4 zv = {0u, 0u, 0u, 0u}; asm volatile("" : "+v"(zv)); *(u32x4*)(WT + (size_t)(nb * 32 + (tid >> 3)) * KD8 + DFF + (tid & 7) * 16) = zv; }
    __syncthreads();
}
constexpr int CONV_GU_ROUNDS = 688, CONV_DN_ROUNDS = 128, CONV_ROUNDS = CONV_GU_ROUNDS + CONV_DN_ROUNDS + (CONV_PER_LAYER - 33024) / 8;
__device__ __forceinline__ void conv_round(const Args& A, LAS unsigned char* lds, int l, int r, int wv) {
    if (r < CONV_GU_ROUNDS) { gu_q8_wg_item(A, lds, l, r / 344, r % 344, wv); return; }
    if (r < CONV_GU_ROUNDS + CONV_DN_ROUNDS) { const int rr = r - CONV_GU_ROUNDS; dn_q8_wg_item(A, lds, l, rr >> 6, rr & 63, wv); return; }
    const int lane = ptid(wv) & 63;
    convert_item(A, l, 33024 + 8 * (r - CONV_GU_ROUNDS - CONV_DN_ROUNDS) + wv, (LAS float*)(lds + wv * 8704), lane);
}
#define QH(l) (8192 + 64 * (l))
__device__ __forceinline__ bool fill_round(const Args& A, LAS unsigned char* lds, int l, int wv) {
    volatile LAS unsigned* MISC = (volatile LAS unsigned*)(lds + LDS_MISC);
    const int tid = ptid(wv);
    if (tid == 0) MISC[4] = __hip_atomic_fetch_add((unsigned*)(ws_opaque(A.ws) + WS_CTL) + QH(l), 1u, __ATOMIC_RELAXED, __HIP_MEMORY_SCOPE_AGENT);
    __syncthreads();
    const int base = (int)MISC[4];
    __syncthreads();
    if (base >= CONV_ROUNDS) return false;
    conv_round(A, lds, l, base, wv);
    return true;
}
__device__ __forceinline__ void fill_wait(const Args& A, LAS unsigned char* lds, int G, int wv, int nbar, int& ql) {
    volatile LAS unsigned* MISC = (volatile LAS unsigned*)(lds + LDS_MISC);
    while (ql < 4) {
        const int tid = ptid(wv);
        if (tid == 0) { unsigned* bar = (unsigned*)(ws_opaque(A.ws) + WS_CTL); unsigned sum = 0u;
#pragma unroll
            for (unsigned j = 0; j < 16; ++j) sum += xb_ld(&bar[XB_XSUB(j)]);
            MISC[5] = ((sum - (unsigned)nbar * (unsigned)G) * 2u >= (unsigned)G) ? 1u : 0u; }
        __syncthreads();
        const unsigned stop = MISC[5];
        __syncthreads();
        if (stop) break;
        if (!fill_round(A, lds, ql, wv)) ++ql;
    }
}

__device__ __forceinline__ void prologue_a(const Args& A, LAS unsigned char* lds, int G, int wv) {
    const int tid = ptid(wv), lane = tid & 63, wave = wv;
    unsigned char* ws = ws_opaque(A.ws);
    LAS float* sil = (LAS float*)(lds + 69632);
    for (int i = tid; i < 3 * DM; i += NTHR) { const int cv = i / DM, k = i % DM; const float v = cv == 0 ? asg(A.in[I_CCTX])[k] : asg(A.in[I_C])[(cv - 1) * DM + k]; sil[i] = v / (1.0f + __expf(-v)); }
    __syncthreads();
    const int gw = obid() * NWAVES + wave, NGW = G * NWAVES;
    for (int it = gw; it < 4 * 144 * 4; it += NGW) {
        const int l = it / 576, r = it % 576, cg = r >> 2, ks = r & 3;
        const float* w = asg(A.in[I_WADA]) + ((size_t)l * DM + ks * 512) * NMODV + cg * 128 + 2 * lane;
        f32x2 a0 = {0.f, 0.f}, a1 = {0.f, 0.f}, a2 = {0.f, 0.f};
        const LAS float* s0 = sil + ks * 512;
#pragma unroll 8
        for (int k = 0; k < 512; ++k) { const f32x2 wv = __builtin_nontemporal_load((const f32x2*)(w + (size_t)k * NMODV)); a0 += wv * s0[k]; a1 += wv * s0[DM + k]; a2 += wv * s0[2 * DM + k]; }
        float* P = (float*)(ws + WS_ADAP) + ((size_t)(l * 4 + ks) * 3) * NMODV + cg * 128 + 2 * lane;
        *(f32x2*)P = a0; *(f32x2*)(P + NMODV) = a1; *(f32x2*)(P + 2 * NMODV) = a2;
    }
    __syncthreads();
    for (int r = obid(); r < CONV_ROUNDS; r += G) conv_round(A, lds, 0, r, wv);
    const size_t gt = (size_t)obid() * NTHR + tid, GT = (size_t)G * NTHR;
    constexpr size_t N_CK = 524288 / 8, N_DK = 2097152 / 8, N_WS = 262144 / 8, N_T = 131072 / 8, N_CS = 2097152 / 8;
    constexpr size_t E0 = N_CK, E1 = E0 + N_CK, E2 = E1 + N_DK, E3 = E2 + N_DK, E4 = E3 + N_WS, E5 = E4 + N_T, E6 = E5 + N_T, E7 = E6 + N_CS;
    for (size_t i = gt; i < E7; i += GT) {
        if (i < E4) {
            const float* src; bf16_t* dst; size_t j;
            if (i < E0) { src = asg(A.in[I_CCK]); dst = (bf16_t*)(ws + WS_CCK); j = i; }
            else if (i < E1) { src = asg(A.in[I_CCV]); dst = (bf16_t*)(ws + WS_CCV); j = i - E0; }
            else if (i < E2) { src = asg(A.in[I_CDK]); dst = (bf16_t*)(ws + WS_CDK); j = i - E1; }
            else if (i < E3) { src = asg(A.in[I_CDV]); dst = (bf16_t*)(ws + WS_CDV); j = i - E2; }
            else { src = asg(A.in[I_WSGU]); dst = (bf16_t*)(ws + WS_WSGU); j = i - E3; }
            const f32x4 x0 = *(const f32x4*)(src + j * 8), x1 = *(const f32x4*)(src + j * 8 + 4);
            u32x4 o; o.x = pk2(x0[0], x0[1]); o.y = pk2(x0[2], x0[3]); o.z = pk2(x1[0], x1[1]); o.w = pk2(x1[2], x1[3]);
            *(u32x4*)(dst + j * 8) = o;
        } else {
            float v[8]; bf16_t* dst; size_t j; size_t doff;
            if (i < E5) { j = i - E4; doff = j * 8; dst = (bf16_t*)(ws + WS_T256); const int m = (int)(j * 8) / 256, k0 = (int)(j * 8) % 256, cp = m & 255, h = m >> 8;
#pragma unroll
                for (int e = 0; e < 8; ++e) { const float ang = (float)(((cp * (k0 + e)) & 255) * 2) * (1.0f / 256.0f); v[e] = h ? sinpif(ang) : cospif(ang); } }
            else if (i < E6) { j = i - E5; dst = (bf16_t*)(ws + WS_CS256); const int sp = (int)(j * 8) / 512, kk0 = (int)(j * 8) % 512, h = kk0 / 256, s0 = kk0 % 256; doff = (size_t)sp * 2048 + kk0;
#pragma unroll
                for (int e = 0; e < 8; ++e) { const float ang = (float)(((sp * (s0 + e)) & 255) * 2) * (1.0f / 256.0f); v[e] = h ? -sinpif(ang) : cospif(ang); } }
            else { j = i - E6; doff = j * 8; dst = (bf16_t*)(ws + WS_CS1024); const int sp = (int)(j * 8) / 2048, kk0 = (int)(j * 8) % 2048, h = kk0 / 1024, s0 = kk0 % 1024;
#pragma unroll
                for (int e = 0; e < 8; ++e) { const float ang = (float)(((sp * (s0 + e)) & 1023) * 2) * (1.0f / 1024.0f); v[e] = h ? -sinpif(ang) : cospif(ang); } }
            u32x4 o; o.x = pk2(v[0], v[1]); o.y = pk2(v[2], v[3]); o.z = pk2(v[4], v[5]); o.w = pk2(v[6], v[7]);
            *(u32x4*)(dst + doff) = o;
        }
    }
    if (gt < 2048) { const int pos = (int)gt >> 5, f = (int)gt & 31; const float inv = powf(10000.0f, -(float)f / 32.0f), ang = (float)pos * inv;
        float* rt = (float*)(ws + WS_ROPE); rt[gt] = cosf(ang); rt[2048 + gt] = sinf(ang); }
}
__device__ __forceinline__ void prologue_b(const Args& A, LAS unsigned char* lds, int G, int wv) {
    const size_t gt = (size_t)obid() * NTHR + ptid(wv), GT = (size_t)G * NTHR;
    const float* P = (const float*)(ws_opaque(A.ws) + WS_ADAP); float* Mo = (float*)(ws_opaque(A.ws) + WS_MODS);
    for (size_t i = gt; i < (size_t)4 * 3 * NMODV; i += GT) { const int l = (int)(i / (3 * NMODV)), r = (int)(i % (3 * NMODV)), j = r % NMODV;
        float s = asg(A.in[I_BADA])[(size_t)l * NMODV + j];
#pragma unroll
        for (int ks = 0; ks < 4; ++ks) s += P[((size_t)(l * 4 + ks) * 3) * NMODV + r];
        Mo[i] = s; }
}

__device__ __forceinline__ void nm_phase(const Args& A, int G, bool first, bool do_slab, float coef, int layer_gate, int kgate, bool do_norm, const float* g, int layer, int kshift, int wv, bool q8, int gx, int grk) {
    const int tid = ptid(wv);
    const int lane = tid & 63, wave = wv;
    const int gw = obid() * NWAVES + wave, NGW = G * NWAVES;
    bf16_t* xd = (bf16_t*)(ws_opaque(A.ws) + WS_XB); bf16_t* H = (bf16_t*)(ws_opaque(A.ws) + WS_H);
    const float* mods = (const float*)(ws_opaque(A.ws) + WS_MODS); const float* slab = (const float*)(ws_opaque(A.ws) + WS_SLAB);
    const int r_lo = do_norm ? 0 : MP;
#define NM_ROW(it_) ((((it_) < 4 ? 4 * gx + (it_) : 32 + gx) * 256) + grk * 8 + wave)
#define NM_LOAD(buf, it_) do { const int r_ = NM_ROW(it_); \
        if (first) { const float* xr_ = r_ < MP ? asg(A.in[I_XP]) + (size_t)r_ * DM : asg(A.in[I_XS]) + (size_t)(r_ - MP) * DM; \
            _Pragma("unroll") for (int j = 0; j < 8; ++j) buf[j] = *(const f32x4*)(xr_ + 4 * lane + 256 * j); } \
        else { const bf16_t* xr_ = xd + (size_t)r_ * DM; \
            _Pragma("unroll") for (int j = 0; j < 8; ++j) { const u32x2 w_ = *(const u32x2*)(xr_ + 4 * lane + 256 * j); buf[j] = (f32x4){bf_lo(w_.x), bf_hi(w_.x), bf_lo(w_.y), bf_hi(w_.y)}; } } } while (0)
    const int it0 = do_norm ? 0 : 4;
    f32x4 v[8], nx[8], ma[8], mb[8]; int cvl = -1;
    NM_LOAD(v, it0);
#pragma unroll 1
    for (int it = it0; it < 5; ++it) {
        const int r = NM_ROW(it);
        const int cv = r < MP ? 0 : 1 + ((r - MP) >> 10);
        if (it < 4) NM_LOAD(nx, it + 1);
        const bool wr_x = first || (do_slab && r >= MP);
        if (do_slab && r >= MP) {
            const float* gt_ = mods + ((size_t)(layer_gate * 3 + cv)) * NMODV + kgate * DM;
            const bf16_t* sb = (const bf16_t*)slab + (size_t)(r - MP) * DM;
#pragma unroll
            for (int j = 0; j < 8; ++j) { const int c = 4 * lane + 256 * j;
                const u32x2 w0 = *(const u32x2*)(sb + c), w1 = *(const u32x2*)(sb + (size_t)MS * DM + c), w2 = *(const u32x2*)(sb + (size_t)2 * MS * DM + c), w3 = *(const u32x2*)(sb + (size_t)3 * MS * DM + c);
                const f32x4 s = {(bf_lo(w0.x) + bf_lo(w1.x)) + (bf_lo(w2.x) + bf_lo(w3.x)), (bf_hi(w0.x) + bf_hi(w1.x)) + (bf_hi(w2.x) + bf_hi(w3.x)),
                                 (bf_lo(w0.y) + bf_lo(w1.y)) + (bf_lo(w2.y) + bf_lo(w3.y)), (bf_hi(w0.y) + bf_hi(w1.y)) + (bf_hi(w2.y) + bf_hi(w3.y))};
                v[j] = v[j] + (*(const f32x4*)(gt_ + c) * coef) * s; }
        }
        if (wr_x) {
            if (!do_norm) {
#pragma unroll
                for (int j = 0; j < 8; ++j) *(f32x4*)(asg(A.out) + (size_t)r * DM + 4 * lane + 256 * j) = v[j];
            } else {
#pragma unroll
                for (int j = 0; j < 8; ++j) { u32x2 w; w.x = cvt_pk_bf16(v[j][0], v[j][1]); w.y = cvt_pk_bf16(v[j][2], v[j][3]); *(u32x2*)(xd + (size_t)r * DM + 4 * lane + 256 * j) = w; }
            }
        }
        if (do_norm) {
            float ss = 0.f;
#pragma unroll
            for (int j = 0; j < 8; ++j) ss += (v[j][0] * v[j][0] + v[j][1] * v[j][1]) + (v[j][2] * v[j][2] + v[j][3] * v[j][3]);
            ss = wave_sum(ss);
            const float rstd = 1.0f / sqrtf(ss * (1.0f / DM) + EPS);
            if (cv != cvl) { cvl = cv; const float* sh = mods + ((size_t)(layer * 3 + cv)) * NMODV + kshift * DM; const float* scp = sh + DM;
#pragma unroll
                for (int j = 0; j < 8; ++j) { const int c = 4 * lane + 256 * j; ma[j] = *(const f32x4*)(g + c) * (*(const f32x4*)(scp + c) + 1.0f); mb[j] = *(const f32x4*)(sh + c); } }
            if (!q8) {
#pragma unroll
                for (int j = 0; j < 8; ++j) { const int c = 4 * lane + 256 * j;
                    const f32x4 y = (v[j] * rstd) * ma[j] + mb[j];
                    u32x2 w; w.x = cvt_pk_bf16(y[0], y[1]); w.y = cvt_pk_bf16(y[2], y[3]);
                    *(u32x2*)(H + (size_t)r * DM + c) = w; }
            } else {
                float amax = 0.f;
#pragma unroll
                for (int j = 0; j < 8; ++j) {
                    v[j] = (v[j] * rstd) * ma[j] + mb[j];
                    amax = fmaxf(fmaxf(amax, fmaxf(fabsf(v[j][0]), fabsf(v[j][1]))), fmaxf(fabsf(v[j][2]), fabsf(v[j][3]))); }
                amax = wave_max(amax);
                amax = fmaxf(amax, 1e-30f);
                const float inv = 127.0f / amax;
                signed char* H8 = (signed char*)H;
#pragma unroll
                for (int j = 0; j < 8; ++j) { const int c = 4 * lane + 256 * j; unsigned w = 0u;
#pragma unroll
                    for (int e = 0; e < 4; ++e) { int q = (int)__builtin_rintf(v[j][e] * inv); q = q > 127 ? 127 : (q < -127 ? -127 : q); w |= (unsigned)(q & 255) << (8 * e); }
                    *(unsigned*)(H8 + (size_t)r * DM + c) = w; }
                if (lane == 0) ((float*)(ws_opaque(A.ws) + WS_RSC))[r] = amax * (1.0f / 127.0f);
            }
        }
#pragma unroll
        for (int j = 0; j < 8; ++j) v[j] = nx[j];
    }
#undef NM_ROW
#undef NM_LOAD
}

__device__ __forceinline__ void q8act_phase(const Args& A, int wv, int gx, int grk) {
    const int tid = ptid(wv), lane = tid & 63;
    const bf16_t* act = (const bf16_t*)(ws_opaque(A.ws) + WS_ACT); signed char* a8 = (signed char*)(ws_opaque(A.ws) + WS_ACT8); float* rs2 = (float*)(ws_opaque(A.ws) + WS_RSC2);
#define QA_ROW(it_) ((((it_) < 4 ? 4 * gx + (it_) : 32 + gx) * 256) + grk * 8 + wv)
#define QA_LOAD(buf, it_) do { const bf16_t* row_ = act + (size_t)QA_ROW(it_) * DFF; \
        _Pragma("unroll") for (int j = 0; j < 11; ++j) { const int idx_ = lane + 64 * j; buf[j] = (idx_ < 688) ? __builtin_nontemporal_load((const u32x4*)(row_ + idx_ * 8)) : (u32x4){0u, 0u, 0u, 0u}; } } while (0)
    u32x4 v[11], nx[11];
    QA_LOAD(v, 0);
#pragma unroll 1
    for (int it = 0; it < 5; ++it) {
        const int r = QA_ROW(it);
        if (it < 4) QA_LOAD(nx, it + 1);
        float amax = 0.f;
#pragma unroll
        for (int j = 0; j < 11; ++j) {
#pragma unroll
            for (int e = 0; e < 4; ++e) amax = fmaxf(amax, fmaxf(fabsf(bf_lo(v[j][e])), fabsf(bf_hi(v[j][e])))); }
        amax = wave_max(amax);
        amax = fmaxf(amax, 1e-30f);
        const float inv = 127.0f / amax;
        signed char* orow = a8 + (size_t)r * KD8;
#pragma unroll
        for (int j = 0; j < 11; ++j) { const int idx = lane + 64 * j; u32x2 o;
#pragma unroll
            for (int h = 0; h < 2; ++h) { unsigned w = 0u;
#pragma unroll
                for (int e = 0; e < 2; ++e) { const unsigned src = v[j][2 * h + e];
                    int q0 = (int)__builtin_rintf(bf_lo(src) * inv), q1 = (int)__builtin_rintf(bf_hi(src) * inv);
                    q0 = q0 > 127 ? 127 : (q0 < -127 ? -127 : q0); q1 = q1 > 127 ? 127 : (q1 < -127 ? -127 : q1);
                    w |= ((unsigned)(q0 & 255) | ((unsigned)(q1 & 255) << 8)) << (16 * e); }
                o[h] = w; }
            if (idx < 688) *(u32x2*)(orow + idx * 8) = o; }
        if (lane < 16) { u32x2 zv = {0u, 0u}; asm volatile("" : "+v"(zv)); *(u32x2*)(orow + DFF + lane * 8) = zv; }
        if (lane == 0) rs2[r] = amax * (1.0f / 127.0f);
#pragma unroll
        for (int j = 0; j < 11; ++j) v[j] = nx[j];
    }
#undef QA_ROW
#undef QA_LOAD
}

__device__ __forceinline__ void vstat_phase(const Args& A, int G, int wv) {
    const int tid = ptid(wv), lane = tid & 63;
    const bf16_t* mixin = (const bf16_t*)(ws_opaque(A.ws) + WS_MIXIN); float* rst = (float*)(ws_opaque(A.ws) + WS_SSQ);
    for (int r = obid() * NWAVES + wv; r < MTOT; r += G * NWAVES) {
        const bf16_t* p = mixin + (size_t)r * NIN_E + 1024 + lane * 8;
        const u32x4 a = *(const u32x4*)p, b = *(const u32x4*)(p + 512);
        float ss = 0.f;
#pragma unroll
        for (int e = 0; e < 4; ++e) { const float x0 = bf_lo(a[e]), x1 = bf_hi(a[e]), y0 = bf_lo(b[e]), y1 = bf_hi(b[e]); ss += (x0 * x0 + x1 * x1) + (y0 * y0 + y1 * y1); }
        ss = wave_sum(ss);
        if (lane == 0) rst[r] = 1.0f / sqrtf(ss * (1.0f / 1024.0f) + EPS);
    }
}

__device__ __forceinline__ void sgu_phase(const Args& A, LAS unsigned char* lds, int G, int e, int wv) {
    const int tid = ptid(wv);
    const int lane = tid & 63, wave = wv;
    const bf16_t* mixin = (const bf16_t*)(ws_opaque(A.ws) + WS_MIXIN); bf16_t* mixout = (bf16_t*)(ws_opaque(A.ws) + WS_MIXOUT);
    const float* ssq = (const float*)(ws_opaque(A.ws) + WS_SSQ);
    const bf16_t* wsg = (const bf16_t*)(ws_opaque(A.ws) + WS_WSGU) + (size_t)e * 8 * 128 * 128;
    LAS bf16_t* LT = (LAS bf16_t*)lds;
    LAS float* rs = (LAS float*)(lds + 128 * 136 * 2);
    volatile LAS unsigned* MISCq = (volatile LAS unsigned*)(lds + LDS_MISC);
    for (;;) {
        if (tid == 0) MISCq[6] = __hip_atomic_fetch_add((unsigned*)(ws_opaque(A.ws) + WS_CTL) + (8192 + 64 * (12 + e)), 1u, __ATOMIC_RELAXED, __HIP_MEMORY_SCOPE_AGENT);
        __syncthreads();
        const int u = (int)MISCq[6];
        if (u >= 80 * 8) break;
        const int ch = u >> 3, g = u & 7, t0 = ch * 128;
        __syncthreads();
        if (tid < 128) rs[tid] = ssq[t0 + tid];
        __syncthreads();
#pragma unroll
        for (int i = 0; i < 4; ++i) { const int idx = tid + NTHR * i, q = idx >> 4, cc = idx & 15;
            const u32x4 w = *(const u32x4*)(mixin + (size_t)(t0 + q) * NIN_E + 1024 + g * 128 + cc * 8);
            const float* gs = asg(A.in[I_GSGU]) + (size_t)e * 1024 + g * 128 + cc * 8; const float r = rs[q];
            const f32x4 g0 = *(const f32x4*)gs, g1 = *(const f32x4*)(gs + 4);
            float y[8] = {bf_lo(w.x) * r * g0[0], bf_hi(w.x) * r * g0[1], bf_lo(w.y) * r * g0[2], bf_hi(w.y) * r * g0[3], bf_lo(w.z) * r * g1[0], bf_hi(w.z) * r * g1[1], bf_lo(w.w) * r * g1[2], bf_hi(w.w) * r * g1[3]};
#pragma unroll
            for (int k = 0; k < 8; ++k) LT[(cc * 8 + k) * 136 + q] = (bf16_t)f2bf(y[k]); }
        __syncthreads();
        const int p = 16 * wave + (lane & 15), kq = lane >> 4;
        bf16x8 wf[4];
#pragma unroll
        for (int ks = 0; ks < 4; ++ks) wf[ks] = *(const bf16x8*)(wsg + ((size_t)g * 128 + p) * 128 + 32 * ks + 8 * kq);
        const float bias = asg(A.in[I_BSGU])[(size_t)e * 1024 + g * 128 + p];
#pragma unroll
        for (int nt = 0; nt < 8; ++nt) { f32x4 acc = {0.f, 0.f, 0.f, 0.f};
#pragma unroll
            for (int ks = 0; ks < 4; ++ks) { const bf16x8 vf = *(const LAS bf16x8*)(LT + (16 * nt + (lane & 15)) * 136 + 32 * ks + 8 * kq);
                acc = __builtin_amdgcn_mfma_f32_16x16x32_bf16(vf, wf[ks], acc, 0, 0, 0); }
            const int c = 16 * nt + 4 * kq;
            const u32x2 uu = *(const u32x2*)(mixin + (size_t)(t0 + p) * NIN_E + g * 128 + c);
            u32x2 o; o.x = cvt_pk_bf16(bf_lo(uu.x) * (acc[0] + bias), bf_hi(uu.x) * (acc[1] + bias)); o.y = cvt_pk_bf16(bf_lo(uu.y) * (acc[2] + bias), bf_hi(uu.y) * (acc[3] + bias));
            *(u32x2*)(mixout + (size_t)(t0 + p) * DM + g * 128 + c) = o; }
    }
    __syncthreads();
}

__device__ __forceinline__ void prep_phase(const Args& A, int G, int o, int wv, int gx, int grk) {
    const int tid = ptid(wv);
    const int lane = tid & 63, wave = wv, li = lane & 15, grp = lane >> 4;
    const int gw = obid() * NWAVES + wave, NGW = G * NWAVES;
    const bf16_t* mixin = (const bf16_t*)(ws_opaque(A.ws) + WS_MIXIN); bf16_t* qkv = (bf16_t*)(ws_opaque(A.ws) + WS_QKV);
    const float* rt = (const float*)(ws_opaque(A.ws) + WS_ROPE);
    for (int it = 0; it < 5; ++it) {
        const int r = (it < 4 ? 4 * gx + it : 32 + gx) * 256 + grk * 8 + wave;
        const bool smp = r >= MP; const int b = smp ? (r - MP) >> 10 : r >> 8, s = smp ? (r - MP) & 1023 : r & 255, S = smp ? 1024 : 256;
        const int prow = s >> 6, pcol = s & 63;
#pragma unroll
        for (int j = 0; j < 9; ++j) {
            const int slot = 4 * j + grp;
            const u32x4 w = __builtin_nontemporal_load((const u32x4*)(mixin + (size_t)r * NIN_O + slot * 128 + li * 8));
            float x[8] = {bf_lo(w.x), bf_hi(w.x), bf_lo(w.y), bf_hi(w.y), bf_lo(w.z), bf_hi(w.z), bf_lo(w.w), bf_hi(w.w)};
            int ty, hd, H;
            if (slot < 8) { ty = 0; hd = slot; H = 8; } else if (slot < 10) { ty = 1; hd = slot - 8; H = 2; } else if (slot < 12) { ty = 2; hd = slot - 10; H = 2; }
            else if (slot < 20) { ty = 3; hd = slot - 12; H = 8; } else if (slot < 28) { ty = 4; hd = slot - 20; H = 8; } else { ty = 5; hd = slot - 28; H = 8; }
            const bool isn = (ty != 2) && (ty != 5);
            float ss = 0.f;
#pragma unroll
            for (int k = 0; k < 8; ++k) ss += x[k] * x[k];
            ss += sx<1>(ss); ss += sx<2>(ss); ss += sx<4>(ss); ss += sx<8>(ss);
            const float rstd = 1.0f / sqrtf(ss * (1.0f / 128.0f) + EPS);
            const float* gp = asg(A.in[ty == 0 ? I_GQC : ty == 1 ? I_GKC : ty == 3 ? I_GQD : I_GKD]) + (size_t)o * 128 + li * 8;
            if (isn) {
                const f32x4 g0 = *(const f32x4*)gp, g1 = *(const f32x4*)(gp + 4);
#pragma unroll
                for (int k = 0; k < 4; ++k) { x[k] = x[k] * rstd * g0[k]; x[4 + k] = x[4 + k] * rstd * g1[k]; }
            }
            if (smp && j <= 2) {
                const int pos = (li < 8) ? prow : pcol; const float* ct = rt + pos * 32 + 8 * (li & 3); const float* st = ct + 2048;
                const bool lo = !(li & 4), dor = ty < 2;
#pragma unroll
                for (int k = 0; k < 8; ++k) { const float xp = sx<4>(x[k]); const float c = ct[k], sn = st[k];
                    const float rr = lo ? (x[k] * c - xp * sn) : (xp * sn + x[k] * c); x[k] = dor ? rr : x[k]; }
            }
            const size_t base = smp ? (ty == 0 ? Q_QCS : ty == 1 ? Q_KCS : ty == 2 ? Q_VCS : ty == 3 ? Q_QDS : ty == 4 ? Q_KDS : Q_VDS)
                                    : (ty == 0 ? Q_QCP : ty == 1 ? Q_KCP : ty == 2 ? Q_VCP : ty == 3 ? Q_QDP : ty == 4 ? Q_KDP : Q_VDP);
            u32x4 ov; ov.x = cvt_pk_bf16(x[0], x[1]); ov.y = cvt_pk_bf16(x[2], x[3]); ov.z = cvt_pk_bf16(x[4], x[5]); ov.w = cvt_pk_bf16(x[6], x[7]);
            *(u32x4*)(qkv + base + ((size_t)(b * H + hd) * S + s) * 128 + li * 8) = ov;
            if (!smp && (ty == 1 || ty == 2 || ty == 4 || ty == 5)) {
                float* sp = asg(A.out) + (ty == 1 ? O_SCK : ty == 2 ? O_SCV : ty == 4 ? O_SDK : O_SDV) + (((size_t)(b * 2 + o) * H + hd) * 256 + s) * 128 + li * 8;
                __builtin_nontemporal_store((f32x4){x[0], x[1], x[2], x[3]}, (f32x4*)sp); __builtin_nontemporal_store((f32x4){x[4], x[5], x[6], x[7]}, (f32x4*)(sp + 4));
            }
        }
    }
}

__device__ __forceinline__ void attn_phase(const Args& A, LAS unsigned char* lds, int G, int o, int wv) {
    const bf16_t* qkv = (const bf16_t*)(ws_opaque(A.ws) + WS_QKV); bf16_t* mixout = (bf16_t*)(ws_opaque(A.ws) + WS_MIXOUT);
    const int c = obid();
    for (int i = 0;; ++i) {
        int u;
        if (G == 256) { if (c < 128) { if (i > 0) break; u = c; } else { if (i >= 4) break; u = 128 + 4 * (c - 128) + i; } }
        else { u = c + i * G; if (u >= 640) break; }
        att::AUnit U;
        if (u < 64) {
            const int b = u >> 5, h = (u >> 2) & 7, qb = u & 3;
            U.q0 = qb * 256; U.kt0 = qb == 0 ? 0 : (qb == 1 ? 0 : (qb == 2 ? 4 : 8)); U.nloc = (qb == 0 || qb == 3) ? 8 : 11; U.nctx = 8; U.nt = 8 + ((U.nloc + 1) & ~1); U.mode = 2;
            U.Q = qkv + Q_QDS + ((size_t)(b * 8 + h) * 1024 + U.q0) * 128; U.O = mixout + (size_t)(MP + b * 1024 + U.q0) * DM + (8 + h) * 128;
            U.Kc = (const bf16_t*)(ws_opaque(A.ws) + WS_CDK) + ((size_t)((b * 2 + o) * 8 + h)) * 512 * 128; U.Vc = (const bf16_t*)(ws_opaque(A.ws) + WS_CDV) + ((size_t)((b * 2 + o) * 8 + h)) * 512 * 128;
            U.Kl = qkv + Q_KDS + ((size_t)(b * 8 + h) * 1024 + U.kt0 * 64) * 128; U.Vl = qkv + Q_VDS + ((size_t)(b * 8 + h) * 1024 + U.kt0 * 64) * 128;
            U.m0 = -1e30f; U.l0 = 0.f; U.rpb = asg(A.in[I_RPB]) + ((size_t)o * 8 + h) * 15 * 31;
        } else if (u < 128) {
            const int v = u - 64, b = v >> 5, h = (v >> 2) & 7, qb = v & 3, kvh = h >> 2;
            U.q0 = qb * 256; const int k_lo = qb == 0 ? 0 : 4 * qb - 2, k_hi = qb == 3 ? 15 : 4 * qb + 5;
            U.kt0 = k_lo; U.nloc = k_hi - k_lo + 1; U.nctx = 8; U.nt = 8 + U.nloc; U.mode = 1;
            U.Q = qkv + Q_QCS + ((size_t)(b * 8 + h) * 1024 + U.q0) * 128; U.O = mixout + (size_t)(MP + b * 1024 + U.q0) * DM + h * 128;
            U.Kc = (const bf16_t*)(ws_opaque(A.ws) + WS_CCK) + ((size_t)((b * 2 + o) * 2 + kvh)) * 512 * 128; U.Vc = (const bf16_t*)(ws_opaque(A.ws) + WS_CCV) + ((size_t)((b * 2 + o) * 2 + kvh)) * 512 * 128;
            U.Kl = qkv + Q_KCS + ((size_t)(b * 2 + kvh) * 1024 + U.kt0 * 64) * 128; U.Vl = qkv + Q_VCS + ((size_t)(b * 2 + kvh) * 1024 + U.kt0 * 64) * 128;
            U.m0 = asg(A.in[I_SINK])[o * 8 + h] * (1.0f / att::SCALE); U.l0 = 1.f; U.rpb = nullptr;
        } else {
            const int v = u - 128, b = v >> 4, hh = v & 15;
            U.q0 = 0; U.kt0 = 0; U.nloc = 0; U.nctx = 4; U.nt = 4; U.mode = 0; U.rpb = nullptr; U.Kl = nullptr; U.Vl = nullptr;
            U.O = mixout + (size_t)(b * 256) * DM + hh * 128;
            if (hh < 8) { const int kvh = hh >> 2;
                U.Q = qkv + Q_QCP + ((size_t)(b * 8 + hh) * 256) * 128; U.Kc = qkv + Q_KCP + ((size_t)(b * 2 + kvh) * 256) * 128; U.Vc = qkv + Q_VCP + ((size_t)(b * 2 + kvh) * 256) * 128;
                U.m0 = asg(A.in[I_SINK])[o * 8 + hh] * (1.0f / att::SCALE); U.l0 = 1.f; }
            else { const int h = hh - 8;
                U.Q = qkv + Q_QDP + ((size_t)(b * 8 + h) * 256) * 128; U.Kc = qkv + Q_KDP + ((size_t)(b * 8 + h) * 256) * 128; U.Vc = qkv + Q_VDP + ((size_t)(b * 8 + h) * 256) * 128;
                U.m0 = -1e30f; U.l0 = 0.f; }
        }
        att::attn_unit(U, (char*)lds, wv);
    }
}

#ifndef ONLY_PH
#define ONLY_PH (-1)
#endif
#define PH(n) (ONLY_PH < 0 || ONLY_PH == (n))
#ifndef DUPMASK
#define DUPMASK 0
#endif
#define DUPN(g) (((DUPMASK >> (g)) & 1) ? 2 : 1)
#define TSMULT 8
#define TS0() do { if (ts_on) ts_t0 = __builtin_amdgcn_s_memrealtime(); } while (0)
#define TSC0() do { if (((TSMASK >> 13) & 1) && ts_on) ts_c0 = (unsigned long long)__builtin_readcyclecounter(); } while (0)
#define TSC1() do { if (((TSMASK >> 13) & 1) && ts_on) { const unsigned long long d_ = (unsigned long long)__builtin_readcyclecounter() - ts_c0; TSACC[0] += (unsigned)(d_ / 20ull); } } while (0)
#define TS1(g) do { if (((TSMASK >> (g)) & 1) && ts_on) { const unsigned long long d_ = __builtin_amdgcn_s_memrealtime() - ts_t0; TSACC[0] += (unsigned)d_; } } while (0)
__global__ void __launch_bounds__(NTHR, 2) mega_fwd(Args args) {
    extern __shared__ __attribute__((aligned(16))) unsigned char lds_raw[];
    LAS unsigned char* lds = (LAS unsigned char*)lds_raw;
    const int G = gridDim.x, wv = __builtin_amdgcn_readfirstlane((int)(threadIdx.x >> 6));
    volatile LAS unsigned* MISC = (volatile LAS unsigned*)(lds + LDS_MISC);
    { const int t0 = ptid(wv); if (t0 < 16) MISC[t0] = 0u; }
    __syncthreads();
#define WSB ws_opaque(args.ws)
    const bool ts_on = (TSMASK != 0 || TSBAR != 0) && (blockIdx.x == 0) && (wv == 0); unsigned long long ts_t0 = 0, ts_c0 = 0; (void)ts_c0; volatile LAS unsigned* TSACC = MISC + 2; (void)ts_on; (void)ts_t0; (void)TSACC;
    XcdBarrier bar = xcd_barrier_post((unsigned*)(WSB + WS_CTL), MISC + 8, ptid(wv));
    const float* mods = (const float*)(WSB + WS_MODS);

    int ql = 1, nbar = 0; int lok = 0; int gx = 0, grk = 0;
#ifndef LOCAL_BAR
#define LOCAL_BAR 1
#endif
#define BARRIER2(g, loc) do { TS0(); \
    if (LOCAL_BAR && (loc) && lok) { local_barrier((unsigned*)(WSB + WS_CTL), (unsigned*)(WSB + WS_CTL) + 8192 + 64 * (20 + gx), 32u, wv); } \
    else { fill_wait(args, lds, G, wv, nbar, ql); for (int br_ = 0; br_ < DUPN(10); ++br_) { xcd_barrier(bar, wv); ++nbar; } } \
    TS1(10); if (((TSBAR >> (g)) & 1) && ts_on) { TSACC[0] += (unsigned)(__builtin_amdgcn_s_memrealtime() - ts_t0); } } while (0)
#define BARRIER(g) BARRIER2(g, false)
    for (int rep = 0; rep < DUPN(0); ++rep) { TS0(); if (PH(0)) prologue_a(args, lds, G, wv); TS1(0); BARRIER(0); }
    if (ptid(wv) == 0) { unsigned* barw = (unsigned*)(WSB + WS_CTL); const unsigned myx = MISC[11]; unsigned npop = 0u, below = 0u; bool uni = (G == 256);
        for (unsigned j = 0; j < 16; ++j) { const unsigned cnt = xb_ld(&barw[XB_XCNT(j)]); if (cnt) { ++npop; if (j < myx) ++below; if (cnt != 32u) uni = false; } }
        uni = uni && (npop == 8u); MISC[12] = below; MISC[13] = uni ? 1u : 0u; }
    __syncthreads();
    lok = __builtin_amdgcn_readfirstlane((int)MISC[13]); asm volatile("" : "+s"(lok));
    gx = lok ? __builtin_amdgcn_readfirstlane((int)MISC[12]) : (int)(blockIdx.x & 7);
    grk = lok ? __builtin_amdgcn_readfirstlane((int)MISC[10]) : (int)(blockIdx.x >> 3);
    TS0(); if (PH(1)) prologue_b(args, lds, G, wv); TS1(11);
    BARRIER(11);

    for (int layer = 0; layer < 4; ++layer) {
        const bf16_t* wl = (const bf16_t*)(WSB + WS_W) + (size_t)layer * W_LAYER;
        const bool odd = layer & 1; const int eo = layer >> 1;
        for (int rep = 0; rep < DUPN(5); ++rep) {
            TS0(); if (PH(2)) nm_phase(args, G, layer == 0 && rep == 0, layer > 0 && rep == 0, 0.5f, layer - 1, 8, true, asg(args.in[I_GF1]) + (size_t)layer * DM, layer, 0, wv, true, gx, grk); TS1(5);
            BARRIER2(5, true); }
        for (int rep = 0; rep < DUPN(1); ++rep) {
            TS0(); TSC0(); if (PH(3)) { pg8::SchedStd S{(const char*)(WSB + WS_H), (const char*)(wl + W_GU1), DM, DM, DM / 128, MTOT / 256, NGU / 256, (MTOT / 256) * (NGU / 256), G, obid(), (char*)(WSB + WS_ACT), DFF, 128, gx, grk};
              pg8::EpiGU8 E{(const float*)(WSB + WS_RSC), (const float*)(WSB + WS_CMAX) + (size_t)(layer * 2 + 0) * NGU}; pg8::gemm_phase<pg8::EpiGU8, pg8::SchedStd, G_ALIGN, G_SP2, true>(lds, S, E, wv); } TS1(1); TSC1();
            BARRIER2(1, true); }
        for (int rep = 0; rep < DUPN(2); ++rep) {
            TS0(); if (PH(4)) { q8act_phase(args, wv, gx, grk); BARRIER2(2, true);
              pg8::SchedSplit S{(const char*)(WSB + WS_ACT8), (const char*)(wl + W_DN1), KD8, KD8, KD8 / 128, 12, G, obid(), gx, grk};
              pg8::EpiResid8 E{(bf16_t*)(WSB + WS_XB), mods + ((size_t)layer * 3) * NMODV + 2 * DM, rep == 0 ? 0.5f : 0.0f, (float*)(WSB + WS_SLAB), (const float*)(WSB + WS_RSC2), (const float*)(WSB + WS_CMAX2) + (size_t)(layer * 2 + 0) * DM, nullptr};
              pg8::gemm_phase<pg8::EpiResid8, pg8::SchedSplit, G_ALIGN, G_SP2, true>(lds, S, E, wv); } TS1(2);
            BARRIER2(2, true); }
        for (int rep = 0; rep < DUPN(5); ++rep) {
            TS0(); if (PH(5)) nm_phase(args, G, false, rep == 0, 0.5f, layer, 2, true, asg(args.in[I_GMIX]) + (size_t)layer * DM, layer, 3, wv, false, gx, grk); TS1(5);
            BARRIER2(5, true); }
        for (int rep = 0; rep < DUPN(3); ++rep) {
            TS0(); if (PH(6)) { const int nin = odd ? NIN_O : NIN_E;
              pg8::SchedStd S{(const char*)(WSB + WS_H), (const char*)(wl + W_IN), DM * 2, DM * 2, DM / 64, MTOT / 256, nin / 256, (MTOT / 256) * (nin / 256), G, obid(), (char*)(WSB + WS_MIXIN), nin, 256, gx, grk};
              pg8::EpiBf16 E{1.0f};
              pg8::gemm_phase<pg8::EpiBf16, pg8::SchedStd, G_ALIGN, G_SP2>(lds, S, E, wv); } TS1(3);
            BARRIER2(3, odd); }
        if (!odd) {
            for (int rep = 0; rep < DUPN(6); ++rep) {
                TS0(); if (PH(7)) { pg8::SchedF1 S{(const char*)(WSB + WS_T256), (const char*)(WSB + WS_MIXIN), (char*)(WSB + WS_GT), (char*)(WSB + WS_GTS), 512, NIN_E * 2, G, obid()};
                  pg8::EpiBf16 E{1.0f};
                  pg8::gemm_phase<pg8::EpiBf16, pg8::SchedF1, G_ALIGN, G_SP2>(lds, S, E, wv); }
                vstat_phase(args, G, wv); TS1(6);
                BARRIER(6); }
            for (int rep = 0; rep < DUPN(7); ++rep) {
                TS0(); if (PH(9)) { pg8::SchedF2 S{(const char*)(WSB + WS_CS256), (const char*)(WSB + WS_CS1024), (const char*)(WSB + WS_GT), (const char*)(WSB + WS_GTS), (char*)(WSB + WS_MIXOUT), 4096, 4096, G, obid()};
                  pg8::EpiF2 E2;
                  pg8::gemm_phase<pg8::EpiF2, pg8::SchedF2, G_ALIGN, G_SP2>(lds, S, E2, wv); }
                if (PH(8)) sgu_phase(args, lds, G, eo, wv); TS1(7);
                }
        } else {
            for (int rep = 0; rep < DUPN(8); ++rep) { TS0(); if (PH(10)) prep_phase(args, G, eo, wv, gx, grk); TS1(8); BARRIER(8); }
            for (int rep = 0; rep < DUPN(9); ++rep) { TS0(); if (PH(11)) attn_phase(args, lds, G, eo, wv); TS1(9); }
        }
        if (layer < 3) { while (fill_round(args, lds, layer + 1, wv)) {} if (ql <= layer + 1) ql = layer + 2; }
        BARRIER(9);
        for (int rep = 0; rep < DUPN(4); ++rep) {
            TS0(); if (PH(12)) { pg8::SchedSplit S{(const char*)(WSB + WS_MIXOUT), (const char*)(wl + W_OUT), DM * 2, DM * 2, DM / 64, 8, G, obid(), gx, grk};
              pg8::EpiResid E{(bf16_t*)(WSB + WS_XB), mods + ((size_t)layer * 3) * NMODV + 5 * DM, rep == 0 ? 1.0f : 0.0f, (float*)(WSB + WS_SLAB)};
              pg8::gemm_phase<pg8::EpiResid, pg8::SchedSplit, G_ALIGN, G_SP2>(lds, S, E, wv); } TS1(4);
            BARRIER2(4, true); }
        for (int rep = 0; rep < DUPN(5); ++rep) {
            TS0(); if (PH(13)) nm_phase(args, G, false, rep == 0, 1.0f, layer, 5, true, asg(args.in[I_GF2]) + (size_t)layer * DM, layer, 6, wv, true, gx, grk); TS1(5);
            BARRIER2(5, true); }
        for (int rep = 0; rep < DUPN(1); ++rep) {
            TS0(); TSC0(); if (PH(14)) { pg8::SchedStd S{(const char*)(WSB + WS_H), (const char*)(wl + W_GU2), DM, DM, DM / 128, MTOT / 256, NGU / 256, (MTOT / 256) * (NGU / 256), G, obid(), (char*)(WSB + WS_ACT), DFF, 128, gx, grk};
              pg8::EpiGU8 E{(const float*)(WSB + WS_RSC), (const float*)(WSB + WS_CMAX) + (size_t)(layer * 2 + 1) * NGU}; pg8::gemm_phase<pg8::EpiGU8, pg8::SchedStd, G_ALIGN, G_SP2, true>(lds, S, E, wv); } TS1(1); TSC1();
            BARRIER2(1, true); }
        for (int rep = 0; rep < DUPN(2); ++rep) {
            TS0(); if (PH(15)) { q8act_phase(args, wv, gx, grk); BARRIER2(2, true);
              pg8::SchedSplit S{(const char*)(WSB + WS_ACT8), (const char*)(wl + W_DN2), KD8, KD8, KD8 / 128, 12, G, obid(), gx, grk};
              pg8::EpiResid8 E{(bf16_t*)(WSB + WS_XB), mods + ((size_t)layer * 3) * NMODV + 8 * DM, rep == 0 ? 0.5f : 0.0f, (float*)(WSB + WS_SLAB), (const float*)(WSB + WS_RSC2), (const float*)(WSB + WS_CMAX2) + (size_t)(layer * 2 + 1) * DM, layer == 3 ? asg(args.out) : nullptr};
              pg8::gemm_phase<pg8::EpiResid8, pg8::SchedSplit, G_ALIGN, G_SP2, true>(lds, S, E, wv); } TS1(2);
            BARRIER2(2, true); }
    }
    TS0(); if (PH(16)) nm_phase(args, G, false, true, 0.5f, 3, 8, false, nullptr, 0, 0, wv, false, gx, grk); TS1(11);
    if (ts_on) { const unsigned long long te_ = __builtin_amdgcn_s_memrealtime() + (unsigned long long)TSMULT * TSACC[0]; while (__builtin_amdgcn_s_memrealtime() < te_) __builtin_amdgcn_s_sleep(8); }
#undef BARRIER
}

extern "C" void kernel_launch(void* const* d_in, const int* in_sizes, int n_in, void* d_out, int out_size, void* d_ws, size_t ws_size, hipStream_t stream) {
    static int grid = 0;
    if (grid == 0) {
        if (n_in != 29 || (size_t)out_size != O_END || ws_size < WS_END) {
            fprintf(stderr, "kernel_launch: unexpected shapes: n_in %d out %d ws %zu (need %zu)\n", n_in, out_size, ws_size, (size_t)WS_END); grid = -1; return; }
        int dev = 0, cus = 0, per_cu = 0;
        if (hipGetDevice(&dev) != hipSuccess || hipDeviceGetAttribute(&cus, hipDeviceAttributeMultiprocessorCount, dev) != hipSuccess) { grid = -1; return; }
        if (hipFuncSetAttribute((const void*)mega_fwd, hipFuncAttributeMaxDynamicSharedMemorySize, LDS_BYTES) != hipSuccess) { fprintf(stderr, "kernel_launch: hipFuncSetAttribute failed\n"); grid = -1; return; }
        if (hipOccupancyMaxActiveBlocksPerMultiprocessor(&per_cu, (const void*)mega_fwd, NTHR, LDS_BYTES) != hipSuccess || per_cu < 1)
            fprintf(stderr, "kernel_launch: occupancy query reports %d\n", per_cu);
        (void)hipGetLastError();
        if (cus != 256) { fprintf(stderr, "kernel_launch: built for a 256-CU device (8 groups of 32 workgroups), found %d CUs; nothing launched\n", cus); grid = -1; return; }
        grid = cus;
    }
    if (grid < 0) return;
    if (hipMemsetAsync((char*)d_ws + WS_CTL, 0, CTL_ZERO_BYTES, stream) != hipSuccess) { fprintf(stderr, "kernel_launch: memset failed\n"); return; }
    Args a{};
    for (int i = 0; i < 29; ++i) a.in[i] = (const float*)d_in[i];
    a.out = (float*)d_out; a.ws = (unsigned char*)d_ws;
    hipLaunchKernelGGL(mega_fwd, dim3(grid), dim3(NTHR), LDS_BYTES, stream, a);
    const hipError_t le = hipPeekAtLastError();
    if (le != hipSuccess) fprintf(stderr, "kernel_launch: launch failed: %s\n", hipGetErrorName(le));
}
```

```cpp
#include <hip/hip_runtime.h>
#include <cstdio>
#include <cstdint>

#define LAS __attribute__((address_space(3)))
#define GAS __attribute__((address_space(1)))
typedef unsigned short bf16_t;
typedef short bf16x8 __attribute__((ext_vector_type(8)));
typedef short s16x4 __attribute__((ext_vector_type(4)));
typedef float f32x2 __attribute__((ext_vector_type(2)));
typedef float f32x4 __attribute__((ext_vector_type(4)));
typedef float f32x8 __attribute__((ext_vector_type(8)));
typedef float f32x16 __attribute__((ext_vector_type(16)));
typedef unsigned u32x2 __attribute__((ext_vector_type(2)));
typedef unsigned u32x4 __attribute__((ext_vector_type(4)));
typedef int i32x4 __attribute__((ext_vector_type(4)));

#ifndef TSMASK
#define TSMASK 0
#endif
#ifndef TSBAR
#define TSBAR 0
#endif
constexpr int DM = 2048, MP = 8192, MS = 2048, MTOT = 10240, DFF = 5504, NGU = 11008, NIN_E = 3072, NIN_O = 4608, NMODV = 18432;
constexpr float EPS = 1e-6f;
constexpr int NWAVES = 8, NTHR = 512;
#ifndef G_ALIGN
#define G_ALIGN true
#endif
#ifndef G_SP2
#define G_SP2 true
#endif

constexpr size_t MiB = 1u << 20;
constexpr size_t WS_CTL = 0, CTL_ZERO_BYTES = 1024 * 1024;
constexpr size_t WS_CMAX = 512 * 1024;
constexpr size_t WS_MODS = 1 * MiB;
constexpr size_t WS_ADAP = 2 * MiB;
constexpr size_t WS_SSQ_OLD = 6 * MiB;
constexpr size_t WS_RSC = 6 * MiB + 704 * 1024;
constexpr size_t WS_RSC2 = 6 * MiB + 768 * 1024;
constexpr size_t WS_CMAX2 = 6 * MiB + 832 * 1024;
constexpr size_t WS_T256 = 7 * MiB;
constexpr size_t WS_ROPE = WS_T256 + 262144;
constexpr size_t WS_WSGU = 8 * MiB;
constexpr size_t WS_CS1024 = 9 * MiB;
constexpr size_t WS_CS256 = 23 * MiB;
constexpr size_t WS_CCK = 13 * MiB;
constexpr size_t WS_CCV = 14 * MiB, WS_CDK = 15 * MiB, WS_CDV = 19 * MiB;
constexpr size_t WS_H = 24 * MiB;
constexpr size_t WS_ACT = 64 * MiB;
constexpr size_t WS_MIXIN = 172 * MiB;
constexpr size_t WS_MIXOUT = 262 * MiB;
constexpr size_t WS_SLAB = 302 * MiB;
constexpr size_t WS_GT = 366 * MiB;
constexpr size_t WS_GTS = WS_GT + 128 * MiB;
constexpr size_t WS_QKV = 366 * MiB;
constexpr size_t WS_W = 502 * MiB;
constexpr size_t W_GU1 = 0, W_DN1 = (size_t)NGU * DM, W_GU2 = W_DN1 + (size_t)DM * DFF, W_DN2 = W_GU2 + (size_t)NGU * DM, W_OUT = W_DN2 + (size_t)DM * DFF,
                 W_IN = W_OUT + (size_t)DM * DM, W_LAYER = W_IN + (size_t)NIN_O * DM;
constexpr size_t WS_ACT8 = WS_W + 4 * W_LAYER * 2;
constexpr int KD8 = 5632;
constexpr size_t WS_SSQ = WS_ACT8 + (size_t)MTOT * KD8;
constexpr size_t WS_XB = (WS_SSQ + (size_t)MTOT * 4 + 4095) & ~(size_t)4095;
constexpr size_t WS_END = WS_XB + (size_t)MTOT * DM * 2;
constexpr size_t Q_QCP = 0, Q_KCP = Q_QCP + (size_t)MP * 1024, Q_VCP = Q_KCP + (size_t)MP * 256, Q_QDP = Q_VCP + (size_t)MP * 256, Q_KDP = Q_QDP + (size_t)MP * 1024,
                 Q_VDP = Q_KDP + (size_t)MP * 1024, Q_QCS = Q_VDP + (size_t)MP * 1024, Q_KCS = Q_QCS + (size_t)MS * 1024, Q_VCS = Q_KCS + (size_t)MS * 256,
                 Q_QDS = Q_VCS + (size_t)MS * 256, Q_KDS = Q_QDS + (size_t)MS * 1024, Q_VDS = Q_KDS + (size_t)MS * 1024, Q_END = Q_VDS + (size_t)MS * 1024;
static_assert(WS_QKV + Q_END * 2 <= WS_W, "qkv region");
constexpr size_t O_YP = 0, O_YS = (size_t)MP * DM, O_SCK = O_YS + (size_t)MS * DM, O_SCV = O_SCK + (size_t)32 * 2 * 2 * 256 * 128, O_SDK = O_SCV + (size_t)32 * 2 * 2 * 256 * 128,
                 O_SDV = O_SDK + (size_t)32 * 2 * 8 * 256 * 128, O_END = O_SDV + (size_t)32 * 2 * 8 * 256 * 128;

constexpr int LDS_BYTES = 147456;
constexpr int LDS_MISC = 135168;

#define LDS_WAIT() asm volatile("s_waitcnt lgkmcnt(0)" ::: "memory")
#define VM_WAIT() asm volatile("s_waitcnt vmcnt(0)" ::: "memory")
__device__ __forceinline__ unsigned f2bf(float f) { unsigned u = __builtin_bit_cast(unsigned, f); return (u + 0x7fffu + ((u >> 16) & 1u)) >> 16; }
__device__ __forceinline__ unsigned pk2(float lo, float hi) { return f2bf(lo) | (f2bf(hi) << 16); }
__device__ __forceinline__ unsigned cvt_pk_bf16(float lo, float hi) { unsigned r; asm volatile("v_cvt_pk_bf16_f32 %0, %1, %2" : "=v"(r) : "v"(lo), "v"(hi)); return r; }
typedef __bf16 bf16x2_t __attribute__((ext_vector_type(2)));
__device__ __forceinline__ unsigned cvt_pk_bf16_b(float lo, float hi) { f32x2 v = {lo, hi}; bf16x2_t b = __builtin_convertvector(v, bf16x2_t); return __builtin_bit_cast(unsigned, b); }
__device__ __forceinline__ float bf_lo(unsigned w) { return __uint_as_float(w << 16); }
__device__ __forceinline__ float bf_hi(unsigned w) { return __uint_as_float(w & 0xffff0000u); }
__device__ __forceinline__ int ptid(int wv) { unsigned z = 0u; asm volatile("" : "+v"(z)); int t = wv * 64 + (int)__builtin_amdgcn_mbcnt_hi(~0u, __builtin_amdgcn_mbcnt_lo(~0u, z)); asm volatile("" : "+v"(t)); return t; }
template <class T> __device__ __forceinline__ T* asg(T* p) { const unsigned long long v = (unsigned long long)p; return (T*)(__attribute__((address_space(1))) T*)v; }
__device__ __forceinline__ unsigned char* ws_opaque(unsigned char* p) { unsigned long long v = (unsigned long long)p; asm volatile("" : "+s"(v)); return (unsigned char*)(__attribute__((address_space(1))) unsigned char*)v; }
__device__ __forceinline__ int obid() { int b = (int)blockIdx.x; asm volatile("" : "+s"(b)); return b; }
template <int M> __device__ __forceinline__ float sx(float v) { return __int_as_float(__builtin_amdgcn_ds_swizzle(__float_as_int(v), (M << 10) | 0x1f)); }
__device__ __forceinline__ float sum32(float v) { auto rr = __builtin_amdgcn_permlane32_swap(__float_as_uint(v), __float_as_uint(v), false, false); return __uint_as_float(rr[0]) + __uint_as_float(rr[1]); }
__device__ __forceinline__ float max32(float v) { auto rr = __builtin_amdgcn_permlane32_swap(__float_as_uint(v), __float_as_uint(v), false, false); return fmaxf(__uint_as_float(rr[0]), __uint_as_float(rr[1])); }
__device__ __forceinline__ float wave_sum(float v) { v += sx<1>(v); v += sx<2>(v); v += sx<4>(v); v += sx<8>(v); v += sx<16>(v); return sum32(v); }
__device__ __forceinline__ float wave_max(float v) { v = fmaxf(v, sx<1>(v)); v = fmaxf(v, sx<2>(v)); v = fmaxf(v, sx<4>(v)); v = fmaxf(v, sx<8>(v)); v = fmaxf(v, sx<16>(v)); return max32(v); }

#define XB_TMO      128
#define XB_XCNT(j)  (256  + 64 * (j))
#define XB_XSUB(j)  (1280 + 64 * (j))
#define XB_XGEN(j)  (2304 + 64 * (j))
#define XB_TOP      3328
#define XB_TOPGEN   3392
#define XCD_BAR_WORDS 3456
#define XB_SPIN_CAP (1u << 18)
__device__ __forceinline__ unsigned xb_ld(unsigned* p)              { return __hip_atomic_load(p, __ATOMIC_RELAXED, __HIP_MEMORY_SCOPE_AGENT); }
__device__ __forceinline__ unsigned xb_add(unsigned* p, unsigned v) { return __hip_atomic_fetch_add(p, v, __ATOMIC_RELAXED, __HIP_MEMORY_SCOPE_AGENT); }
__device__ __forceinline__ unsigned xb_xcc_id() { return (unsigned)__builtin_amdgcn_s_getreg((3 << 11) | 20) & 0xFu; }
#define XB_SPIN(cond, bar) do { unsigned _sp = 0; while (cond) { __builtin_amdgcn_s_sleep(1); \
    if ((++_sp & 255u) == 0u) { if (xb_ld(&(bar)[XB_TMO])) break; if (_sp > XB_SPIN_CAP) { atomicAdd(&(bar)[XB_TMO], 1u); break; } } } } while (0)
struct XcdBarrier { unsigned* bar; unsigned x; volatile LAS unsigned* st; };
__device__ __forceinline__ XcdBarrier xcd_barrier_post(unsigned* bar, volatile LAS unsigned* st, int tid) {
    XcdBarrier b; b.bar = bar; b.x = 0; b.st = st;
    if (tid == 0) { const unsigned xcc = xb_xcc_id(); st[2] = xb_add(&bar[XB_XCNT(xcc)], 1u); st[3] = xcc; }
    return b;
}
__device__ __forceinline__ void xcd_barrier_complete(unsigned* bar, unsigned x, unsigned& nloc, unsigned& nx) {
    const unsigned G = gridDim.x * gridDim.y * gridDim.z;
    unsigned sum, cnt, mine, sp = 0u;
    for (;;) {
        sum = 0u; cnt = 0u; mine = 0u;
#pragma unroll
        for (unsigned j = 0; j < 16; ++j) { const unsigned c = xb_ld(&bar[XB_XCNT(j)]); sum += c; cnt += (c > 0u) ? 1u : 0u; mine = (j == x) ? c : mine; }
        if (sum == G) break;
        __builtin_amdgcn_s_sleep(1);
        if ((++sp & 255u) == 0u) { if (xb_ld(&bar[XB_TMO])) break; if (sp > XB_SPIN_CAP) { atomicAdd(&bar[XB_TMO], 1u); break; } }
    }
    nloc = mine > 0u ? mine : 1u; nx = cnt > 0u ? cnt : 1u;
}
__device__ __forceinline__ void xcd_barrier(const XcdBarrier& b, int wv) {
    asm volatile("s_waitcnt vmcnt(0)" ::: "memory");
    __syncthreads();
    if (ptid(wv) == 0) {
        unsigned* bar = b.bar; const unsigned bx = xb_xcc_id();
        __builtin_amdgcn_s_waitcnt(0);
        unsigned nloc = b.st[0], nx = b.st[1];
        if (nloc == 0u) { xcd_barrier_complete(bar, bx, nloc, nx); b.st[0] = nloc; b.st[1] = nx; }
        const unsigned old = xb_add(&bar[XB_XSUB(bx)], 1u);
        const unsigned gen = old / nloc;
        if (old + 1u == (gen + 1u) * nloc) {
            __builtin_amdgcn_fence(__ATOMIC_RELEASE, "agent");
            asm volatile("s_waitcnt vmcnt(0)" ::: "memory");
            const unsigned og = xb_add(&bar[XB_TOP], 1u);
            const unsigned tg = og / nx;
            if (og + 1u == (tg + 1u) * nx) xb_add(&bar[XB_TOPGEN], 1u);
            else XB_SPIN(xb_ld(&bar[XB_TOPGEN]) == tg, bar);
            __builtin_amdgcn_fence(__ATOMIC_ACQUIRE, "agent");
            xb_add(&bar[XB_XGEN(bx)], 1u);
            asm volatile("s_waitcnt vmcnt(0)" ::: "memory");
        } else {
            XB_SPIN(xb_ld(&bar[XB_XGEN(bx)]) == gen, bar);
            __builtin_amdgcn_fence(__ATOMIC_ACQUIRE, "agent");
            asm volatile("s_waitcnt vmcnt(0)" ::: "memory");
        }
    }
    __syncthreads();
}

__device__ __forceinline__ void local_barrier(unsigned* bar, unsigned* lb, unsigned gsize, int wv) {
    asm volatile("s_waitcnt vmcnt(0)" ::: "memory");
    __syncthreads();
    if (ptid(wv) == 0) {
        __builtin_amdgcn_s_waitcnt(0);
        const unsigned old = xb_add(lb, 1u), target = (old / gsize + 1u) * gsize;
        XB_SPIN(xb_ld(lb) < target, bar);
        __builtin_amdgcn_fence(__ATOMIC_ACQUIRE, "agent");
        asm volatile("s_waitcnt vmcnt(0)" ::: "memory");
    }
    __syncthreads();
}

namespace pg8 {
constexpr int BM = 256, BK = 64, HALF = 128, HTB = HALF * BK * 2, STAGE_BYTES = 8 * HTB;
__device__ __forceinline__ int lds_byte(int r, int c) { const int st = (r >> 4) * 2 + (c >> 5), rr = r & 15, cc = c & 31, ob = rr * 64 + cc * 2; return st * 1024 + (ob ^ (((ob >> 9) & 1) << 5)); }
__device__ __forceinline__ void stage_rc(int b, int& R, int& C) { const int st = b / 1024, sb = b % 1024, swz = sb ^ (((sb >> 9) & 1) << 5); R = (st >> 1) * 16 + swz / 64; C = (st & 1) * 32 + (swz % 64) / 2; }
__device__ __forceinline__ int perm32(int rho) { const int n = rho >> 4, i = rho & 15; return 8 * (i >> 2) + 4 * n + (i & 3); }

struct GUnit { const char* a; const char* b; int nt; int pm, pn, ks; };

template <bool I8> struct AccT { typedef f32x4 T; };
template <> struct AccT<true> { typedef i32x4 T; };
template <class Epi, class Sched, bool ALIGN_EPI, bool SP2, bool I8 = false>
__device__ __forceinline__ void gemm_phase(LAS unsigned char* lds, const Sched& S, const Epi& E, int wv) {
    const int tid = ptid(wv);
    const int wid = wv, lane = tid & 63, wr = wid >> 2, wc = wid & 3, fr = lane & 15, fq = lane >> 4;
    unsigned cvA0, cvA1, cvB0, cvB1;
    { int R0, C0, R1, C1; stage_rc(tid * 16, R0, C0); stage_rc(tid * 16 + 8192, R1, C1);
      const int Rb0 = Epi::PERM ? ((R0 & ~31) + perm32(R0 & 31)) : R0, Rb1 = Epi::PERM ? ((R1 & ~31) + perm32(R1 & 31)) : R1;
      cvA0 = (unsigned)(R0 * S.lda2 + C0 * 2); cvA1 = (unsigned)(R1 * S.lda2 + C1 * 2); cvB0 = (unsigned)(Rb0 * S.ldb2 + C0 * 2); cvB1 = (unsigned)(Rb1 * S.ldb2 + C1 * 2); }
    const unsigned ldsw = (unsigned)wid * 1024u;
    const int aoff = lds_byte(wr * 64 + fr, fq * 8), boff = lds_byte(wc * 32 + fr, fq * 8);
#define PG8_SA(b, h) (((b) * 2 + (h)) * HTB)
#define PG8_SB(b, h) ((4 + (b) * 2 + (h)) * HTB)
#define PG8_STAGE(bufoff, gbase, v0, v1) do { \
        __builtin_amdgcn_global_load_lds((const unsigned*)((const char*)(gbase) + (v0)), (LAS unsigned*)(lds + (bufoff) + ldsw), 16, 0, 0); \
        __builtin_amdgcn_global_load_lds((const unsigned*)((const char*)(gbase) + (v1)), (LAS unsigned*)(lds + (bufoff) + ldsw + 8192), 16, 0, 0); } while (0)
#define PG8_LDA(dst, b, h) do { _Pragma("unroll") for (int m = 0; m < 4; ++m) _Pragma("unroll") for (int k = 0; k < 2; ++k) dst[m][k] = *(const LAS bf16x8*)(lds + PG8_SA(b, h) + aoff + m * 2048 + k * 1024); } while (0)
#define PG8_LDB(dst, b, h) do { _Pragma("unroll") for (int n = 0; n < 2; ++n) _Pragma("unroll") for (int k = 0; k < 2; ++k) dst[n][k] = *(const LAS bf16x8*)(lds + PG8_SB(b, h) + boff + n * 2048 + k * 1024); } while (0)
#define PG8_MMA(ai, bj, At, Bt) do { __builtin_amdgcn_s_setprio(1); _Pragma("unroll") for (int m = 0; m < 4; ++m) _Pragma("unroll") for (int n = 0; n < 2; ++n) _Pragma("unroll") for (int k = 0; k < 2; ++k) { \
        if constexpr (I8) acc[ai][bj][m][n] = __builtin_amdgcn_mfma_i32_16x16x64_i8(__builtin_bit_cast(i32x4, Bt[n][k]), __builtin_bit_cast(i32x4, At[m][k]), acc[ai][bj][m][n], 0, 0, 0); \
        else acc[ai][bj][m][n] = __builtin_amdgcn_mfma_f32_16x16x32_bf16(Bt[n][k], At[m][k], acc[ai][bj][m][n], 0, 0, 0); } __builtin_amdgcn_s_setprio(0); } while (0)
#define PG8_WAIT_V(n) asm volatile("s_waitcnt vmcnt(" #n ")" ::: "memory")
#define PG8_WAIT_L(n) asm volatile("s_waitcnt lgkmcnt(" #n ")" ::: "memory")
#define PG8_BAR __builtin_amdgcn_s_barrier()
#define PG8_SCHED __builtin_amdgcn_sched_barrier(0)
    GUnit cur, nxt; int ui = 0;
    if (!S.next(0, cur)) return;
    typedef typename AccT<I8>::T acc_t;
    acc_t acc[2][2][4][2];
    acc_t zz = (acc_t){0, 0, 0, 0}; asm volatile("" : "+v"(zz));
#pragma unroll
    for (int a = 0; a < 2; ++a)
#pragma unroll
        for (int b = 0; b < 2; ++b)
#pragma unroll
            for (int m = 0; m < 4; ++m)
#pragma unroll
                for (int n = 0; n < 2; ++n) acc[a][b][m][n] = zz;
    bf16x8 At[4][2], B0[2][2], B1[2][2];
    const size_t chA = (size_t)HALF * S.lda2, chB = (size_t)HALF * S.ldb2;
    const size_t kstep = (size_t)(BK * 2);
    const char* cA = cur.a; const char* cB = cur.b;
    if constexpr (SP2) {
        PG8_STAGE(PG8_SB(0, 0), cB, cvB0, cvB1); PG8_STAGE(PG8_SB(0, 1), cB + chB, cvB0, cvB1); PG8_STAGE(PG8_SA(0, 0), cA, cvA0, cvA1); PG8_STAGE(PG8_SA(0, 1), cA + chA, cvA0, cvA1);
        if (wr == 1) PG8_BAR;
        PG8_WAIT_V(2); PG8_BAR;
        PG8_STAGE(PG8_SB(1, 0), cB + kstep, cvB0, cvB1); PG8_STAGE(PG8_SA(1, 0), cA + kstep, cvA0, cvA1); PG8_STAGE(PG8_SB(1, 1), cB + chB + kstep, cvB0, cvB1);
        PG8_WAIT_V(6); PG8_BAR;
    } else {
        PG8_STAGE(PG8_SB(0, 0), cB, cvB0, cvB1); PG8_STAGE(PG8_SA(0, 0), cA, cvA0, cvA1); PG8_STAGE(PG8_SB(0, 1), cB + chB, cvB0, cvB1); PG8_STAGE(PG8_SA(0, 1), cA + chA, cvA0, cvA1);
        if (wr == 1) PG8_BAR;
        PG8_WAIT_V(4); PG8_BAR;
        PG8_STAGE(PG8_SB(1, 0), cB + kstep, cvB0, cvB1); PG8_STAGE(PG8_SA(1, 0), cA + kstep, cvA0, cvA1); PG8_STAGE(PG8_SB(1, 1), cB + chB + kstep, cvB0, cvB1);
        PG8_WAIT_V(6); PG8_BAR;
    }
    for (;;) {
        const bool has_next = S.next(ui + 1, nxt);
        const char* nA = has_next ? nxt.a : cA; const char* nB = has_next ? nxt.b : cB;
        int nt = cur.nt; asm volatile("" : "+s"(nt));
        for (int t = 0; t < nt; t += 2) {
            const bool last = (t == nt - 2);
            const char* a1 = cA + (size_t)(t + 1) * kstep;
            const char* a2 = last ? nA : cA + (size_t)(t + 2) * kstep; const char* b2 = last ? nB : cB + (size_t)(t + 2) * kstep;
            const char* a3 = a2 + kstep; const char* b3 = b2 + kstep;
            if constexpr (SP2) {
            PG8_LDB(B0, 0, 0); PG8_LDB(B1, 0, 1); PG8_SCHED; PG8_LDA(At, 0, 0); PG8_STAGE(PG8_SA(1, 1), a1 + chA, cvA0, cvA1);
            PG8_WAIT_V(8); PG8_WAIT_L(0); PG8_BAR; PG8_MMA(0, 0, At, B0); PG8_MMA(0, 1, At, B1); PG8_BAR; PG8_SCHED;
            PG8_LDA(At, 0, 1); PG8_STAGE(PG8_SB(0, 0), b2, cvB0, cvB1); PG8_STAGE(PG8_SB(0, 1), b2 + chB, cvB0, cvB1); PG8_STAGE(PG8_SA(0, 0), a2, cvA0, cvA1);
            PG8_WAIT_V(8); PG8_WAIT_L(0); PG8_BAR; PG8_MMA(1, 0, At, B0); PG8_MMA(1, 1, At, B1); PG8_BAR; PG8_SCHED;
            PG8_LDB(B0, 1, 0); PG8_LDB(B1, 1, 1); PG8_SCHED; PG8_LDA(At, 1, 0); PG8_STAGE(PG8_SA(0, 1), a2 + chA, cvA0, cvA1);
            PG8_WAIT_V(8); PG8_WAIT_L(0); PG8_BAR; PG8_MMA(0, 0, At, B0); PG8_MMA(0, 1, At, B1); PG8_BAR; PG8_SCHED;
            PG8_LDA(At, 1, 1); PG8_STAGE(PG8_SB(1, 0), b3, cvB0, cvB1); PG8_STAGE(PG8_SB(1, 1), b3 + chB, cvB0, cvB1); PG8_STAGE(PG8_SA(1, 0), a3, cvA0, cvA1);
            PG8_WAIT_V(8); PG8_WAIT_L(0); PG8_BAR; PG8_MMA(1, 0, At, B0); PG8_MMA(1, 1, At, B1); PG8_BAR; PG8_SCHED;
            } else {
            PG8_LDB(B0, 0, 0); PG8_SCHED; PG8_LDA(At, 0, 0); PG8_STAGE(PG8_SA(1, 1), a1 + chA, cvA0, cvA1);
            PG8_WAIT_L(8); PG8_BAR; PG8_WAIT_L(0); PG8_MMA(0, 0, At, B0); PG8_BAR; PG8_SCHED;
            PG8_LDB(B1, 0, 1); PG8_STAGE(PG8_SB(0, 0), b2, cvB0, cvB1);
            PG8_BAR; PG8_WAIT_L(0); PG8_MMA(0, 1, At, B1); PG8_BAR;
            PG8_LDA(At, 0, 1); PG8_STAGE(PG8_SA(0, 0), a2, cvA0, cvA1);
            PG8_BAR; PG8_WAIT_L(0); PG8_MMA(1, 0, At, B0); PG8_BAR; PG8_SCHED;
            PG8_STAGE(PG8_SB(0, 1), b2 + chB, cvB0, cvB1);
            PG8_WAIT_V(6); PG8_BAR; PG8_MMA(1, 1, At, B1); PG8_BAR;
            PG8_LDB(B0, 1, 0); PG8_SCHED; PG8_LDA(At, 1, 0); PG8_STAGE(PG8_SA(0, 1), a2 + chA, cvA0, cvA1);
            PG8_WAIT_L(8); PG8_BAR; PG8_WAIT_L(0); PG8_MMA(0, 0, At, B0); PG8_BAR; PG8_SCHED;
            PG8_LDB(B1, 1, 1); PG8_STAGE(PG8_SB(1, 0), b3, cvB0, cvB1);
            PG8_BAR; PG8_WAIT_L(0); PG8_MMA(0, 1, At, B1); PG8_BAR;
            PG8_LDA(At, 1, 1); PG8_STAGE(PG8_SA(1, 0), a3, cvA0, cvA1);
            PG8_BAR; PG8_WAIT_L(0); PG8_MMA(1, 0, At, B0); PG8_BAR; PG8_SCHED;
            PG8_STAGE(PG8_SB(1, 1), b3 + chB, cvB0, cvB1);
            PG8_WAIT_V(6); PG8_BAR; PG8_MMA(1, 1, At, B1); PG8_BAR;
            }
        }
        unsigned long long te0_ = 0; const bool tse_ = ((TSMASK >> 12) & 1) && blockIdx.x == 0 && wv == 0;
        if (tse_) te0_ = __builtin_amdgcn_s_memrealtime();
        if constexpr (ALIGN_EPI) { if (wr == 0) PG8_BAR; }
        E(acc, cur, S, wr, wc, fr, fq);
        if (tse_) { volatile LAS unsigned* ta_ = (volatile LAS unsigned*)(lds + 135168 + 8); ta_[0] += (unsigned)(__builtin_amdgcn_s_memrealtime() - te0_); }
        if (!has_next) break;
        acc_t z2 = (acc_t){0, 0, 0, 0}; asm volatile("" : "+v"(z2));
#pragma unroll
        for (int a = 0; a < 2; ++a)
#pragma unroll
            for (int b = 0; b < 2; ++b)
#pragma unroll
                for (int m = 0; m < 4; ++m)
#pragma unroll
                    for (int n = 0; n < 2; ++n) acc[a][b][m][n] = z2;
        cur = nxt; cA = nA; cB = nB; ++ui;
        if constexpr (ALIGN_EPI) { if (wr == 1) PG8_BAR; }
    }
    PG8_WAIT_V(0);
    if constexpr (!ALIGN_EPI) { if (wr == 0) PG8_BAR; }
    PG8_BAR;
#undef PG8_SA
#undef PG8_SB
#undef PG8_STAGE
#undef PG8_LDA
#undef PG8_LDB
#undef PG8_MMA
#undef PG8_WAIT_V
#undef PG8_WAIT_L
#undef PG8_BAR
#undef PG8_SCHED
}

struct SchedStd {
    const char* A; const char* Bt; int lda2, ldb2, nt; int nM, nN, nwg, G, c; char* O; int ldc, otile;
    int gx, grk;
    __device__ __forceinline__ bool next(int i, GUnit& u) const {
        if (G == 256) { const int uu = i * 32 + grk; if (uu >= 5 * nN) return false;
            const int pl = uu % 5; u.pm = pl < 4 ? 4 * gx + pl : 32 + gx; u.pn = uu / 5; u.ks = -1;
            u.a = A + (size_t)u.pm * 256 * lda2; u.b = Bt + (size_t)u.pn * 256 * ldb2; u.nt = nt; return true; }
        const long L = (long)i * G + c; if (L >= nwg) return false;
        int wgid = (int)L; { const int q = nwg / 8, r = nwg % 8, xcd = wgid % 8, off = wgid / 8; wgid = (xcd < r ? xcd * (q + 1) : r * (q + 1) + (xcd - r) * q) + off; }
        const int nig = 8 * nN, gid = wgid / nig, fm = gid * 8, gsz = (nM - fm) < 8 ? (nM - fm) : 8;
        u.pm = fm + ((wgid % nig) % gsz); u.pn = (wgid % nig) / gsz; u.ks = -1;
        u.a = A + (size_t)u.pm * 256 * lda2; u.b = Bt + (size_t)u.pn * 256 * ldb2; u.nt = nt;
        return true;
    }
    __device__ __forceinline__ void out(const GUnit& u, char*& o, int& ld) const { o = O + ((size_t)u.pm * 256 * ldc + (size_t)u.pn * otile) * 2; ld = ldc; }
};
struct SchedSplit {
    const char* A; const char* Bt; int lda2, ldb2, ntot, kq; int G, c; int gx, grk;
    __device__ __forceinline__ bool next(int i, GUnit& u) const {
        const int L = i * G + c; if (L >= 512) return false;
        const int Lr = L & 255; int x = Lr & 7, j = Lr >> 3, kt0 = 0;
        if (G == 256) { x = gx; j = grk; }
        if (L < 256) { u.pm = 4 * x + (j >> 3); u.pn = j & 7; u.ks = -1; u.nt = ntot; }
        else { u.pm = 32 + x; u.pn = j & 7; u.ks = j >> 3; kt0 = u.ks * kq; u.nt = (u.ks < 3) ? kq : ntot - 3 * kq; }
        u.a = A + (size_t)u.pm * 256 * lda2 + (size_t)kt0 * 128; u.b = Bt + (size_t)u.pn * 256 * ldb2 + (size_t)kt0 * 128;
        return true;
    }
};
struct SchedF1 {
    const char* T; const char* mixin; char* gtp; char* gts; int lda2, ldb2; int G, c;
    __device__ __forceinline__ bool next(int i, GUnit& u) const {
        const int L = i * G + c; if (L >= 320) return false;
        u.nt = 4; u.ks = L;
        if (L < 256) { const int bg = L >> 1, b = bg >> 2, g = bg & 3; u.pm = L & 1; u.pn = 0;
            u.b = mixin + ((size_t)(b * 256) * NIN_E + 2048 + g * 256) * 2; }
        else { const int l2 = L - 256, bg = l2 >> 3, b = bg >> 2, g = bg & 3; u.pm = (l2 >> 2) & 1; u.pn = l2 & 3;
            u.b = mixin + ((size_t)(MP + b * 1024 + u.pn * 256) * NIN_E + 2048 + g * 256) * 2; }
        u.a = T + (size_t)u.pm * 256 * 512;
        return true;
    }
    __device__ __forceinline__ void out(const GUnit& u, char*& o, int& ld) const { const int L = u.ks; ld = 2048;
        if (L < 256) o = gtp + ((size_t)(L >> 1) * 256 * 2048 + (size_t)u.pm * 256) * 2;
        else o = gts + ((size_t)((L - 256) >> 3) * 256 * 2048 + (size_t)u.pm * 1024 + u.pn * 256) * 2; }
};
struct SchedF2 {
    const char* cs256; const char* cs1024; const char* gtp; const char* gts; char* mixout; int lda2, ldb2; int G, c;
    __device__ __forceinline__ bool next(int i, GUnit& u) const {
        const int L = i * G + c; if (L >= 160) return false;
        u.ks = L; u.pn = 0;
        if (L < 32) { const int bg = L >> 2; u.pm = L & 3; u.nt = 32; u.a = cs1024 + (size_t)u.pm * 256 * 4096; u.b = gts + (size_t)bg * 256 * 2048 * 2; }
        else { const int bg = L - 32; u.pm = 0; u.nt = 8; u.a = cs256; u.b = gtp + (size_t)bg * 256 * 2048 * 2; }
        return true;
    }
    __device__ __forceinline__ void out(const GUnit& u, char*& o, int& ld) const { const int L = u.ks; ld = DM;
        if (L < 32) { const int bg = L >> 2, b = bg >> 2, g = bg & 3; o = mixout + ((size_t)(MP + b * 1024 + u.pm * 256) * DM + 1024 + g * 256) * 2; }
        else { const int bg = L - 32, b = bg >> 2, g = bg & 3; o = mixout + ((size_t)(b * 256) * DM + 1024 + g * 256) * 2; } }
};

struct EpiBf16 {
    static constexpr bool PERM = true;
    float scale;
    template <class Sched>
    __device__ __forceinline__ void operator()(const f32x4 (&acc)[2][2][4][2], const GUnit& u, const Sched& S, int wr, int wc, int fr, int fq) const {
        char* o; int ldc; S.out(u, o, ldc); bf16_t* T = (bf16_t*)o;
        const unsigned off0 = (unsigned)((wr * 64 + fr) * ldc + wc * 32 + 8 * fq);
#pragma unroll
        for (int ai = 0; ai < 2; ++ai)
#pragma unroll
            for (int m = 0; m < 4; ++m) { const unsigned off = off0 + (unsigned)((ai * HALF + m * 16) * ldc);
#pragma unroll
                for (int bj = 0; bj < 2; ++bj) { const f32x4 v0 = acc[ai][bj][m][0] * scale, v1 = acc[ai][bj][m][1] * scale;
                    u32x4 w; w.x = cvt_pk_bf16(v0[0], v0[1]); w.y = cvt_pk_bf16(v0[2], v0[3]); w.z = cvt_pk_bf16(v1[0], v1[1]); w.w = cvt_pk_bf16(v1[2], v1[3]);
                    *(u32x4*)(T + off + bj * HALF) = w; } }
    }
};
struct EpiF2 { static constexpr bool PERM = true;
    template <class Sched>
    __device__ __forceinline__ void operator()(const f32x4 (&acc)[2][2][4][2], const GUnit& u, const Sched& S, int wr, int wc, int fr, int fq) const {
        EpiBf16 e{u.nt == 32 ? 1.0f / 512.0f : 1.0f / 256.0f}; e(acc, u, S, wr, wc, fr, fq); } };
struct EpiGU {
    static constexpr bool PERM = true;
    template <class Sched>
    __device__ __forceinline__ void operator()(const f32x4 (&acc)[2][2][4][2], const GUnit& u, const Sched& S, int wr, int wc, int fr, int fq) const {
        char* o; int ldc; S.out(u, o, ldc); bf16_t* T = (bf16_t*)o;
        const unsigned off0 = (unsigned)((wr * 64 + fr) * ldc + wc * 32 + 8 * fq);
#pragma unroll
        for (int ai = 0; ai < 2; ++ai)
#pragma unroll
            for (int m = 0; m < 4; ++m) { const unsigned off = off0 + (unsigned)((ai * HALF + m * 16) * ldc); float t[8], r[8];
#pragma unroll
                for (int i = 0; i < 8; ++i) t[i] = acc[ai][0][m][i >> 2][i & 3] * -1.4426950408889634f;
#pragma unroll
                for (int i = 0; i < 8; ++i) t[i] = __builtin_amdgcn_exp2f(t[i]);
#pragma unroll
                for (int i = 0; i < 8; ++i) t[i] = t[i] + 1.0f;
#pragma unroll
                for (int i = 0; i < 8; ++i) t[i] = __builtin_amdgcn_rcpf(t[i]);
#pragma unroll
                for (int i = 0; i < 8; ++i) r[i] = (acc[ai][0][m][i >> 2][i & 3] * acc[ai][1][m][i >> 2][i & 3]) * t[i];
                asm volatile("" : "+v"(r[0]), "+v"(r[1]), "+v"(r[2]), "+v"(r[3]), "+v"(r[4]), "+v"(r[5]), "+v"(r[6]), "+v"(r[7]));
                u32x4 w; w.x = cvt_pk_bf16(r[0], r[1]); w.y = cvt_pk_bf16(r[2], r[3]); w.z = cvt_pk_bf16(r[4], r[5]); w.w = cvt_pk_bf16(r[6], r[7]);
                *(u32x4*)(T + off) = w; }
    }
};
struct EpiGU8 {
    static constexpr bool PERM = true;
    const float* rsc; const float* cmax;
    template <class Sched>
    __device__ __forceinline__ void operator()(const i32x4 (&acc)[2][2][4][2], const GUnit& u, const Sched& S, int wr, int wc, int fr, int fq) const {
        char* o; int ldc; S.out(u, o, ldc); bf16_t* T = (bf16_t*)o;
        const unsigned off0 = (unsigned)((wr * 64 + fr) * ldc + wc * 32 + 4 * fq);
        bf16x8 hf[2];
#pragma unroll
        for (int nt = 0; nt < 2; ++nt) { u32x4 hw;
#pragma unroll
            for (int p = 0; p < 4; ++p) { const unsigned s0 = __builtin_popcount((unsigned)((8 * fq + 2 * p) & (16 * nt + fr))) & 1u, s1 = __builtin_popcount((unsigned)((8 * fq + 2 * p + 1) & (16 * nt + fr))) & 1u;
                hw[p] = (s0 ? 0xbf80u : 0x3f80u) | ((s1 ? 0xbf80u : 0x3f80u) << 16); }
            hf[nt] = __builtin_bit_cast(bf16x8, hw); }
        const float* cp = cmax + u.pn * BM + wc * 32 + 8 * fq;
        f32x4 cs[2][2];
#pragma unroll
        for (int bj = 0; bj < 2; ++bj)
#pragma unroll
            for (int n = 0; n < 2; ++n) cs[bj][n] = *(const f32x4*)(cp + bj * HALF + 4 * n) * (1.0f / 127.0f);
        const float* rp = rsc + u.pm * BM + wr * 64 + fr;
#pragma unroll
        for (int ai = 0; ai < 2; ++ai)
#pragma unroll
            for (int m = 0; m < 4; ++m) { const unsigned off = off0 + (unsigned)((ai * HALF + m * 16) * ldc); float t[8], gg[8], r[8];
                const float rs = rp[ai * HALF + m * 16];
#pragma unroll
                for (int i = 0; i < 8; ++i) gg[i] = (float)acc[ai][0][m][i >> 2][i & 3] * (rs * cs[0][i >> 2][i & 3]);
#pragma unroll
                for (int i = 0; i < 8; ++i) t[i] = gg[i] * -1.4426950408889634f;
#pragma unroll
                for (int i = 0; i < 8; ++i) t[i] = __builtin_amdgcn_exp2f(t[i]);
#pragma unroll
                for (int i = 0; i < 8; ++i) t[i] = t[i] + 1.0f;
#pragma unroll
                for (int i = 0; i < 8; ++i) t[i] = __builtin_amdgcn_rcpf(t[i]);
#pragma unroll
                for (int i = 0; i < 8; ++i) r[i] = (gg[i] * ((float)acc[ai][1][m][i >> 2][i & 3] * (rs * cs[1][i >> 2][i & 3]))) * t[i];
                asm volatile("" : "+v"(r[0]), "+v"(r[1]), "+v"(r[2]), "+v"(r[3]), "+v"(r[4]), "+v"(r[5]), "+v"(r[6]), "+v"(r[7]));
                u32x4 w; w.x = cvt_pk_bf16_b(r[0], r[1]); w.y = cvt_pk_bf16_b(r[2], r[3]); w.z = cvt_pk_bf16_b(r[4], r[5]); w.w = cvt_pk_bf16_b(r[6], r[7]);
                const bf16x8 af = __builtin_bit_cast(bf16x8, w);
                float zf = 0.f; asm volatile("" : "+v"(zf));
                const f32x4 z4 = {zf, zf, zf, zf};
                const f32x4 h0 = __builtin_amdgcn_mfma_f32_16x16x32_bf16(hf[0], af, z4, 0, 0, 0), h1 = __builtin_amdgcn_mfma_f32_16x16x32_bf16(hf[1], af, z4, 0, 0, 0);
                u32x2 o0, o1; o0.x = cvt_pk_bf16_b(h0[0], h0[1]); o0.y = cvt_pk_bf16_b(h0[2], h0[3]); o1.x = cvt_pk_bf16_b(h1[0], h1[1]); o1.y = cvt_pk_bf16_b(h1[2], h1[3]);
                *(u32x2*)(T + off) = o0; *(u32x2*)(T + off + 16) = o1;
                __builtin_amdgcn_sched_barrier(0); }
    }
};
struct EpiResid8 {
    static constexpr bool PERM = false;
    bf16_t* x; const float* gate; float coef; float* slab; const float* rsc; const float* cmax; float* yout;
    template <class Sched>
    __device__ __forceinline__ void operator()(const i32x4 (&acc)[2][2][4][2], const GUnit& u, const Sched& S, int wr, int wc, int fr, int fq) const {
        const unsigned off0 = (unsigned)((wr * 64 + fr) * DM + wc * 32 + 4 * fq);
        const float* cp = cmax + u.pn * BM + wc * 32 + 4 * fq;
        const float* rp = rsc + u.pm * BM + wr * 64 + fr;
        float rsv[8];
#pragma unroll
        for (int i = 0; i < 8; ++i) rsv[i] = rp[(i >> 2) * HALF + (i & 3) * 16];
        f32x4 gv[2][2];
        if (u.ks < 0) { const float* gt = gate + u.pn * BM + wc * 32 + 4 * fq;
#pragma unroll
            for (int bj = 0; bj < 2; ++bj)
#pragma unroll
                for (int n = 0; n < 2; ++n) gv[bj][n] = (*(const f32x4*)(gt + bj * HALF + n * 16) * coef) * (*(const f32x4*)(cp + bj * HALF + n * 16) * (1.0f / 127.0f));
        } else {
#pragma unroll
            for (int bj = 0; bj < 2; ++bj)
#pragma unroll
                for (int n = 0; n < 2; ++n) gv[bj][n] = *(const f32x4*)(cp + bj * HALF + n * 16) * (1.0f / 127.0f);
        }
        asm volatile("" : "+v"(rsv[0]), "+v"(rsv[1]), "+v"(rsv[2]), "+v"(rsv[3]), "+v"(rsv[4]), "+v"(rsv[5]), "+v"(rsv[6]), "+v"(rsv[7]));
        if (u.ks < 0) {
            bf16_t* T = x + (size_t)u.pm * BM * DM + u.pn * BM; float* Y = yout ? yout + (size_t)u.pm * BM * DM + u.pn * BM : nullptr;
#pragma unroll
            for (int ai = 0; ai < 2; ++ai)
#pragma unroll
                for (int m = 0; m < 4; ++m) { const unsigned off = off0 + (unsigned)((ai * HALF + m * 16) * DM); const float rs = rsv[ai * 4 + m];
#pragma unroll
                    for (int bj = 0; bj < 2; ++bj)
#pragma unroll
                        for (int n = 0; n < 2; ++n) { u32x2* p = (u32x2*)(T + off + bj * HALF + n * 16); const i32x4 a = acc[ai][bj][m][n]; const u32x2 xo = *p;
                            const f32x4 af = {(float)a[0], (float)a[1], (float)a[2], (float)a[3]};
                            const f32x4 xn = (f32x4){bf_lo(xo.x), bf_hi(xo.x), bf_lo(xo.y), bf_hi(xo.y)} + (gv[bj][n] * rs) * af;
                            if (Y) *(f32x4*)(Y + off + bj * HALF + n * 16) = xn;
                            else { u32x2 w; w.x = cvt_pk_bf16(xn[0], xn[1]); w.y = cvt_pk_bf16(xn[2], xn[3]); *p = w; } }
                    if (m == 3) asm volatile("" ::: "memory"); }
        } else {
            bf16_t* T = (bf16_t*)slab + (size_t)u.ks * MS * DM + (size_t)(u.pm - 32) * BM * DM + u.pn * BM;
#pragma unroll
            for (int ai = 0; ai < 2; ++ai)
#pragma unroll
                for (int m = 0; m < 4; ++m) { const unsigned off = off0 + (unsigned)((ai * HALF + m * 16) * DM); const float rs = rsv[ai * 4 + m];
#pragma unroll
                    for (int bj = 0; bj < 2; ++bj)
#pragma unroll
                        for (int n = 0; n < 2; ++n) { const i32x4 a = acc[ai][bj][m][n]; const f32x4 v = (f32x4){(float)a[0], (float)a[1], (float)a[2], (float)a[3]} * (gv[bj][n] * rs);
                            u32x2 w; w.x = cvt_pk_bf16(v[0], v[1]); w.y = cvt_pk_bf16(v[2], v[3]); *(u32x2*)(T + off + bj * HALF + n * 16) = w; } }
        }
    }
};
struct EpiResid {
    static constexpr bool PERM = false;
    bf16_t* x; const float* gate; float coef; float* slab;
    template <class Sched>
    __device__ __forceinline__ void operator()(const f32x4 (&acc)[2][2][4][2], const GUnit& u, const Sched& S, int wr, int wc, int fr, int fq) const {
        const unsigned off0 = (unsigned)((wr * 64 + fr) * DM + wc * 32 + 4 * fq);
        if (u.ks < 0) {
            bf16_t* T = x + (size_t)u.pm * BM * DM + u.pn * BM; const float* gt = gate + u.pn * BM + wc * 32 + 4 * fq;
            f32x4 gv[2][2];
#pragma unroll
            for (int bj = 0; bj < 2; ++bj)
#pragma unroll
                for (int n = 0; n < 2; ++n) gv[bj][n] = *(const f32x4*)(gt + bj * HALF + n * 16) * coef;
#pragma unroll
            for (int ai = 0; ai < 2; ++ai)
#pragma unroll
                for (int m = 0; m < 4; ++m) { const unsigned off = off0 + (unsigned)((ai * HALF + m * 16) * DM);
#pragma unroll
                    for (int bj = 0; bj < 2; ++bj)
#pragma unroll
                        for (int n = 0; n < 2; ++n) { u32x2* p = (u32x2*)(T + off + bj * HALF + n * 16); const u32x2 xo = *p;
                            const f32x4 xn = (f32x4){bf_lo(xo.x), bf_hi(xo.x), bf_lo(xo.y), bf_hi(xo.y)} + gv[bj][n] * acc[ai][bj][m][n];
                            u32x2 w; w.x = cvt_pk_bf16(xn[0], xn[1]); w.y = cvt_pk_bf16(xn[2], xn[3]); *p = w; }
                    if (m == 3) asm volatile("" ::: "memory"); }
        } else {
            bf16_t* T = (bf16_t*)slab + (size_t)u.ks * MS * DM + (size_t)(u.pm - 32) * BM * DM + u.pn * BM;
#pragma unroll
            for (int ai = 0; ai < 2; ++ai)
#pragma unroll
                for (int m = 0; m < 4; ++m) { const unsigned off = off0 + (unsigned)((ai * HALF + m * 16) * DM);
#pragma unroll
                    for (int bj = 0; bj < 2; ++bj)
#pragma unroll
                        for (int n = 0; n < 2; ++n) { const f32x4 v = acc[ai][bj][m][n]; u32x2 w; w.x = cvt_pk_bf16(v[0], v[1]); w.y = cvt_pk_bf16(v[2], v[3]); *(u32x2*)(T + off + bj * HALF + n * 16) = w; } }
        }
    }
};
}

namespace att {
constexpr int D = 128, QBLK = 32, KVBLK = 64;
constexpr float SCALE = 0.088388347648318440f;
constexpr float THR = 8.f;
constexpr float NEG = -1e30f;
constexpr size_t SHM_V = KVBLK * D * 2, SHM_K = KVBLK * D * 2, SHM_ATTN = 2 * SHM_V + 2 * SHM_K + 8 * 64 * 4;
constexpr int RPB_OFF = (int)SHM_ATTN;
#define KSWZ(row, colB) ((row) * 256 + ((colB) ^ (((row) & 7) << 4)))
#define SBAR() __builtin_amdgcn_sched_barrier(0)
__device__ __forceinline__ int crow(int r, int hi) { return (r & 3) + 8 * (r >> 2) + 4 * hi; }

struct AUnit { const bf16_t* Q; bf16_t* O; const bf16_t* Kc; const bf16_t* Vc; const bf16_t* Kl; const bf16_t* Vl; int nctx, nloc, nt, mode, q0, kt0; float m0, l0; const float* rpb; };

__device__ __forceinline__ void partialSM(f32x16& p0, f32x16& p1, float& m_reg, float& mn, float& alpha) {
  constexpr float C = SCALE * 1.4426950408889634f;
  float pmax = p0[0];
#pragma unroll
  for (int r = 1; r < 16; ++r) pmax = fmaxf(pmax, p0[r]);
#pragma unroll
  for (int r = 0; r < 16; ++r) pmax = fmaxf(pmax, p1[r]);
  { auto rr = __builtin_amdgcn_permlane32_swap(__float_as_uint(pmax), __float_as_uint(pmax), false, false);
    pmax = fmaxf(__uint_as_float(rr[0]), __uint_as_float(rr[1])); }
  if (__builtin_expect(__all(pmax - m_reg <= THR / SCALE), 1)) { mn = m_reg; alpha = 1.f; }
  else { mn = fmaxf(m_reg, pmax); alpha = __builtin_amdgcn_exp2f((m_reg - mn) * C); m_reg = mn; }
  float mnC = -mn * C;
#pragma unroll
  for (int r = 0; r < 16; ++r) p0[r] = fmaf(p0[r], C, mnC);
#pragma unroll
  for (int r = 0; r < 16; ++r) p1[r] = fmaf(p1[r], C, mnC);
#pragma unroll
  for (int r = 0; r < 16; ++r) p0[r] = __builtin_amdgcn_exp2f(p0[r]);
}
__device__ __forceinline__ void finishSM(f32x16& p0, f32x16& p1, float alpha, float& l_reg, bf16x8& pa0, bf16x8& pa1, bf16x8& pa2, bf16x8& pa3) {
#pragma unroll
  for (int r = 0; r < 16; ++r) p1[r] = __builtin_amdgcn_exp2f(p1[r]);
  float ps = 0;
#pragma unroll
  for (int r = 0; r < 16; ++r) ps += p0[r];
#pragma unroll
  for (int r = 0; r < 16; ++r) ps += p1[r];
  { auto rr = __builtin_amdgcn_permlane32_swap(__float_as_uint(ps), __float_as_uint(ps), false, false);
    ps = __uint_as_float(rr[0]) + __uint_as_float(rr[1]); }
  l_reg = l_reg * alpha + ps;
#define PK4(P, BASE, OUT) do { unsigned a0 = cvt_pk_bf16(P[BASE + 0], P[BASE + 1]), a1 = cvt_pk_bf16(P[BASE + 2], P[BASE + 3]);   \
    unsigned b0 = cvt_pk_bf16(P[BASE + 4], P[BASE + 5]), b1 = cvt_pk_bf16(P[BASE + 6], P[BASE + 7]);                              \
    auto r0 = __builtin_amdgcn_permlane32_swap(a0, b0, false, false); auto r1 = __builtin_amdgcn_permlane32_swap(a1, b1, false, false); \
    u32x4 w = {r0[0], r1[0], r0[1], r1[1]}; OUT = *reinterpret_cast<bf16x8*>(&w); } while (0)
  PK4(p0, 0, pa0); PK4(p0, 8, pa1); PK4(p1, 0, pa2); PK4(p1, 8, pa3);
#undef PK4
}
__device__ __forceinline__ void qkt(f32x16& p0, f32x16& p1, const bf16_t* Ks, const bf16x8* qr, int r32, int hi) {
  p0 = f32x16{}; p1 = f32x16{};
#pragma unroll
  for (int d0 = 0; d0 < 8; ++d0) { int cb = (d0 * 16 + hi * 8) * 2;
    bf16x8 b0 = *reinterpret_cast<const bf16x8*>((const char*)Ks + KSWZ(r32, cb));
    bf16x8 b1 = *reinterpret_cast<const bf16x8*>((const char*)Ks + KSWZ(32 + r32, cb));
    p0 = __builtin_amdgcn_mfma_f32_32x32x16_bf16(b0, qr[d0], p0, 0, 0, 0);
    p1 = __builtin_amdgcn_mfma_f32_32x32x16_bf16(b1, qr[d0], p1, 0, 0, 0); }
}
__device__ __forceinline__ int v_st(int k, int c) { const int kk = (k & ~0xC) | ((k & 4) << 1) | ((k & 8) >> 1); return ((kk >> 3) * 4 + (c >> 5)) * 512 + ((kk & 7) * 32 + (c & 31)) * 2; }
__device__ __forceinline__ int v_rd_base(int lane) { return ((lane & 3) << 3) | (((lane >> 2) & 3) << 6) | (((lane >> 4) & 1) << 5) | (((lane >> 5) & 1) << 8); }
constexpr int v_rd_off(int d0, int ks, int half) { return d0 * 512 + ks * 4096 + half * 2048; }
template <int OFF> __device__ __forceinline__ s16x4 tr_read(int vb) {
  s16x4 r; asm volatile("ds_read_b64_tr_b16 %0, %1 offset:%2" : "=&v"(r) : "v"(vb), "i"(OFF) : "memory"); return r;
}
template <int D0> __device__ __forceinline__ void pv_one(f32x16& od, int vb, bf16x8 pa0, bf16x8 pa1, bf16x8 pa2, bf16x8 pa3) {
  const s16x4 l0 = tr_read<v_rd_off(D0, 0, 0)>(vb), h0 = tr_read<v_rd_off(D0, 0, 1)>(vb), l1 = tr_read<v_rd_off(D0, 1, 0)>(vb), h1 = tr_read<v_rd_off(D0, 1, 1)>(vb);
  const s16x4 l2 = tr_read<v_rd_off(D0, 2, 0)>(vb), h2 = tr_read<v_rd_off(D0, 2, 1)>(vb), l3 = tr_read<v_rd_off(D0, 3, 0)>(vb), h3 = tr_read<v_rd_off(D0, 3, 1)>(vb);
  asm volatile("s_waitcnt lgkmcnt(0)" ::: "memory"); SBAR();
#define PK(L, H) (bf16x8){L[0], L[1], L[2], L[3], H[0], H[1], H[2], H[3]}
  od = __builtin_amdgcn_mfma_f32_32x32x16_bf16(pa0, PK(l0, h0), od, 0, 0, 0);
  od = __builtin_amdgcn_mfma_f32_32x32x16_bf16(pa1, PK(l1, h1), od, 0, 0, 0);
  od = __builtin_amdgcn_mfma_f32_32x32x16_bf16(pa2, PK(l2, h2), od, 0, 0, 0);
  od = __builtin_amdgcn_mfma_f32_32x32x16_bf16(pa3, PK(l3, h3), od, 0, 0, 0);
#undef PK
}
__device__ __forceinline__ void pv_d0(f32x16* o, int vb, bf16x8 pa0, bf16x8 pa1, bf16x8 pa2, bf16x8 pa3) {
  pv_one<0>(o[0], vb, pa0, pa1, pa2, pa3); pv_one<1>(o[1], vb, pa0, pa1, pa2, pa3); pv_one<2>(o[2], vb, pa0, pa1, pa2, pa3); pv_one<3>(o[3], vb, pa0, pa1, pa2, pa3);
}
__device__ __forceinline__ void mask_tile(f32x16& p0, f32x16& p1, const AUnit& U, int j, int qrel, int hi, const float* rpbT) {
  if (j < U.nctx) return;
  const int jl = j - U.nctx;
  if (jl >= U.nloc) {
#pragma unroll
    for (int r = 0; r < 16; ++r) { p0[r] = NEG; p1[r] = NEG; }
    return; }
  if (U.mode == 1) {
    const int dq = (U.kt0 + jl) * 64 - (U.q0 + qrel) + 128;
#pragma unroll
    for (int r = 0; r < 16; ++r) { const int d0 = dq + crow(r, hi); if ((unsigned)d0 > 256u) p0[r] = NEG; if ((unsigned)(d0 + 32) > 256u) p1[r] = NEG; }
  } else if (U.mode == 2) {
    const int qpos = U.q0 + qrel, qrow = qpos >> 6, qcol = qpos & 63, krow = U.kt0 + jl;
    int rs = qrow - 4; rs = rs < 0 ? 0 : (rs > 8 ? 8 : rs);
    int cs = qcol - 8; cs = cs < 0 ? 0 : (cs > 48 ? 48 : cs);
    const bool rowok = (krow >= rs) && (krow < rs + 8);
    const int ib = (krow - qrow + 7) * 31 - qcol + 15;
#pragma unroll
    for (int r = 0; r < 16; ++r) { const int kc0 = crow(r, hi), kc1 = kc0 + 32;
      const bool ok0 = rowok && ((unsigned)(kc0 - cs) < 16u), ok1 = rowok && ((unsigned)(kc1 - cs) < 16u);
      const float b0 = rpbT[ok0 ? ib + kc0 : 0], b1 = rpbT[ok1 ? ib + kc1 : 0];
      p0[r] = ok0 ? p0[r] + b0 : NEG; p1[r] = ok1 ? p1[r] + b1 : NEG; }
  }
}
__device__ __forceinline__ void attn_unit(const AUnit& U, char* lds, int wv) {
  const int tid = ptid(wv);
  const int wid = wv, lane = tid & 63, r32 = lane & 31, hi = lane >> 5;
  bf16_t* V_lds = (bf16_t*)lds; bf16_t* K_lds = (bf16_t*)(lds + 2 * SHM_V);
  float* ws = (float*)(lds + 2 * SHM_V + 2 * SHM_K) + wid * 64; float* li_l = ws; float* al_l = ws + 32;
  float* rpbT = (float*)(lds + RPB_OFF);
  if (U.mode == 2) { for (int i = tid; i < 15 * 31; i += NTHR) rpbT[i] = U.rpb[i] * (1.0f / SCALE); }
  float m_reg = U.m0, l_reg = U.l0; f32x16 o[4] = {}; bf16x8 qr[8];
  const bf16_t* Qw = U.Q + (long)(wid * QBLK + r32) * D + hi * 8;
#pragma unroll
  for (int d0 = 0; d0 < 8; ++d0) qr[d0] = *reinterpret_cast<const bf16x8*>(Qw + d0 * 16);
  const int sr = tid >> 4, sc = (tid & 15) * 8, vst0 = v_st(sr, sc), vst1 = v_st(32 + sr, sc);
  const int vb0 = (int)(uintptr_t)V_lds + v_rd_base(lane);
  const int qrel = wid * QBLK + r32;
  struct { bf16x8 vs0, vs1, ks0, ks1; } sr_[1];
#define KTP(j) ((j) < U.nctx ? U.Kc + (long)(j) * 8192 : U.Kl + (long)(((j) - U.nctx) < U.nloc ? ((j) - U.nctx) : (U.nloc - 1)) * 8192)
#define VTP(j) ((j) < U.nctx ? U.Vc + (long)(j) * 8192 : U.Vl + (long)(((j) - U.nctx) < U.nloc ? ((j) - U.nctx) : (U.nloc - 1)) * 8192)
#define SLOAD(i, j) do { const bf16_t* kp_ = KTP(j); const bf16_t* vp_ = VTP(j); \
    sr_[i].vs0 = *reinterpret_cast<const bf16x8*>(&vp_[(long)(sr) * D + sc]); sr_[i].vs1 = *reinterpret_cast<const bf16x8*>(&vp_[(long)(32 + sr) * D + sc]); \
    sr_[i].ks0 = *reinterpret_cast<const bf16x8*>(&kp_[(long)(sr) * D + sc]); sr_[i].ks1 = *reinterpret_cast<const bf16x8*>(&kp_[(long)(32 + sr) * D + sc]); } while (0)
#define SWRITE(b, i) do { *(bf16x8*)((char*)V_lds + (b) * SHM_V + vst0) = sr_[i].vs0;          \
    *(bf16x8*)((char*)V_lds + (b) * SHM_V + vst1) = sr_[i].vs1; int kc = sc * 2;               \
    *(bf16x8*)((char*)K_lds + (b) * SHM_K + KSWZ(sr, kc)) = sr_[i].ks0;                       \
    *(bf16x8*)((char*)K_lds + (b) * SHM_K + KSWZ(32 + sr, kc)) = sr_[i].ks1; } while (0)
#define SWAIT() asm volatile("s_waitcnt vmcnt(0)" ::: "memory")
#define RESC(a) do { if (__any((a) < 1.f)) { if (hi == 0) al_l[r32] = (a); asm volatile("s_waitcnt lgkmcnt(0)" ::: "memory"); \
    _Pragma("unroll") for (int d = 0; d < 4; ++d) _Pragma("unroll") for (int r = 0; r < 16; ++r) o[d][r] *= al_l[crow(r, hi)]; } } while (0)
  f32x16 pA0, pA1, pB0, pB1; float mnA, mnB, alA, alB; bf16x8 pa0, pa1, pa2, pa3; const int NT = U.nt;
  SLOAD(0, 0); asm volatile("s_waitcnt vmcnt(0)" ::: "memory"); SWRITE(0, 0); __syncthreads();
  qkt(pA0, pA1, K_lds, qr, r32, hi); partialSM(pA0, pA1, m_reg, mnA, alA);
  SLOAD(0, 1);
  SWAIT(); SWRITE(1, 0); __syncthreads();
  for (int j = 1; j + 1 < NT; j += 2) {
    SBAR(); qkt(pB0, pB1, (bf16_t*)((char*)K_lds + SHM_K), qr, r32, hi);
    finishSM(pA0, pA1, alA, l_reg, pa0, pa1, pa2, pa3); SBAR();
    SLOAD(0, j + 1); SBAR();
    pv_d0(o, vb0, pa0, pa1, pa2, pa3); mask_tile(pB0, pB1, U, j, qrel, hi, rpbT); partialSM(pB0, pB1, m_reg, mnB, alB);
    __syncthreads(); SWAIT(); SWRITE(0, 0);
    RESC(alB); __syncthreads();
    SBAR(); qkt(pA0, pA1, K_lds, qr, r32, hi);
    finishSM(pB0, pB1, alB, l_reg, pa0, pa1, pa2, pa3); SBAR();
    SLOAD(0, j + 2); SBAR();
    pv_d0(o, vb0 + (int)SHM_V, pa0, pa1, pa2, pa3); mask_tile(pA0, pA1, U, j + 1, qrel, hi, rpbT); partialSM(pA0, pA1, m_reg, mnA, alA);
    __syncthreads(); SWAIT(); SWRITE(1, 0);
    RESC(alA); __syncthreads();
  }
  SBAR(); qkt(pB0, pB1, (bf16_t*)((char*)K_lds + SHM_K), qr, r32, hi);
  finishSM(pA0, pA1, alA, l_reg, pa0, pa1, pa2, pa3); SBAR();
  pv_d0(o, vb0, pa0, pa1, pa2, pa3); mask_tile(pB0, pB1, U, NT - 1, qrel, hi, rpbT); partialSM(pB0, pB1, m_reg, mnB, alB);
  __syncthreads(); RESC(alB);
  finishSM(pB0, pB1, alB, l_reg, pa0, pa1, pa2, pa3); SBAR();
  pv_d0(o, vb0 + (int)SHM_V, pa0, pa1, pa2, pa3);
  if (hi == 0) li_l[r32] = l_reg; asm volatile("s_waitcnt lgkmcnt(0)" ::: "memory");
  float rli[16];
#pragma unroll
  for (int r = 0; r < 16; ++r) rli[r] = __builtin_amdgcn_rcpf(li_l[crow(r, hi)]);
  bf16_t* Ow = U.O + (long)(wid * QBLK) * DM;
#pragma unroll
  for (int r = 0; r < 16; ++r) { int orow = crow(r, hi);
#pragma unroll
    for (int d0 = 0; d0 < 4; ++d0) Ow[(long)orow * DM + d0 * 32 + r32] = (bf16_t)f2bf(o[d0][r] * rli[r]); }
  __syncthreads();
#undef KTP
#undef VTP
#undef SLOAD
#undef SWRITE
#undef SWAIT
#undef RESC
}
#undef KSWZ
#undef SBAR
}

struct Args { const float* in[29]; float* out; unsigned char* ws; };
enum { I_XP = 0, I_XS, I_C, I_CCK, I_CCV, I_CDK, I_CDV, I_CCTX, I_WADA, I_BADA, I_GF1, I_WGU1, I_WDN1, I_GMIX, I_WOUT, I_GF2, I_WGU2, I_WDN2, I_WINE, I_GSGU, I_WSGU, I_BSGU, I_WINO,
       I_GQC, I_GKC, I_GQD, I_GKD, I_SINK, I_RPB };

__device__ __forceinline__ void transpose_item(const float* W, int K, int N, bf16_t* WT, int k0, int n0, int drow0, LAS float* scr, int lane) {
    (void)scr;
    const int r8 = lane >> 3, c4 = (lane & 7) * 4;
    f32x4 dd[8]; const float* wp = W + (size_t)(k0 + 8 * r8) * N + n0 + c4;
#pragma unroll
    for (int ii = 0; ii < 8; ++ii) dd[ii] = __builtin_nontemporal_load((const f32x4*)(wp + (size_t)ii * N));
#pragma unroll
    for (int e = 0; e < 4; ++e) { u32x4 o; o.x = pk2(dd[0][e], dd[1][e]); o.y = pk2(dd[2][e], dd[3][e]); o.z = pk2(dd[4][e], dd[5][e]); o.w = pk2(dd[6][e], dd[7][e]);
        __builtin_nontemporal_store(o, (u32x4*)(WT + (size_t)(drow0 + c4 + e) * K + k0 + 8 * r8)); }
}
__device__ __forceinline__ void transpose_item_q8(const float* W, int K, int N, signed char* WT, int k0, int n0, int drow0, const float* cmax, LAS float* scr, int lane) {
#pragma unroll 8
    for (int i = 0; i < 32; ++i) { const int kk = 2 * i + (lane >> 5); scr[kk * 33 + (lane & 31)] = W[(size_t)(k0 + kk) * N + n0 + (lane & 31)]; }
    LDS_WAIT(); asm volatile("" ::: "memory");
    const int c = lane & 7;
#pragma unroll
    for (int j = 0; j < 4; ++j) { const int n = (lane >> 3) + 8 * j; const LAS float* s = scr + (8 * c) * 33 + n;
        const float inv = 127.0f / fmaxf(cmax[drow0 + n], 1e-30f); int q[8];
#pragma unroll
        for (int i = 0; i < 8; ++i) { int v = (int)__builtin_rintf(s[i * 33] * inv); v = v > 127 ? 127 : (v < -127 ? -127 : v); q[i] = v & 255; }
        u32x2 o; o.x = (unsigned)q[0] | ((unsigned)q[1] << 8) | ((unsigned)q[2] << 16) | ((unsigned)q[3] << 24); o.y = (unsigned)q[4] | ((unsigned)q[5] << 8) | ((unsigned)q[6] << 16) | ((unsigned)q[7] << 24);
        *(u32x2*)(WT + (size_t)(drow0 + n) * K + k0 + 8 * c) = o; }
    LDS_WAIT(); asm volatile("" ::: "memory");
}
__device__ __forceinline__ int gu_row(int n) { return n < DFF ? ((n >> 7) * 256 + (n & 127)) : (((n - DFF) >> 7) * 256 + 128 + ((n - DFF) & 127)); }

constexpr int CONV_PER_LAYER = 11008 * 2 + 5504 * 2 + 2048 + 4608;
__device__ __forceinline__ void convert_item(const Args& A, int l, int r, LAS float* scr, int lane) {
    bf16_t* wl = (bf16_t*)(ws_opaque(A.ws) + WS_W) + (size_t)l * W_LAYER;
    if (r < 22016) { const int f = r / 11008; r %= 11008; const int kb = r / 344, nb = r % 344;
        transpose_item_q8(asg(A.in[f ? I_WGU2 : I_WGU1]) + (size_t)l * DM * NGU, DM, NGU, (signed char*)(wl + (f ? W_GU2 : W_GU1)), kb * 64, nb * 32, gu_row(nb * 32),
                          (const float*)(ws_opaque(A.ws) + WS_CMAX) + (size_t)(l * 2 + f) * NGU, scr, lane); return; }
    r -= 22016;
    if (r < 11008) { const int f = r / 5504; r %= 5504; const int kb = r / 64, nb = r % 64;
        transpose_item(asg(A.in[f ? I_WDN2 : I_WDN1]) + (size_t)l * DFF * DM, DFF, DM, wl + (f ? W_DN2 : W_DN1), kb * 64, nb * 32, nb * 32, scr, lane); return; }
    r -= 11008;
    if (r < 2048) { const int kb = r / 64, nb = r % 64;
        transpose_item(asg(A.in[I_WOUT]) + (size_t)l * DM * DM, DM, DM, wl + W_OUT, kb * 64, nb * 32, nb * 32, scr, lane); return; }
    r -= 2048;
    if (l & 1) { const int kb = r / 144, nb = r % 144;
        transpose_item(asg(A.in[I_WINO]) + (size_t)(l >> 1) * DM * NIN_O, DM, NIN_O, wl + W_IN, kb * 64, nb * 32, nb * 32, scr, lane); }
    else if (r < 3072) { const int kb = r / 96, nb = r % 96;
        transpose_item(asg(A.in[I_WINE]) + (size_t)(l >> 1) * DM * NIN_E, DM, NIN_E, wl + W_IN, kb * 64, nb * 32, nb * 32, scr, lane); }
}
__device__ __forceinline__ void gu_q8_wg_item(const Args& A, LAS unsigned char* lds, int l, int f, int nb, int wv) {
    const int tid = ptid(wv), lane = tid & 63, r8 = lane >> 3, c4 = (lane & 7) * 4;
    const float* W = asg(A.in[f ? I_WGU2 : I_WGU1]) + (size_t)l * DM * NGU;
    LAS float* wmax = (LAS float*)(lds + 69632);
    LAS float* cm = wmax + 256;
    f32x4 d[32];
    { const float* w = W + (size_t)(wv * 256 + 8 * r8) * NGU + nb * 32 + c4;
#pragma unroll
      for (int i = 0; i < 32; ++i) d[i] = __builtin_nontemporal_load((const f32x4*)(w + (size_t)((i >> 3) * 64 + (i & 7)) * NGU)); }
    { f32x4 mx = {0.f, 0.f, 0.f, 0.f};
#pragma unroll
      for (int i = 0; i < 32; ++i) { mx[0] = fmaxf(mx[0], fabsf(d[i][0])); mx[1] = fmaxf(mx[1], fabsf(d[i][1])); mx[2] = fmaxf(mx[2], fabsf(d[i][2])); mx[3] = fmaxf(mx[3], fabsf(d[i][3])); }
#pragma unroll
      for (int q = 0; q < 4; ++q) { mx[q] = fmaxf(mx[q], sx<8>(mx[q])); mx[q] = fmaxf(mx[q], sx<16>(mx[q])); mx[q] = max32(mx[q]); }
      if (lane < 8) { wmax[wv * 32 + lane * 4 + 0] = mx[0]; wmax[wv * 32 + lane * 4 + 1] = mx[1]; wmax[wv * 32 + lane * 4 + 2] = mx[2]; wmax[wv * 32 + lane * 4 + 3] = mx[3]; } }
    __syncthreads();
    const int drow0 = gu_row(nb * 32);
    if (tid < 32) { float m = wmax[tid];
#pragma unroll
        for (int w8 = 1; w8 < 8; ++w8) m = fmaxf(m, wmax[w8 * 32 + tid]);
        cm[tid] = m; ((float*)(ws_opaque(A.ws) + WS_CMAX))[(size_t)(l * 2 + f) * NGU + drow0 + tid] = m; }
    __syncthreads();
    signed char* WT = (signed char*)((bf16_t*)(ws_opaque(A.ws) + WS_W) + (size_t)l * W_LAYER + (f ? W_GU2 : W_GU1));
    float inv[4];
#pragma unroll
    for (int e = 0; e < 4; ++e) inv[e] = 127.0f / fmaxf(cm[c4 + e], 1e-30f);
#pragma unroll
    for (int kb = 0; kb < 4; ++kb)
#pragma unroll
        for (int e = 0; e < 4; ++e) { int q[8];
#pragma unroll
            for (int i = 0; i < 8; ++i) { int v = (int)__builtin_rintf(d[kb * 8 + i][e] * inv[e]); v = v > 127 ? 127 : (v < -127 ? -127 : v); q[i] = v & 255; }
            u32x2 o; o.x = (unsigned)q[0] | ((unsigned)q[1] << 8) | ((unsigned)q[2] << 16) | ((unsigned)q[3] << 24); o.y = (unsigned)q[4] | ((unsigned)q[5] << 8) | ((unsigned)q[6] << 16) | ((unsigned)q[7] << 24);
            __builtin_nontemporal_store(o, (u32x2*)(WT + (size_t)(drow0 + c4 + e) * DM + wv * 256 + kb * 64 + 8 * r8)); }
    __syncthreads();
}
__device__ __forceinline__ void wht32_rows(float (&v)[8], int r8) {
#pragma unroll
    for (int st = 1; st < 8; st <<= 1)
#pragma unroll
        for (int i = 0; i < 8; ++i) if (!(i & st)) { const float a = v[i], b = v[i + st]; v[i] = a + b; v[i + st] = a - b; }
#pragma unroll
    for (int i = 0; i < 8; ++i) { const float p = sx<8>(v[i]); v[i] = (r8 & 1) ? (p - v[i]) : (v[i] + p); }
#pragma unroll
    for (int i = 0; i < 8; ++i) { const float p = sx<16>(v[i]); v[i] = (r8 & 2) ? (p - v[i]) : (v[i] + p); }
}
__device__ __forceinline__ void dn_q8_wg_item(const Args& A, LAS unsigned char* lds, int l, int f, int nb, int wv) {
    const int tid = ptid(wv), lane = tid & 63, r8 = lane >> 3, c4 = (lane & 7) * 4;
    const float* W = asg(A.in[f ? I_WDN2 : I_WDN1]) + (size_t)l * DFF * DM;
    LAS float* wmax = (LAS float*)(lds + 69632);
    LAS float* cm = wmax + 256;
    signed char* WT = (signed char*)((bf16_t*)(ws_opaque(A.ws) + WS_W) + (size_t)l * W_LAYER + (f ? W_DN2 : W_DN1));
    float mx[4] = {0.f, 0.f, 0.f, 0.f}, inv[4] = {0.f, 0.f, 0.f, 0.f};
    for (int pass = 0; pass < 2; ++pass) {
#define DN_LOAD(buf, kb_) do { const float* wp_ = W + (size_t)((kb_) * 64 + 8 * r8) * DM + nb * 32 + c4; _Pragma("unroll") for (int ii = 0; ii < 8; ++ii) buf[ii] = *(const f32x4*)(wp_ + (size_t)ii * DM); } while (0)
#define DN_PROC(buf, kb_) do { const int k0_ = (kb_) * 64; _Pragma("unroll") for (int e = 0; e < 4; ++e) { float v[8]; \
            _Pragma("unroll") for (int i = 0; i < 8; ++i) v[i] = buf[i][e]; \
            wht32_rows(v, r8); \
            if (pass == 0) { _Pragma("unroll") for (int i = 0; i < 8; ++i) mx[e] = fmaxf(mx[e], fabsf(v[i])); } \
            else { int q[8]; _Pragma("unroll") for (int i = 0; i < 8; ++i) { int t = (int)__builtin_rintf(v[i] * inv[e]); t = t > 127 ? 127 : (t < -127 ? -127 : t); q[i] = t & 255; } \
                u32x2 o; o.x = (unsigned)q[0] | ((unsigned)q[1] << 8) | ((unsigned)q[2] << 16) | ((unsigned)q[3] << 24); o.y = (unsigned)q[4] | ((unsigned)q[5] << 8) | ((unsigned)q[6] << 16) | ((unsigned)q[7] << 24); \
                __builtin_nontemporal_store(o, (u32x2*)(WT + (size_t)(nb * 32 + c4 + e) * KD8 + k0_ + 8 * r8)); } } } while (0)
        f32x4 bA[8], bB[8];
        DN_LOAD(bA, wv);
        for (int kb = wv; ; kb += 16) {
            const bool h1 = kb + 8 < 86; if (h1) DN_LOAD(bB, kb + 8);
            DN_PROC(bA, kb);
            if (!h1) break;
            const bool h2 = kb + 16 < 86; if (h2) DN_LOAD(bA, kb + 16);
            DN_PROC(bB, kb + 8);
            if (!h2) break;
        }
#undef DN_LOAD
#undef DN_PROC
        if (pass == 0) {
#pragma unroll
            for (int e = 0; e < 4; ++e) { mx[e] = fmaxf(mx[e], sx<8>(mx[e])); mx[e] = fmaxf(mx[e], sx<16>(mx[e])); mx[e] = max32(mx[e]); }
            if (lane < 8) {
#pragma unroll
                for (int e = 0; e < 4; ++e) wmax[wv * 32 + c4 + e] = mx[e]; }
            __syncthreads();
            if (tid < 32) { float m = wmax[tid];
#pragma unroll
                for (int w8 = 1; w8 < 8; ++w8) m = fmaxf(m, wmax[w8 * 32 + tid]);
                cm[tid] = m; ((float*)(ws_opaque(A.ws) + WS_CMAX2))[(size_t)(l * 2 + f) * DM + nb * 32 + tid] = m * (1.0f / 32.0f); }
            __syncthreads();
#pragma unroll
            for (int e = 0; e < 4; ++e) inv[e] = 127.0f / fmaxf(cm[c4 + e], 1e-30f);
        }
    }
    if (tid < 256) { u32x4 zv = {0u, 0u, 0u, 0u}; asm volatile("" : "+v"(zv)); *(u32x4*)(WT + (size_t)(nb * 32 + (tid >> 3)) * KD8 + DFF + (tid & 7) * 16) = zv; }
    __syncthreads();
}
constexpr int CONV_GU_ROUNDS = 688, CONV_DN_ROUNDS = 128, CONV_ROUNDS = CONV_GU_ROUNDS + CONV_DN_ROUNDS + (CONV_PER_LAYER - 33024) / 8;
__device__ __forceinline__ void conv_round(const Args& A, LAS unsigned char* lds, int l, int r, int wv) {
    if (r < CONV_GU_ROUNDS) { gu_q8_wg_item(A, lds, l, r / 344, r % 344, wv); return; }
    if (r < CONV_GU_ROUNDS + CONV_DN_ROUNDS) { const int rr = r - CONV_GU_ROUNDS; dn_q8_wg_item(A, lds, l, rr >> 6, rr & 63, wv); return; }
    const int lane = ptid(wv) & 63;
    convert_item(A, l, 33024 + 8 * (r - CONV_GU_ROUNDS - CONV_DN_ROUNDS) + wv, (LAS float*)(lds + wv * 8704), lane);
}
#define QH(l) (8192 + 64 * (l))
__device__ __forceinline__ bool fill_round(const Args& A, LAS unsigned char* lds, int l, int wv) {
    volatile LAS unsigned* MISC = (volatile LAS unsigned*)(lds + LDS_MISC);
    const int tid = ptid(wv);
    if (tid == 0) MISC[4] = __hip_atomic_fetch_add((unsigned*)(ws_opaque(A.ws) + WS_CTL) + QH(l), 1u, __ATOMIC_RELAXED, __HIP_MEMORY_SCOPE_AGENT);
    __syncthreads();
    const int base = (int)MISC[4];
    __syncthreads();
    if (base >= CONV_ROUNDS) return false;
    conv_round(A, lds, l, base, wv);
    return true;
}
__device__ __forceinline__ void fill_wait(const Args& A, LAS unsigned char* lds, int G, int wv, int nbar, int& ql) {
    volatile LAS unsigned* MISC = (volatile LAS unsigned*)(lds + LDS_MISC);
    while (ql < 4) {
        const int tid = ptid(wv);
        if (tid == 0) { unsigned* bar = (unsigned*)(ws_opaque(A.ws) + WS_CTL); unsigned sum = 0u;
#pragma unroll
            for (unsigned j = 0; j < 16; ++j) sum += xb_ld(&bar[XB_XSUB(j)]);
            MISC[5] = ((sum - (unsigned)nbar * (unsigned)G) * 2u >= (unsigned)G) ? 1u : 0u; }
        __syncthreads();
        const unsigned stop = MISC[5];
        __syncthreads();
        if (stop) break;
        if (!fill_round(A, lds, ql, wv)) ++ql;
    }
}

__device__ __forceinline__ void prologue_a(const Args& A, LAS unsigned char* lds, int G, int wv) {
    const int tid = ptid(wv), lane = tid & 63, wave = wv;
    unsigned char* ws = ws_opaque(A.ws);
    LAS float* sil = (LAS float*)(lds + 69632);
    for (int i = tid; i < 3 * DM; i += NTHR) { const int cv = i / DM, k = i % DM; const float v = cv == 0 ? asg(A.in[I_CCTX])[k] : asg(A.in[I_C])[(cv - 1) * DM + k]; sil[i] = v / (1.0f + __expf(-v)); }
    __syncthreads();
    const int gw = obid() * NWAVES + wave, NGW = G * NWAVES;
    for (int it = gw; it < 4 * 144 * 4; it += NGW) {
        const int l = it / 576, r = it % 576, cg = r >> 2, ks = r & 3;
        const float* w = asg(A.in[I_WADA]) + ((size_t)l * DM + ks * 512) * NMODV + cg * 128 + 2 * lane;
        f32x2 a0 = {0.f, 0.f}, a1 = {0.f, 0.f}, a2 = {0.f, 0.f};
        const LAS float* s0 = sil + ks * 512;
#pragma unroll 8
        for (int k = 0; k < 512; ++k) { const f32x2 wv = __builtin_nontemporal_load((const f32x2*)(w + (size_t)k * NMODV)); a0 += wv * s0[k]; a1 += wv * s0[DM + k]; a2 += wv * s0[2 * DM + k]; }
        float* P = (float*)(ws + WS_ADAP) + ((size_t)(l * 4 + ks) * 3) * NMODV + cg * 128 + 2 * lane;
        *(f32x2*)P = a0; *(f32x2*)(P + NMODV) = a1; *(f32x2*)(P + 2 * NMODV) = a2;
    }
    __syncthreads();
    for (int r = obid(); r < CONV_ROUNDS; r += G) conv_round(A, lds, 0, r, wv);
    const size_t gt = (size_t)obid() * NTHR + tid, GT = (size_t)G * NTHR;
    constexpr size_t N_CK = 524288 / 8, N_DK = 2097152 / 8, N_WS = 262144 / 8, N_T = 131072 / 8, N_CS = 2097152 / 8;
    constexpr size_t E0 = N_CK, E1 = E0 + N_CK, E2 = E1 + N_DK, E3 = E2 + N_DK, E4 = E3 + N_WS, E5 = E4 + N_T, E6 = E5 + N_T, E7 = E6 + N_CS;
    for (size_t i = gt; i < E7; i += GT) {
        if (i < E4) {
            const float* src; bf16_t* dst; size_t j;
            if (i < E0) { src = asg(A.in[I_CCK]); dst = (bf16_t*)(ws + WS_CCK); j = i; }
            else if (i < E1) { src = asg(A.in[I_CCV]); dst = (bf16_t*)(ws + WS_CCV); j = i - E0; }
            else if (i < E2) { src = asg(A.in[I_CDK]); dst = (bf16_t*)(ws + WS_CDK); j = i - E1; }
            else if (i < E3) { src = asg(A.in[I_CDV]); dst = (bf16_t*)(ws + WS_CDV); j = i - E2; }
            else { src = asg(A.in[I_WSGU]); dst = (bf16_t*)(ws + WS_WSGU); j = i - E3; }
            const f32x4 x0 = *(const f32x4*)(src + j * 8), x1 = *(const f32x4*)(src + j * 8 + 4);
            u32x4 o; o.x = pk2(x0[0], x0[1]); o.y = pk2(x0[2], x0[3]); o.z = pk2(x1[0], x1[1]); o.w = pk2(x1[2], x1[3]);
            *(u32x4*)(dst + j * 8) = o;
        } else {
            float v[8]; bf16_t* dst; size_t j; size_t doff;
            if (i < E5) { j = i - E4; doff = j * 8; dst = (bf16_t*)(ws + WS_T256); const int m = (int)(j * 8) / 256, k0 = (int)(j * 8) % 256, cp = m & 255, h = m >> 8;
#pragma unroll
                for (int e = 0; e < 8; ++e) { const float ang = (float)(((cp * (k0 + e)) & 255) * 2) * (1.0f / 256.0f); v[e] = h ? sinpif(ang) : cospif(ang); } }
            else if (i < E6) { j = i - E5; dst = (bf16_t*)(ws + WS_CS256); const int sp = (int)(j * 8) / 512, kk0 = (int)(j * 8) % 512, h = kk0 / 256, s0 = kk0 % 256; doff = (size_t)sp * 2048 + kk0;
#pragma unroll
                for (int e = 0; e < 8; ++e) { const float ang = (float)(((sp * (s0 + e)) & 255) * 2) * (1.0f / 256.0f); v[e] = h ? -sinpif(ang) : cospif(ang); } }
            else { j = i - E6; doff = j * 8; dst = (bf16_t*)(ws + WS_CS1024); const int sp = (int)(j * 8) / 2048, kk0 = (int)(j * 8) % 2048, h = kk0 / 1024, s0 = kk0 % 1024;
#pragma unroll
                for (int e = 0; e < 8; ++e) { const float ang = (float)(((sp * (s0 + e)) & 1023) * 2) * (1.0f / 1024.0f); v[e] = h ? -sinpif(ang) : cospif(ang); } }
            u32x4 o; o.x = pk2(v[0], v[1]); o.y = pk2(v[2], v[3]); o.z = pk2(v[4], v[5]); o.w = pk2(v[6], v[7]);
            *(u32x4*)(dst + doff) = o;
        }
    }
    if (gt < 2048) { const int pos = (int)gt >> 5, f = (int)gt & 31; const float inv = powf(10000.0f, -(float)f / 32.0f), ang = (float)pos * inv;
        float* rt = (float*)(ws + WS_ROPE); rt[gt] = cosf(ang); rt[2048 + gt] = sinf(ang); }
}
__device__ __forceinline__ void prologue_b(const Args& A, LAS unsigned char* lds, int G, int wv) {
    const size_t gt = (size_t)obid() * NTHR + ptid(wv), GT = (size_t)G * NTHR;
    const float* P = (const float*)(ws_opaque(A.ws) + WS_ADAP); float* Mo = (float*)(ws_opaque(A.ws) + WS_MODS);
    for (size_t i = gt; i < (size_t)4 * 3 * NMODV; i += GT) { const int l = (int)(i / (3 * NMODV)), r = (int)(i % (3 * NMODV)), j = r % NMODV;
        float s = asg(A.in[I_BADA])[(size_t)l * NMODV + j];
#pragma unroll
        for (int ks = 0; ks < 4; ++ks) s += P[((size_t)(l * 4 + ks) * 3) * NMODV + r];
        Mo[i] = s; }
}

__device__ __forceinline__ void nm_phase(const Args& A, int G, bool first, bool do_slab, float coef, int layer_gate, int kgate, bool do_norm, const float* g, int layer, int kshift, int wv, bool q8, int gx, int grk) {
    const int tid = ptid(wv);
    const int lane = tid & 63, wave = wv;
    const int gw = obid() * NWAVES + wave, NGW = G * NWAVES;
    bf16_t* xd = (bf16_t*)(ws_opaque(A.ws) + WS_XB); bf16_t* H = (bf16_t*)(ws_opaque(A.ws) + WS_H);
    const float* mods = (const float*)(ws_opaque(A.ws) + WS_MODS); const float* slab = (const float*)(ws_opaque(A.ws) + WS_SLAB);
    const int r_lo = do_norm ? 0 : MP;
#define NM_ROW(it_) ((((it_) < 4 ? 4 * gx + (it_) : 32 + gx) * 256) + grk * 8 + wave)
#define NM_LOAD(buf, it_) do { const int r_ = NM_ROW(it_); \
        if (first) { const float* xr_ = r_ < MP ? asg(A.in[I_XP]) + (size_t)r_ * DM : asg(A.in[I_XS]) + (size_t)(r_ - MP) * DM; \
            _Pragma("unroll") for (int j = 0; j < 8; ++j) buf[j] = *(const f32x4*)(xr_ + 4 * lane + 256 * j); } \
        else { const bf16_t* xr_ = xd + (size_t)r_ * DM; \
            _Pragma("unroll") for (int j = 0; j < 8; ++j) { const u32x2 w_ = *(const u32x2*)(xr_ + 4 * lane + 256 * j); buf[j] = (f32x4){bf_lo(w_.x), bf_hi(w_.x), bf_lo(w_.y), bf_hi(w_.y)}; } } } while (0)
    const int it0 = do_norm ? 0 : 4;
    f32x4 v[8], nx[8], ma[8], mb[8]; int cvl = -1;
    NM_LOAD(v, it0);
#pragma unroll 1
    for (int it = it0; it < 5; ++it) {
        const int r = NM_ROW(it);
        const int cv = r < MP ? 0 : 1 + ((r - MP) >> 10);
        if (it < 4) NM_LOAD(nx, it + 1);
        const bool wr_x = first || (do_slab && r >= MP);
        if (do_slab && r >= MP) {
            const float* gt_ = mods + ((size_t)(layer_gate * 3 + cv)) * NMODV + kgate * DM;
            const bf16_t* sb = (const bf16_t*)slab + (size_t)(r - MP) * DM;
#pragma unroll
            for (int jh = 0; jh < 8; jh += 4) {
                u32x2 sw[4][4]; f32x4 gq[4];
#pragma unroll
                for (int jj = 0; jj < 4; ++jj) { const int c = 4 * lane + 256 * (jh + jj);
                    sw[0][jj] = *(const u32x2*)(sb + c); sw[1][jj] = *(const u32x2*)(sb + (size_t)MS * DM + c); sw[2][jj] = *(const u32x2*)(sb + (size_t)2 * MS * DM + c); sw[3][jj] = *(const u32x2*)(sb + (size_t)3 * MS * DM + c);
                    gq[jj] = *(const f32x4*)(gt_ + c); }
                __builtin_amdgcn_sched_barrier(0);
#pragma unroll
                for (int jj = 0; jj < 4; ++jj) { const u32x2 w0 = sw[0][jj], w1 = sw[1][jj], w2 = sw[2][jj], w3 = sw[3][jj];
                    const f32x4 s = {(bf_lo(w0.x) + bf_lo(w1.x)) + (bf_lo(w2.x) + bf_lo(w3.x)), (bf_hi(w0.x) + bf_hi(w1.x)) + (bf_hi(w2.x) + bf_hi(w3.x)),
                                     (bf_lo(w0.y) + bf_lo(w1.y)) + (bf_lo(w2.y) + bf_lo(w3.y)), (bf_hi(w0.y) + bf_hi(w1.y)) + (bf_hi(w2.y) + bf_hi(w3.y))};
                    v[jh + jj] = v[jh + jj] + (gq[jj] * coef) * s; }
            }
        }
        if (wr_x) {
            if (!do_norm) {
#pragma unroll
                for (int j = 0; j < 8; ++j) *(f32x4*)(asg(A.out) + (size_t)r * DM + 4 * lane + 256 * j) = v[j];
            } else {
#pragma unroll
                for (int j = 0; j < 8; ++j) { u32x2 w; w.x = cvt_pk_bf16(v[j][0], v[j][1]); w.y = cvt_pk_bf16(v[j][2], v[j][3]); *(u32x2*)(xd + (size_t)r * DM + 4 * lane + 256 * j) = w; }
            }
        }
        if (do_norm) {
            float ss = 0.f;
#pragma unroll
            for (int j = 0; j < 8; ++j) ss += (v[j][0] * v[j][0] + v[j][1] * v[j][1]) + (v[j][2] * v[j][2] + v[j][3] * v[j][3]);
            ss = wave_sum(ss);
            const float rstd = 1.0f / sqrtf(ss * (1.0f / DM) + EPS);
            if (cv != cvl) { cvl = cv; const float* sh = mods + ((size_t)(layer * 3 + cv)) * NMODV + kshift * DM; const float* scp = sh + DM;
                f32x4 t1[8];
#pragma unroll
                for (int j = 0; j < 8; ++j) { const int c = 4 * lane + 256 * j; ma[j] = *(const f32x4*)(g + c); t1[j] = *(const f32x4*)(scp + c); mb[j] = *(const f32x4*)(sh + c); }
                __builtin_amdgcn_sched_barrier(0);
#pragma unroll
                for (int j = 0; j < 8; ++j) ma[j] = ma[j] * (t1[j] + 1.0f); }
            if (!q8) {
#pragma unroll
                for (int j = 0; j < 8; ++j) { const int c = 4 * lane + 256 * j;
                    const f32x4 y = (v[j] * rstd) * ma[j] + mb[j];
                    u32x2 w; w.x = cvt_pk_bf16(y[0], y[1]); w.y = cvt_pk_bf16(y[2], y[3]);
                    *(u32x2*)(H + (size_t)r * DM + c) = w; }
            } else {
                float amax = 0.f;
#pragma unroll
                for (int j = 0; j < 8; ++j) {
                    v[j] = (v[j] * rstd) * ma[j] + mb[j];
                    amax = fmaxf(fmaxf(amax, fmaxf(fabsf(v[j][0]), fabsf(v[j][1]))), fmaxf(fabsf(v[j][2]), fabsf(v[j][3]))); }
                amax = wave_max(amax);
                amax = fmaxf(amax, 1e-30f);
                const float inv = 127.0f / amax;
                signed char* H8 = (signed char*)H;
#pragma unroll
                for (int j = 0; j < 8; ++j) { const int c = 4 * lane + 256 * j; unsigned w = 0u;
#pragma unroll
                    for (int e = 0; e < 4; ++e) { int q = (int)__builtin_rintf(v[j][e] * inv); q = q > 127 ? 127 : (q < -127 ? -127 : q); w |= (unsigned)(q & 255) << (8 * e); }
                    *(unsigned*)(H8 + (size_t)r * DM + c) = w; }
                if (lane == 0) ((float*)(ws_opaque(A.ws) + WS_RSC))[r] = amax * (1.0f / 127.0f);
            }
        }
#pragma unroll
        for (int j = 0; j < 8; ++j) v[j] = nx[j];
    }
#undef NM_ROW
#undef NM_LOAD
}

__device__ __forceinline__ void q8act_phase(const Args& A, int wv, int gx, int grk) {
    const int tid = ptid(wv), lane = tid & 63;
    const bf16_t* act = (const bf16_t*)(ws_opaque(A.ws) + WS_ACT); signed char* a8 = (signed char*)(ws_opaque(A.ws) + WS_ACT8); float* rs2 = (float*)(ws_opaque(A.ws) + WS_RSC2);
#define QA_ROW(it_) ((((it_) < 4 ? 4 * gx + (it_) : 32 + gx) * 256) + grk * 8 + wv)
#define QA_LOAD(buf, it_) do { const bf16_t* row_ = act + (size_t)QA_ROW(it_) * DFF; \
        _Pragma("unroll") for (int j = 0; j < 11; ++j) { const int idx_ = lane + 64 * j; buf[j] = (idx_ < 688) ? __builtin_nontemporal_load((const u32x4*)(row_ + idx_ * 8)) : (u32x4){0u, 0u, 0u, 0u}; } } while (0)
    u32x4 v[11], nx[11];
    QA_LOAD(v, 0);
#pragma unroll 1
    for (int it = 0; it < 5; ++it) {
        const int r = QA_ROW(it);
        if (it < 4) QA_LOAD(nx, it + 1);
        float amax = 0.f;
#pragma unroll
        for (int j = 0; j < 11; ++j) {
#pragma unroll
            for (int e = 0; e < 4; ++e) amax = fmaxf(amax, fmaxf(fabsf(bf_lo(v[j][e])), fabsf(bf_hi(v[j][e])))); }
        amax = wave_max(amax);
        amax = fmaxf(amax, 1e-30f);
        const float inv = 127.0f / amax;
        signed char* orow = a8 + (size_t)r * KD8;
#pragma unroll
        for (int j = 0; j < 11; ++j) { const int idx = lane + 64 * j; u32x2 o;
#pragma unroll
            for (int h = 0; h < 2; ++h) { unsigned w = 0u;
#pragma unroll
                for (int e = 0; e < 2; ++e) { const unsigned src = v[j][2 * h + e];
                    int q0 = (int)__builtin_rintf(bf_lo(src) * inv), q1 = (int)__builtin_rintf(bf_hi(src) * inv);
                    q0 = q0 > 127 ? 127 : (q0 < -127 ? -127 : q0); q1 = q1 > 127 ? 127 : (q1 < -127 ? -127 : q1);
                    w |= ((unsigned)(q0 & 255) | ((unsigned)(q1 & 255) << 8)) << (16 * e); }
                o[h] = w; }
            if (idx < 688) *(u32x2*)(orow + idx * 8) = o; }
        if (lane < 16) { u32x2 zv = {0u, 0u}; asm volatile("" : "+v"(zv)); *(u32x2*)(orow + DFF + lane * 8) = zv; }
        if (lane == 0) rs2[r] = amax * (1.0f / 127.0f);
#pragma unroll
        for (int j = 0; j < 11; ++j) v[j] = nx[j];
    }
#undef QA_ROW
#undef QA_LOAD
}

__device__ __forceinline__ void vstat_phase(const Args& A, int G, int wv) {
    const int tid = ptid(wv), lane = tid & 63;
    const bf16_t* mixin = (const bf16_t*)(ws_opaque(A.ws) + WS_MIXIN); float* rst = (float*)(ws_opaque(A.ws) + WS_SSQ);
    for (int r = obid() * NWAVES + wv; r < MTOT; r += G * NWAVES) {
        const bf16_t* p = mixin + (size_t)r * NIN_E + 1024 + lane * 8;
        const u32x4 a = *(const u32x4*)p, b = *(const u32x4*)(p + 512);
        float ss = 0.f;
#pragma unroll
        for (int e = 0; e < 4; ++e) { const float x0 = bf_lo(a[e]), x1 = bf_hi(a[e]), y0 = bf_lo(b[e]), y1 = bf_hi(b[e]); ss += (x0 * x0 + x1 * x1) + (y0 * y0 + y1 * y1); }
        ss = wave_sum(ss);
        if (lane == 0) rst[r] = 1.0f / sqrtf(ss * (1.0f / 1024.0f) + EPS);
    }
}

__device__ __forceinline__ void sgu_phase(const Args& A, LAS unsigned char* lds, int G, int e, int wv) {
    const int tid = ptid(wv);
    const int lane = tid & 63, wave = wv;
    const bf16_t* mixin = (const bf16_t*)(ws_opaque(A.ws) + WS_MIXIN); bf16_t* mixout = (bf16_t*)(ws_opaque(A.ws) + WS_MIXOUT);
    const float* ssq = (const float*)(ws_opaque(A.ws) + WS_SSQ);
    const bf16_t* wsg = (const bf16_t*)(ws_opaque(A.ws) + WS_WSGU) + (size_t)e * 8 * 128 * 128;
    LAS bf16_t* LT = (LAS bf16_t*)lds;
    LAS float* rs = (LAS float*)(lds + 128 * 136 * 2);
    volatile LAS unsigned* MISCq = (volatile LAS unsigned*)(lds + LDS_MISC);
    for (;;) {
        if (tid == 0) MISCq[6] = __hip_atomic_fetch_add((unsigned*)(ws_opaque(A.ws) + WS_CTL) + (8192 + 64 * (12 + e)), 1u, __ATOMIC_RELAXED, __HIP_MEMORY_SCOPE_AGENT);
        __syncthreads();
        const int u = (int)MISCq[6];
        if (u >= 80 * 8) break;
        const int ch = u >> 3, g = u & 7, t0 = ch * 128;
        __syncthreads();
        if (tid < 128) rs[tid] = ssq[t0 + tid];
        __syncthreads();
#pragma unroll
        for (int i = 0; i < 4; ++i) { const int idx = tid + NTHR * i, q = idx >> 4, cc = idx & 15;
            const u32x4 w = *(const u32x4*)(mixin + (size_t)(t0 + q) * NIN_E + 1024 + g * 128 + cc * 8);
            const float* gs = asg(A.in[I_GSGU]) + (size_t)e * 1024 + g * 128 + cc * 8; const float r = rs[q];
            const f32x4 g0 = *(const f32x4*)gs, g1 = *(const f32x4*)(gs + 4);
            float y[8] = {bf_lo(w.x) * r * g0[0], bf_hi(w.x) * r * g0[1], bf_lo(w.y) * r * g0[2], bf_hi(w.y) * r * g0[3], bf_lo(w.z) * r * g1[0], bf_hi(w.z) * r * g1[1], bf_lo(w.w) * r * g1[2], bf_hi(w.w) * r * g1[3]};
#pragma unroll
            for (int k = 0; k < 8; ++k) LT[(cc * 8 + k) * 136 + q] = (bf16_t)f2bf(y[k]); }
        __syncthreads();
        const int p = 16 * wave + (lane & 15), kq = lane >> 4;
        bf16x8 wf[4];
#pragma unroll
        for (int ks = 0; ks < 4; ++ks) wf[ks] = *(const bf16x8*)(wsg + ((size_t)g * 128 + p) * 128 + 32 * ks + 8 * kq);
        const float bias = asg(A.in[I_BSGU])[(size_t)e * 1024 + g * 128 + p];
#pragma unroll
        for (int nt = 0; nt < 8; ++nt) { f32x4 acc = {0.f, 0.f, 0.f, 0.f};
#pragma unroll
            for (int ks = 0; ks < 4; ++ks) { const bf16x8 vf = *(const LAS bf16x8*)(LT + (16 * nt + (lane & 15)) * 136 + 32 * ks + 8 * kq);
                acc = __builtin_amdgcn_mfma_f32_16x16x32_bf16(vf, wf[ks], acc, 0, 0, 0); }
            const int c = 16 * nt + 4 * kq;
            const u32x2 uu = *(const u32x2*)(mixin + (size_t)(t0 + p) * NIN_E + g * 128 + c);
            u32x2 o; o.x = cvt_pk_bf16(bf_lo(uu.x) * (acc[0] + bias), bf_hi(uu.x) * (acc[1] + bias)); o.y = cvt_pk_bf16(bf_lo(uu.y) * (acc[2] + bias), bf_hi(uu.y) * (acc[3] + bias));
            *(u32x2*)(mixout + (size_t)(t0 + p) * DM + g * 128 + c) = o; }
    }
    __syncthreads();
}

__device__ __forceinline__ void prep_phase(const Args& A, int G, int o, int wv, int gx, int grk) {
    const int tid = ptid(wv);
    const int lane = tid & 63, wave = wv, li = lane & 15, grp = lane >> 4;
    const int gw = obid() * NWAVES + wave, NGW = G * NWAVES;
    const bf16_t* mixin = (const bf16_t*)(ws_opaque(A.ws) + WS_MIXIN); bf16_t* qkv = (bf16_t*)(ws_opaque(A.ws) + WS_QKV);
    const float* rt = (const float*)(ws_opaque(A.ws) + WS_ROPE);
    for (int it = 0; it < 5; ++it) {
        const int r = (it < 4 ? 4 * gx + it : 32 + gx) * 256 + grk * 8 + wave;
        const bool smp = r >= MP; const int b = smp ? (r - MP) >> 10 : r >> 8, s = smp ? (r - MP) & 1023 : r & 255, S = smp ? 1024 : 256;
        const int prow = s >> 6, pcol = s & 63;
#pragma unroll
        for (int j = 0; j < 9; ++j) {
            const int slot = 4 * j + grp;
            const u32x4 w = __builtin_nontemporal_load((const u32x4*)(mixin + (size_t)r * NIN_O + slot * 128 + li * 8));
            float x[8] = {bf_lo(w.x), bf_hi(w.x), bf_lo(w.y), bf_hi(w.y), bf_lo(w.z), bf_hi(w.z), bf_lo(w.w), bf_hi(w.w)};
            int ty, hd, H;
            if (slot < 8) { ty = 0; hd = slot; H = 8; } else if (slot < 10) { ty = 1; hd = slot - 8; H = 2; } else if (slot < 12) { ty = 2; hd = slot - 10; H = 2; }
            else if (slot < 20) { ty = 3; hd = slot - 12; H = 8; } else if (slot < 28) { ty = 4; hd = slot - 20; H = 8; } else { ty = 5; hd = slot - 28; H = 8; }
            const bool isn = (ty != 2) && (ty != 5);
            float ss = 0.f;
#pragma unroll
            for (int k = 0; k < 8; ++k) ss += x[k] * x[k];
            ss += sx<1>(ss); ss += sx<2>(ss); ss += sx<4>(ss); ss += sx<8>(ss);
            const float rstd = 1.0f / sqrtf(ss * (1.0f / 128.0f) + EPS);
            const float* gp = asg(A.in[ty == 0 ? I_GQC : ty == 1 ? I_GKC : ty == 3 ? I_GQD : I_GKD]) + (size_t)o * 128 + li * 8;
            if (isn) {
                const f32x4 g0 = *(const f32x4*)gp, g1 = *(const f32x4*)(gp + 4);
#pragma unroll
                for (int k = 0; k < 4; ++k) { x[k] = x[k] * rstd * g0[k]; x[4 + k] = x[4 + k] * rstd * g1[k]; }
            }
            if (smp && j <= 2) {
                const int pos = (li < 8) ? prow : pcol; const float* ct = rt + pos * 32 + 8 * (li & 3); const float* st = ct + 2048;
                const bool lo = !(li & 4), dor = ty < 2;
#pragma unroll
                for (int k = 0; k < 8; ++k) { const float xp = sx<4>(x[k]); const float c = ct[k], sn = st[k];
                    const float rr = lo ? (x[k] * c - xp * sn) : (xp * sn + x[k] * c); x[k] = dor ? rr : x[k]; }
            }
            const size_t base = smp ? (ty == 0 ? Q_QCS : ty == 1 ? Q_KCS : ty == 2 ? Q_VCS : ty == 3 ? Q_QDS : ty == 4 ? Q_KDS : Q_VDS)
                                    : (ty == 0 ? Q_QCP : ty == 1 ? Q_KCP : ty == 2 ? Q_VCP : ty == 3 ? Q_QDP : ty == 4 ? Q_KDP : Q_VDP);
            u32x4 ov; ov.x = cvt_pk_bf16(x[0], x[1]); ov.y = cvt_pk_bf16(x[2], x[3]); ov.z = cvt_pk_bf16(x[4], x[5]); ov.w = cvt_pk_bf16(x[6], x[7]);
            *(u32x4*)(qkv + base + ((size_t)(b * H + hd) * S + s) * 128 + li * 8) = ov;
            if (!smp && (ty == 1 || ty == 2 || ty == 4 || ty == 5)) {
                float* sp = asg(A.out) + (ty == 1 ? O_SCK : ty == 2 ? O_SCV : ty == 4 ? O_SDK : O_SDV) + (((size_t)(b * 2 + o) * H + hd) * 256 + s) * 128 + li * 8;
                __builtin_nontemporal_store((f32x4){x[0], x[1], x[2], x[3]}, (f32x4*)sp); __builtin_nontemporal_store((f32x4){x[4], x[5], x[6], x[7]}, (f32x4*)(sp + 4));
            }
        }
    }
}

__device__ __forceinline__ void attn_phase(const Args& A, LAS unsigned char* lds, int G, int o, int wv) {
    const bf16_t* qkv = (const bf16_t*)(ws_opaque(A.ws) + WS_QKV); bf16_t* mixout = (bf16_t*)(ws_opaque(A.ws) + WS_MIXOUT);
    const int c = obid();
    for (int i = 0;; ++i) {
        int u;
        if (G == 256) { if (c < 128) { if (i > 0) break; u = c; } else { if (i >= 4) break; u = 128 + 4 * (c - 128) + i; } }
        else { u = c + i * G; if (u >= 640) break; }
        att::AUnit U;
        if (u < 64) {
            const int b = u >> 5, h = (u >> 2) & 7, qb = u & 3;
            U.q0 = qb * 256; U.kt0 = qb == 0 ? 0 : (qb == 1 ? 0 : (qb == 2 ? 4 : 8)); U.nloc = (qb == 0 || qb == 3) ? 8 : 11; U.nctx = 8; U.nt = 8 + ((U.nloc + 1) & ~1); U.mode = 2;
            U.Q = qkv + Q_QDS + ((size_t)(b * 8 + h) * 1024 + U.q0) * 128; U.O = mixout + (size_t)(MP + b * 1024 + U.q0) * DM + (8 + h) * 128;
            U.Kc = (const bf16_t*)(ws_opaque(A.ws) + WS_CDK) + ((size_t)((b * 2 + o) * 8 + h)) * 512 * 128; U.Vc = (const bf16_t*)(ws_opaque(A.ws) + WS_CDV) + ((size_t)((b * 2 + o) * 8 + h)) * 512 * 128;
            U.Kl = qkv + Q_KDS + ((size_t)(b * 8 + h) * 1024 + U.kt0 * 64) * 128; U.Vl = qkv + Q_VDS + ((size_t)(b * 8 + h) * 1024 + U.kt0 * 64) * 128;
            U.m0 = -1e30f; U.l0 = 0.f; U.rpb = asg(A.in[I_RPB]) + ((size_t)o * 8 + h) * 15 * 31;
        } else if (u < 128) {
            const int v = u - 64, b = v >> 5, h = (v >> 2) & 7, qb = v & 3, kvh = h >> 2;
            U.q0 = qb * 256; const int k_lo = qb == 0 ? 0 : 4 * qb - 2, k_hi = qb == 3 ? 15 : 4 * qb + 5;
            U.kt0 = k_lo; U.nloc = k_hi - k_lo + 1; U.nctx = 8; U.nt = 8 + U.nloc; U.mode = 1;
            U.Q = qkv + Q_QCS + ((size_t)(b * 8 + h) * 1024 + U.q0) * 128; U.O = mixout + (size_t)(MP + b * 1024 + U.q0) * DM + h * 128;
            U.Kc = (const bf16_t*)(ws_opaque(A.ws) + WS_CCK) + ((size_t)((b * 2 + o) * 2 + kvh)) * 512 * 128; U.Vc = (const bf16_t*)(ws_opaque(A.ws) + WS_CCV) + ((size_t)((b * 2 + o) * 2 + kvh)) * 512 * 128;
            U.Kl = qkv + Q_KCS + ((size_t)(b * 2 + kvh) * 1024 + U.kt0 * 64) * 128; U.Vl = qkv + Q_VCS + ((size_t)(b * 2 + kvh) * 1024 + U.kt0 * 64) * 128;
            U.m0 = asg(A.in[I_SINK])[o * 8 + h] * (1.0f / att::SCALE); U.l0 = 1.f; U.rpb = nullptr;
        } else {
            const int v = u - 128, b = v >> 4, hh = v & 15;
            U.q0 = 0; U.kt0 = 0; U.nloc = 0; U.nctx = 4; U.nt = 4; U.mode = 0; U.rpb = nullptr; U.Kl = nullptr; U.Vl = nullptr;
            U.O = mixout + (size_t)(b * 256) * DM + hh * 128;
            if (hh < 8) { const int kvh = hh >> 2;
                U.Q = qkv + Q_QCP + ((size_t)(b * 8 + hh) * 256) * 128; U.Kc = qkv + Q_KCP + ((size_t)(b * 2 + kvh) * 256) * 128; U.Vc = qkv + Q_VCP + ((size_t)(b * 2 + kvh) * 256) * 128;
                U.m0 = asg(A.in[I_SINK])[o * 8 + hh] * (1.0f / att::SCALE); U.l0 = 1.f; }
            else { const int h = hh - 8;
                U.Q = qkv + Q_QDP + ((size_t)(b * 8 + h) * 256) * 128; U.Kc = qkv + Q_KDP + ((size_t)(b * 8 + h) * 256) * 128; U.Vc = qkv + Q_VDP + ((size_t)(b * 8 + h) * 256) * 128;
                U.m0 = -1e30f; U.l0 = 0.f; }
        }
        att::attn_unit(U, (char*)lds, wv);
    }
}

#ifndef ONLY_PH
#define ONLY_PH (-1)
#endif
#define PH(n) (ONLY_PH < 0 || ONLY_PH == (n))
#ifndef DUPMASK
#define DUPMASK 0
#endif
#define DUPN(g) (((DUPMASK >> (g)) & 1) ? 2 : 1)
#define TSMULT 8
#define TS0() do { if (ts_on) ts_t0 = __builtin_amdgcn_s_memrealtime(); } while (0)
#define TSC0() do { if (((TSMASK >> 13) & 1) && ts_on) ts_c0 = (unsigned long long)__builtin_readcyclecounter(); } while (0)
#define TSC1() do { if (((TSMASK >> 13) & 1) && ts_on) { const unsigned long long d_ = (unsigned long long)__builtin_readcyclecounter() - ts_c0; TSACC[0] += (unsigned)(d_ / 20ull); } } while (0)
#define TS1(g) do { if (((TSMASK >> (g)) & 1) && ts_on) { const unsigned long long d_ = __builtin_amdgcn_s_memrealtime() - ts_t0; TSACC[0] += (unsigned)d_; } } while (0)
__global__ void __launch_bounds__(NTHR, 2) mega_fwd(Args args) {
    extern __shared__ __attribute__((aligned(16))) unsigned char lds_raw[];
    LAS unsigned char* lds = (LAS unsigned char*)lds_raw;
    const int G = gridDim.x, wv = __builtin_amdgcn_readfirstlane((int)(threadIdx.x >> 6));
    volatile LAS unsigned* MISC = (volatile LAS unsigned*)(lds + LDS_MISC);
    { const int t0 = ptid(wv); if (t0 < 16) MISC[t0] = 0u; }
    __syncthreads();
#define WSB ws_opaque(args.ws)
    const bool ts_on = (TSMASK != 0 || TSBAR != 0) && (blockIdx.x == 0) && (wv == 0); unsigned long long ts_t0 = 0, ts_c0 = 0; (void)ts_c0; volatile LAS unsigned* TSACC = MISC + 2; (void)ts_on; (void)ts_t0; (void)TSACC;
    XcdBarrier bar = xcd_barrier_post((unsigned*)(WSB + WS_CTL), MISC + 8, ptid(wv));
    const float* mods = (const float*)(WSB + WS_MODS);

    int ql = 1, nbar = 0; int lok = 0; int gx = 0, grk = 0;
#ifndef LOCAL_BAR
#define LOCAL_BAR 1
#endif
#define BARRIER2(g, loc) do { TS0(); \
    if (LOCAL_BAR && (loc) && lok) { local_barrier((unsigned*)(WSB + WS_CTL), (unsigned*)(WSB + WS_CTL) + 8192 + 64 * (20 + gx), 32u, wv); } \
    else { fill_wait(args, lds, G, wv, nbar, ql); for (int br_ = 0; br_ < DUPN(10); ++br_) { xcd_barrier(bar, wv); ++nbar; } } \
    TS1(10); if (((TSBAR >> (g)) & 1) && ts_on) { TSACC[0] += (unsigned)(__builtin_amdgcn_s_memrealtime() - ts_t0); } } while (0)
#define BARRIER(g) BARRIER2(g, false)
    for (int rep = 0; rep < DUPN(0); ++rep) { TS0(); if (PH(0)) prologue_a(args, lds, G, wv); TS1(0); BARRIER(0); }
    if (ptid(wv) == 0) { unsigned* barw = (unsigned*)(WSB + WS_CTL); const unsigned myx = MISC[11]; unsigned npop = 0u, below = 0u; bool uni = (G == 256);
        for (unsigned j = 0; j < 16; ++j) { const unsigned cnt = xb_ld(&barw[XB_XCNT(j)]); if (cnt) { ++npop; if (j < myx) ++below; if (cnt != 32u) uni = false; } }
        uni = uni && (npop == 8u); MISC[12] = below; MISC[13] = uni ? 1u : 0u; }
    __syncthreads();
    lok = __builtin_amdgcn_readfirstlane((int)MISC[13]); asm volatile("" : "+s"(lok));
    gx = lok ? __builtin_amdgcn_readfirstlane((int)MISC[12]) : (int)(blockIdx.x & 7);
    grk = lok ? __builtin_amdgcn_readfirstlane((int)MISC[10]) : (int)(blockIdx.x >> 3);
    TS0(); if (PH(1)) prologue_b(args, lds, G, wv); TS1(11);
    BARRIER(11);

    for (int layer = 0; layer < 4; ++layer) {
        const bf16_t* wl = (const bf16_t*)(WSB + WS_W) + (size_t)layer * W_LAYER;
        const bool odd = layer & 1; const int eo = layer >> 1;
        for (int rep = 0; rep < DUPN(5); ++rep) {
            TS0(); if (PH(2)) nm_phase(args, G, layer == 0 && rep == 0, layer > 0 && rep == 0, 0.5f, layer - 1, 8, true, asg(args.in[I_GF1]) + (size_t)layer * DM, layer, 0, wv, true, gx, grk); TS1(5);
            BARRIER2(5, true); }
        for (int rep = 0; rep < DUPN(1); ++rep) {
            TS0(); TSC0(); if (PH(3)) { pg8::SchedStd S{(const char*)(WSB + WS_H), (const char*)(wl + W_GU1), DM, DM, DM / 128, MTOT / 256, NGU / 256, (MTOT / 256) * (NGU / 256), G, obid(), (char*)(WSB + WS_ACT), DFF, 128, gx, grk};
              pg8::EpiGU8 E{(const float*)(WSB + WS_RSC), (const float*)(WSB + WS_CMAX) + (size_t)(layer * 2 + 0) * NGU}; pg8::gemm_phase<pg8::EpiGU8, pg8::SchedStd, G_ALIGN, G_SP2, true>(lds, S, E, wv); } TS1(1); TSC1();
            BARRIER2(1, true); }
        for (int rep = 0; rep < DUPN(2); ++rep) {
            TS0(); if (PH(4)) { q8act_phase(args, wv, gx, grk); BARRIER2(2, true);
              pg8::SchedSplit S{(const char*)(WSB + WS_ACT8), (const char*)(wl + W_DN1), KD8, KD8, KD8 / 128, 12, G, obid(), gx, grk};
              pg8::EpiResid8 E{(bf16_t*)(WSB + WS_XB), mods + ((size_t)layer * 3) * NMODV + 2 * DM, rep == 0 ? 0.5f : 0.0f, (float*)(WSB + WS_SLAB), (const float*)(WSB + WS_RSC2), (const float*)(WSB + WS_CMAX2) + (size_t)(layer * 2 + 0) * DM, nullptr};
              pg8::gemm_phase<pg8::EpiResid8, pg8::SchedSplit, G_ALIGN, G_SP2, true>(lds, S, E, wv); } TS1(2);
            BARRIER2(2, true); }
        for (int rep = 0; rep < DUPN(5); ++rep) {
            TS0(); if (PH(5)) nm_phase(args, G, false, rep == 0, 0.5f, layer, 2, true, asg(args.in[I_GMIX]) + (size_t)layer * DM, layer, 3, wv, false, gx, grk); TS1(5);
            BARRIER2(5, true); }
        for (int rep = 0; rep < DUPN(3); ++rep) {
            TS0(); if (PH(6)) { const int nin = odd ? NIN_O : NIN_E;
              pg8::SchedStd S{(const char*)(WSB + WS_H), (const char*)(wl + W_IN), DM * 2, DM * 2, DM / 64, MTOT / 256, nin / 256, (MTOT / 256) * (nin / 256), G, obid(), (char*)(WSB + WS_MIXIN), nin, 256, gx, grk};
              pg8::EpiBf16 E{1.0f};
              pg8::gemm_phase<pg8::EpiBf16, pg8::SchedStd, G_ALIGN, G_SP2>(lds, S, E, wv); } TS1(3);
            BARRIER2(3, odd); }
        if (!odd) {
            for (int rep = 0; rep < DUPN(6); ++rep) {
                TS0(); if (PH(7)) { pg8::SchedF1 S{(const char*)(WSB + WS_T256), (const char*)(WSB + WS_MIXIN), (char*)(WSB + WS_GT), (char*)(WSB + WS_GTS), 512, NIN_E * 2, G, obid()};
                  pg8::EpiBf16 E{1.0f};
                  pg8::gemm_phase<pg8::EpiBf16, pg8::SchedF1, G_ALIGN, G_SP2>(lds, S, E, wv); }
                vstat_phase(args, G, wv); TS1(6);
                BARRIER(6); }
            for (int rep = 0; rep < DUPN(7); ++rep) {
                TS0(); if (PH(9)) { pg8::SchedF2 S{(const char*)(WSB + WS_CS256), (const char*)(WSB + WS_CS1024), (const char*)(WSB + WS_GT), (const char*)(WSB + WS_GTS), (char*)(WSB + WS_MIXOUT), 4096, 4096, G, obid()};
                  pg8::EpiF2 E2;
                  pg8::gemm_phase<pg8::EpiF2, pg8::SchedF2, G_ALIGN, G_SP2>(lds, S, E2, wv); }
                if (PH(8)) sgu_phase(args, lds, G, eo, wv); TS1(7);
                }
        } else {
            for (int rep = 0; rep < DUPN(8); ++rep) { TS0(); if (PH(10)) prep_phase(args, G, eo, wv, gx, grk); TS1(8); BARRIER(8); }
            for (int rep = 0; rep < DUPN(9); ++rep) { TS0(); if (PH(11)) attn_phase(args, lds, G, eo, wv); TS1(9); }
        }
        if (layer < 3) { while (fill_round(args, lds, layer + 1, wv)) {} if (ql <= layer + 1) ql = layer + 2; }
        BARRIER(9);
        for (int rep = 0; rep < DUPN(4); ++rep) {
            TS0(); if (PH(12)) { pg8::SchedSplit S{(const char*)(WSB + WS_MIXOUT), (const char*)(wl + W_OUT), DM * 2, DM * 2, DM / 64, 8, G, obid(), gx, grk};
              pg8::EpiResid E{(bf16_t*)(WSB + WS_XB), mods + ((size_t)layer * 3) * NMODV + 5 * DM, rep == 0 ? 1.0f : 0.0f, (float*)(WSB + WS_SLAB)};
              pg8::gemm_phase<pg8::EpiResid, pg8::SchedSplit, G_ALIGN, G_SP2>(lds, S, E, wv); } TS1(4);
            BARRIER2(4, true); }
        for (int rep = 0; rep < DUPN(5); ++rep) {
            TS0(); if (PH(13)) nm_phase(args, G, false, rep == 0, 1.0f, layer, 5, true, asg(args.in[I_GF2]) + (size_t)layer * DM, layer, 6, wv, true, gx, grk); TS1(5);
            BARRIER2(5, true); }
        for (int rep = 0; rep < DUPN(1); ++rep) {
            TS0(); TSC0(); if (PH(14)) { pg8::SchedStd S{(const char*)(WSB + WS_H), (const char*)(wl + W_GU2), DM, DM, DM / 128, MTOT / 256, NGU / 256, (MTOT / 256) * (NGU / 256), G, obid(), (char*)(WSB + WS_ACT), DFF, 128, gx, grk};
              pg8::EpiGU8 E{(const float*)(WSB + WS_RSC), (const float*)(WSB + WS_CMAX) + (size_t)(layer * 2 + 1) * NGU}; pg8::gemm_phase<pg8::EpiGU8, pg8::SchedStd, G_ALIGN, G_SP2, true>(lds, S, E, wv); } TS1(1); TSC1();
            BARRIER2(1, true); }
        for (int rep = 0; rep < DUPN(2); ++rep) {
            TS0(); if (PH(15)) { q8act_phase(args, wv, gx, grk); BARRIER2(2, true);
              pg8::SchedSplit S{(const char*)(WSB + WS_ACT8), (const char*)(wl + W_DN2), KD8, KD8, KD8 / 128, 12, G, obid(), gx, grk};
              pg8::EpiResid8 E{(bf16_t*)(WSB + WS_XB), mods + ((size_t)layer * 3) * NMODV + 8 * DM, rep == 0 ? 0.5f : 0.0f, (float*)(WSB + WS_SLAB), (const float*)(WSB + WS_RSC2), (const float*)(WSB + WS_CMAX2) + (size_t)(layer * 2 + 1) * DM, layer == 3 ? asg(args.out) : nullptr};
              pg8::gemm_phase<pg8::EpiResid8, pg8::SchedSplit, G_ALIGN, G_SP2, true>(lds, S, E, wv); } TS1(2);
            BARRIER2(2, true); }
    }
    TS0(); if (PH(16)) nm_phase(args, G, false, true, 0.5f, 3, 8, false, nullptr, 0, 0, wv, false, gx, grk); TS1(11);
    if (ts_on) { const unsigned long long te_ = __builtin_amdgcn_s_memrealtime() + (unsigned long long)TSMULT * TSACC[0]; while (__builtin_amdgcn_s_memrealtime() < te_) __builtin_amdgcn_s_sleep(8); }
#undef BARRIER
}

extern "C" void kernel_launch(void* const* d_in, const int* in_sizes, int n_in, void* d_out, int out_size, void* d_ws, size_t ws_size, hipStream_t stream) {
    static int grid = 0;
    if (grid == 0) {
        if (n_in != 29 || (size_t)out_size != O_END || ws_size < WS_END) {
            fprintf(stderr, "kernel_launch: unexpected shapes: n_in %d out %d ws %zu (need %zu)\n", n_in, out_size, ws_size, (size_t)WS_END); grid = -1; return; }
        int dev = 0, cus = 0, per_cu = 0;
        if (hipGetDevice(&dev) != hipSuccess || hipDeviceGetAttribute(&cus, hipDeviceAttributeMultiprocessorCount, dev) != hipSuccess) { grid = -1; return; }
        if (hipFuncSetAttribute((const void*)mega_fwd, hipFuncAttributeMaxDynamicSharedMemorySize, LDS_BYTES) != hipSuccess) { fprintf(stderr, "kernel_launch: hipFuncSetAttribute failed\n"); grid = -1; return; }
        if (hipOccupancyMaxActiveBlocksPerMultiprocessor(&per_cu, (const void*)mega_fwd, NTHR, LDS_BYTES) != hipSuccess || per_cu < 1)
            fprintf(stderr, "kernel_launch: occupancy query reports %d\n", per_cu);
        (void)hipGetLastError();
        if (cus != 256) { fprintf(stderr, "kernel_launch: built for a 256-CU device (8 groups of 32 workgroups), found %d CUs; nothing launched\n", cus); grid = -1; return; }
        grid = cus;
    }
    if (grid < 0) return;
    if (hipMemsetAsync((char*)d_ws + WS_CTL, 0, CTL_ZERO_BYTES, stream) != hipSuccess) { fprintf(stderr, "kernel_launch: memset failed\n"); return; }
    Args a{};
    for (int i = 0; i < 29; ++i) a.in[i] = (const float*)d_in[i];
    a.out = (float*)d_out; a.ws = (unsigned char*)d_ws;
    hipLaunchKernelGGL(mega_fwd, dim3(grid), dim3(NTHR), LDS_BYTES, stream, a);
    const hipError_t le = hipPeekAtLastError();
    if (le != hipSuccess) fprintf(stderr, "kernel_launch: launch failed: %s\n", hipGetErrorName(le));
}
```
